# Optimizing an MI355X kernel written in HIP

```python
import math
import jax
import jax.numpy as jnp
from jax import lax
import numpy as np

D_MODEL = 1024
BATCH = 2
SEQ = 8192
DEPTH = 2

RWKV_HEADS = 8
RWKV_HEAD_DIM = 64
RWKV_WIDTH = RWKV_HEADS * RWKV_HEAD_DIM
DECAY_LORA = 64
AAA_LORA = 64
GATE_LORA = 160
RWKV_SIZES = (RWKV_WIDTH, RWKV_WIDTH, RWKV_WIDTH, DECAY_LORA, AAA_LORA, GATE_LORA)
RWKV_COLS = sum(RWKV_SIZES)
RWKV_GN_EPS = 64e-5
LRU_WIDTH = 512
LRU_BLOCKS = 8
LRU_BLOCK_DIM = LRU_WIDTH // LRU_BLOCKS
CONV_WIDTH = 4
LRU_C = 8.0
ATTN_HEAD_DIM = 64
DILATION_PAIRS = ((128, 1), (512, 4), (2048, 16))
N_GROUPS = len(DILATION_PAIRS)
HEADS_PER_GROUP = 4
ATTN_HEADS = N_GROUPS * HEADS_PER_GROUP
ATTN_WIDTH = ATTN_HEADS * ATTN_HEAD_DIM
ATTN_OUT_WIDTH = HEADS_PER_GROUP * ATTN_HEAD_DIM
BLK = 128
N_BUCKETS = 32
MAX_DISTANCE = 2048
NEG_INF = -1e30
N_BRANCHES = 3
D_FF = 4 * D_MODEL
RMS_EPS = 1e-6
IN_SIZES = (RWKV_COLS, LRU_WIDTH, LRU_WIDTH, ATTN_WIDTH, ATTN_WIDTH, ATTN_WIDTH, N_BRANCHES * D_MODEL)
D_IN = sum(IN_SIZES)

kernel_name = 'hybrid_rwkv7_rglru_dilated_attn_block'


def split_cols(z, sizes):
    parts, off = [], 0
    for s in sizes:
        parts.append(z[..., off:off + s])
        off += s
    return parts


def rms_norm(x, g):
    xf = x.astype(jnp.float32)
    y = xf * lax.rsqrt(jnp.mean(xf * xf, axis=-1, keepdims=True) + RMS_EPS)
    return (y * g.astype(jnp.float32)).astype(x.dtype)


def token_shift(t):
    return jnp.pad(t, ((0, 0), (1, 0), (0, 0)))[:, :-1]


def rwkv7_scan(r, decay, k, v, a, b):
    bsz, _, nh, n = r.shape

    def step(state, inp):
        r_t, w_t, k_t, v_t, a_t, b_t = inp
        sa = jnp.einsum('bhij,bhj->bhi', state, a_t)
        state = (state * w_t[:, :, None, :] + sa[..., None] * b_t[:, :, None, :]
                 + v_t[..., None] * k_t[:, :, None, :])
        return state, jnp.einsum('bhij,bhj->bhi', state, r_t)

    seq_major = tuple(jnp.swapaxes(t, 0, 1) for t in (r, decay, k, v, a, b))
    _, y = lax.scan(step, jnp.zeros((bsz, nh, n, n), jnp.float32), seq_major)
    return jnp.swapaxes(y, 0, 1)


def rwkv7_mixer(feats, mu, w0, w_up, a0, a_up, g_up, k_k, k_a, r_k, ln_g, ln_b):
    f32 = jnp.float32
    f = feats.astype(f32)
    f = f + (token_shift(f) - f) * mu.astype(f32)
    r, k, v, xw, xa, xg = split_cols(f, RWKV_SIZES)
    bsz, seq, _ = r.shape
    w = -jax.nn.softplus(-(w0.astype(f32) + jnp.tanh(xw) @ w_up.astype(f32))) - 0.5
    decay = jnp.exp(-jnp.exp(w))
    a = jax.nn.sigmoid(a0.astype(f32) + xa @ a_up.astype(f32))
    g = jax.nn.sigmoid(xg) @ g_up.astype(f32)
    heads = lambda t: t.reshape(bsz, seq, RWKV_HEADS, RWKV_HEAD_DIM)
    kk = heads(k * k_k.astype(f32))
    kk = kk / jnp.maximum(jnp.sqrt(jnp.sum(kk * kk, axis=-1, keepdims=True)), 1e-12)
    k = k * (1.0 + (a - 1.0) * k_a.astype(f32))
    r_h, k_h, v_h, w_h, a_h = heads(r), heads(k), heads(v), heads(decay), heads(a)
    y = rwkv7_scan(r_h, w_h, k_h, v_h, -kk, kk * a_h)
    mean = jnp.mean(y, axis=-1, keepdims=True)
    var = jnp.mean(jnp.square(y - mean), axis=-1, keepdims=True)
    y = ((y - mean) * lax.rsqrt(var + RWKV_GN_EPS)).reshape(bsz, seq, RWKV_WIDTH)
    y = y * ln_g.astype(f32) + ln_b.astype(f32)
    bonus = jnp.sum(r_h * k_h * r_k.astype(f32), axis=-1, keepdims=True) * v_h
    return (y + bonus.reshape(bsz, seq, RWKV_WIDTH)) * g


def linear_scan(a, b):
    def combine(left, right):
        a_l, b_l = left
        a_r, b_r = right
        return a_l * a_r, a_r * b_l + b_r
    _, h = lax.associative_scan(combine, (a, b), axis=1)
    return h


def rglru_mixer(xb, yb, conv_w, conv_b, wa, ba, wx, bx, lam):
    f32 = jnp.float32
    xb = xb.astype(f32)
    bsz, seq, _ = xb.shape
    xc = lax.conv_general_dilated(xb, conv_w.astype(f32)[:, None, :], window_strides=(1,),
                                  padding=((CONV_WIDTH - 1, 0),),
                                  dimension_numbers=('NWC', 'WIO', 'NWC'),
                                  feature_group_count=LRU_WIDTH) + conv_b.astype(f32)
    xblk = xc.reshape(bsz, seq, LRU_BLOCKS, LRU_BLOCK_DIM)
    gate_a = jax.nn.sigmoid(jnp.einsum('bsni,nij->bsnj', xblk, wa.astype(f32)).reshape(bsz, seq, LRU_WIDTH) + ba.astype(f32))
    gate_x = jax.nn.sigmoid(jnp.einsum('bsni,nij->bsnj', xblk, wx.astype(f32)).reshape(bsz, seq, LRU_WIDTH) + bx.astype(f32))
    log_a = -LRU_C * gate_a * jax.nn.softplus(-lam.astype(f32))
    a = jnp.exp(log_a)
    mult = jnp.sqrt(jnp.maximum(-jnp.expm1(2.0 * log_a), 0.0))
    mult = jnp.where((jnp.arange(seq) == 0)[None, :, None], 1.0, mult)
    h = linear_scan(a, xc * gate_x * mult)
    return h * jax.nn.gelu(yb.astype(f32), approximate=True)


def t5_bucket(dist):
    max_exact = N_BUCKETS // 2
    d = jnp.maximum(dist, 0)
    large = max_exact + (jnp.log(jnp.maximum(d, 1).astype(jnp.float32) / max_exact)
                         / math.log(MAX_DISTANCE / max_exact) * (N_BUCKETS - max_exact)).astype(jnp.int32)
    large = jnp.minimum(large, N_BUCKETS - 1)
    return jnp.where(d < max_exact, d, large)


def dilated_group_attention(q, k, v, bias_table, window, dilation):
    bsz, seq, hg, dh = q.shape
    span = dilation * BLK
    s_pad = -(-seq // span) * span
    nb = s_pad // span

    def to_sub(t):
        t = jnp.pad(t, ((0, 0), (0, s_pad - seq), (0, 0), (0, 0)))
        return t.reshape(bsz, nb, BLK, dilation, hg, dh).transpose(0, 3, 1, 2, 4, 5)

    def with_prev(t):
        prev = jnp.pad(t, ((0, 0), (0, 0), (1, 0), (0, 0), (0, 0), (0, 0)))[:, :, :-1]
        return jnp.concatenate([prev, t], axis=3)

    qs = to_sub(q)
    kb, vb = with_prev(to_sub(k)), with_prev(to_sub(v))
    n_keys = window // dilation
    kj = jnp.arange(2 * BLK)[None, :]
    rel = (jnp.arange(BLK)[:, None] + BLK) - kj
    band = (rel >= 0) & (rel <= n_keys)
    valid = band[None] & ((jnp.arange(nb)[:, None, None] > 0) | (kj >= BLK)[None])
    bias = jnp.moveaxis(bias_table.astype(jnp.float32)[t5_bucket(rel * dilation)], -1, 0)
    logits = jnp.einsum('brnqhe,brnkhe->brnhqk', qs, kb) + bias
    logits = jnp.where(valid[None, None, :, None], logits, NEG_INF)
    m = jnp.max(logits, axis=-1, keepdims=True)
    p = jnp.exp(logits - m)
    l = jnp.sum(p, axis=-1)
    o = jnp.einsum('brnhqk,brnkhe->brnqhe', p, vb) / jnp.swapaxes(l, -1, -2)[..., None]
    lse = jnp.swapaxes(m[..., 0] + jnp.log(l), -1, -2)

    def from_sub(t):
        t = jnp.moveaxis(t, 1, 3)
        return t.reshape((bsz, s_pad) + t.shape[4:])[:, :seq]

    return from_sub(o), from_sub(lse)


def dilated_attention_mixer(zq, zk, zv, q_g, k_g, rel_bias):
    f32 = jnp.float32
    bsz, seq, _ = zq.shape
    shp = (bsz, seq, ATTN_HEADS, ATTN_HEAD_DIM)
    q = rms_norm(zq.astype(f32).reshape(shp), q_g) * (ATTN_HEAD_DIM ** -0.5)
    k = rms_norm(zk.astype(f32).reshape(shp), k_g)
    v = zv.astype(f32).reshape(shp)
    outs, lses = [], []
    for gi, (window, dil) in enumerate(DILATION_PAIRS):
        hs = slice(gi * HEADS_PER_GROUP, (gi + 1) * HEADS_PER_GROUP)
        o, lse = dilated_group_attention(q[:, :, hs], k[:, :, hs], v[:, :, hs], rel_bias[:, hs], window, dil)
        outs.append(o)
        lses.append(lse)
    wts = jax.nn.softmax(jnp.stack(lses, axis=0), axis=0)
    o = jnp.sum(jnp.stack(outs, axis=0) * wts[..., None], axis=0)
    return o.reshape(bsz, seq, ATTN_OUT_WIDTH)


def setup_inputs(seed: int = 0) -> dict:
    key = jax.random.key(seed)
    ks = jax.random.split(key, 32)
    L = DEPTH
    nrm = lambda kk, shape, s: jax.random.normal(kk, shape, jnp.float32) * s
    u = jax.random.uniform(ks[22], (L, LRU_WIDTH), jnp.float32, 0.9, 0.999)
    s = u ** (1.0 / LRU_C)
    return {
        'x': nrm(ks[0], (BATCH, SEQ, D_MODEL), 1.0),
        'rel_bias': nrm(ks[1], (N_BUCKETS, ATTN_HEADS), 0.5),
        'norm_mix_g': 1.0 + nrm(ks[2], (L, D_MODEL), 0.02),
        'w_in': nrm(ks[3], (L, D_MODEL, D_IN), D_MODEL ** -0.5),
        'rwkv_mu': jax.random.uniform(ks[4], (L, RWKV_COLS), jnp.float32),
        'rwkv_w0': jax.random.uniform(ks[5], (L, RWKV_WIDTH), jnp.float32, -6.0, -1.0),
        'rwkv_w_up': nrm(ks[6], (L, DECAY_LORA, RWKV_WIDTH), 0.1 * DECAY_LORA ** -0.5),
        'rwkv_a0': nrm(ks[7], (L, RWKV_WIDTH), 0.1),
        'rwkv_a_up': nrm(ks[8], (L, AAA_LORA, RWKV_WIDTH), AAA_LORA ** -0.5),
        'rwkv_g_up': nrm(ks[9], (L, GATE_LORA, RWKV_WIDTH), GATE_LORA ** -0.5),
        'rwkv_k_k': 0.85 + nrm(ks[10], (L, RWKV_WIDTH), 0.02),
        'rwkv_k_a': 1.0 + nrm(ks[11], (L, RWKV_WIDTH), 0.02),
        'rwkv_r_k': nrm(ks[12], (L, RWKV_HEADS, RWKV_HEAD_DIM), 0.1),
        'rwkv_ln_g': 1.0 + nrm(ks[13], (L, RWKV_WIDTH), 0.02),
        'rwkv_ln_b': nrm(ks[14], (L, RWKV_WIDTH), 0.02),
        'proj_a': nrm(ks[15], (L, RWKV_WIDTH, D_MODEL), RWKV_WIDTH ** -0.5),
        'conv_w': nrm(ks[16], (L, CONV_WIDTH, LRU_WIDTH), CONV_WIDTH ** -0.5),
        'conv_b': nrm(ks[17], (L, LRU_WIDTH), 0.02),
        'lru_wa': nrm(ks[18], (L, LRU_BLOCKS, LRU_BLOCK_DIM, LRU_BLOCK_DIM), LRU_BLOCK_DIM ** -0.5),
        'lru_ba': nrm(ks[19], (L, LRU_WIDTH), 0.02),
        'lru_wx': nrm(ks[20], (L, LRU_BLOCKS, LRU_BLOCK_DIM, LRU_BLOCK_DIM), LRU_BLOCK_DIM ** -0.5),
        'lru_bx': nrm(ks[21], (L, LRU_WIDTH), 0.02),
        'lru_lambda': jnp.log(s) - jnp.log1p(-s),
        'proj_b': nrm(ks[23], (L, LRU_WIDTH, D_MODEL), LRU_WIDTH ** -0.5),
        'q_norm_g': 1.0 + nrm(ks[24], (L, ATTN_HEAD_DIM), 0.02),
        'k_norm_g': 1.0 + nrm(ks[25], (L, ATTN_HEAD_DIM), 0.02),
        'proj_c': nrm(ks[26], (L, ATTN_OUT_WIDTH, D_MODEL), ATTN_OUT_WIDTH ** -0.5),
        'w_out': nrm(ks[27], (L, D_MODEL, D_MODEL), D_MODEL ** -0.5),
        'norm_mlp_g': 1.0 + nrm(ks[28], (L, D_MODEL), 0.02),
        'mlp_up': nrm(ks[29], (L, D_MODEL, D_FF), D_MODEL ** -0.5),
        'mlp_down': nrm(ks[30], (L, D_FF, D_MODEL), D_FF ** -0.5),
    }


def reference(x, rel_bias, norm_mix_g, w_in, rwkv_mu, rwkv_w0, rwkv_w_up, rwkv_a0, rwkv_a_up,
              rwkv_g_up, rwkv_k_k, rwkv_k_a, rwkv_r_k, rwkv_ln_g, rwkv_ln_b, proj_a, conv_w, conv_b,
              lru_wa, lru_ba, lru_wx, lru_bx, lru_lambda, proj_b, q_norm_g, k_norm_g, proj_c, w_out,
              norm_mlp_g, mlp_up, mlp_down):
    dt = x.dtype
    bsz, seq, _ = x.shape
    for l in range(DEPTH):
        h = rms_norm(x, norm_mix_g[l])
        z_a, z_bx, z_by, z_q, z_k, z_v, z_g = split_cols(h @ w_in[l], IN_SIZES)
        y_a = rwkv7_mixer(z_a, rwkv_mu[l], rwkv_w0[l], rwkv_w_up[l], rwkv_a0[l], rwkv_a_up[l],
                          rwkv_g_up[l], rwkv_k_k[l], rwkv_k_a[l], rwkv_r_k[l], rwkv_ln_g[l],
                          rwkv_ln_b[l]).astype(dt) @ proj_a[l]
        y_b = rglru_mixer(z_bx, z_by, conv_w[l], conv_b[l], lru_wa[l], lru_ba[l], lru_wx[l],
                          lru_bx[l], lru_lambda[l]).astype(dt) @ proj_b[l]
        y_c = dilated_attention_mixer(z_q, z_k, z_v, q_norm_g[l], k_norm_g[l],
                                      rel_bias).astype(dt) @ proj_c[l]
        gates = jax.nn.sigmoid(z_g.reshape(bsz, seq, N_BRANCHES, D_MODEL))
        merged = gates[:, :, 0] * y_a + gates[:, :, 1] * y_b + gates[:, :, 2] * y_c
        x = x + merged @ w_out[l]
        u = rms_norm(x, norm_mlp_g[l]) @ mlp_up[l]
        x = x + jnp.square(jax.nn.relu(u)) @ mlp_down[l]
    return x
```

```cpp
#include <hip/hip_runtime.h>
#include <cstdio>
#include <cstdint>

#ifndef MK_ONE_LAUNCH
#define MK_ONE_LAUNCH 0
#endif

constexpr int BATCH = 2, SEQ = 8192, D = 1024, M = BATCH * SEQ, DEPTH = 2;
constexpr int DIN = 8224, FF = 4096;
constexpr int NMIX = 5152;
constexpr int NGATE = 3072;
constexpr float RMS_EPS = 1e-6f, GN_EPS = 64e-5f;
constexpr int NWAVES = 8, NTHR = 512;

constexpr size_t MiB = 1u << 20;
constexpr size_t WS_CTL = 0, CTL_ZERO_BYTES = 1 * MiB;
constexpr size_t WS_XB = 1 * MiB;
constexpr size_t WS_Z = 33 * MiB;
constexpr size_t Z_R = WS_Z + 0 * MiB, Z_K = WS_Z + 16 * MiB, Z_V = WS_Z + 32 * MiB, Z_L = WS_Z + 48 * MiB  , Z_BX = WS_Z + 57 * MiB;
constexpr size_t A_K = WS_Z + 73 * MiB, A_V = WS_Z + 97 * MiB, Z_BY = WS_Z + 121 * MiB, A_Q = WS_Z + 137 * MiB;
constexpr size_t WS_GATES = WS_Z;
constexpr size_t WS_H2 = WS_Z;
constexpr size_t WS_HID = WS_Z + 32 * MiB;
constexpr size_t WS_OA = 194 * MiB;
constexpr size_t WS_OC = 210 * MiB;
constexpr size_t WS_LSE = 239 * MiB;
constexpr size_t WS_END = 255 * MiB;
static_assert(WS_HID + (size_t)M * FF * 2 <= WS_OA && A_Q + (size_t)M * 768 * 2 <= WS_OA && WS_GATES + (size_t)M * NGATE * 2 <= Z_BY, "ws map");

#define GAS __attribute__((address_space(1)))
#define LAS __attribute__((address_space(3)))
typedef unsigned short bf16;
typedef GAS unsigned gu32;
#define RLX_AGENT __ATOMIC_RELAXED, __HIP_MEMORY_SCOPE_AGENT
__device__ __forceinline__ unsigned f2bf(float f) { unsigned u = __builtin_bit_cast(unsigned, f); return (u + 0x7fffu + ((u >> 16) & 1u)) >> 16; }
__device__ __forceinline__ float bf2f(unsigned h) { return __builtin_bit_cast(float, h << 16); }
__device__ __forceinline__ float wave_sum(float v) {
#pragma unroll
    for (int o = 1; o < 64; o <<= 1) v += __shfl_xor(v, o);
    return v;
}
template <class T> __device__ __forceinline__ T* launder(T* p) { asm volatile("" : "+s"(p)); return p; }
__device__ __forceinline__ float sigmoidf_(float x) { return 1.f / (1.f + __expf(-x)); }
__device__ __forceinline__ float softplusf_(float x) { return x > 20.f ? x : log1pf(expf(x)); }

#define XB_TMO      128
#define XB_XCNT(j)  (256  + 64 * (j))
#define XB_XSUB(j)  (1280 + 64 * (j))
#define XB_XGEN(j)  (2304 + 64 * (j))
#define XB_TOP      3328
#define XB_TOPGEN   3392
#define XCD_BAR_WORDS 3456
#define XB_SPIN_CAP (1u << 22)
constexpr int CW_BAR = 4096;
__device__ __forceinline__ unsigned xb_ld(unsigned* p)              { return __hip_atomic_load(p, __ATOMIC_RELAXED, __HIP_MEMORY_SCOPE_AGENT); }
__device__ __forceinline__ unsigned xb_add(unsigned* p, unsigned v) { return __hip_atomic_fetch_add(p, v, __ATOMIC_RELAXED, __HIP_MEMORY_SCOPE_AGENT); }
__device__ __forceinline__ unsigned xb_xcc_id() { return (unsigned)__builtin_amdgcn_s_getreg((3 << 11) | 20) & 0xFu; }
#define XB_SPIN(cond, bar) do { unsigned _sp = 0; while (cond) { __builtin_amdgcn_s_sleep(1); \
    if ((++_sp & 255u) == 0u) { if (xb_ld(&(bar)[XB_TMO])) break; if (_sp > XB_SPIN_CAP) { atomicAdd(&(bar)[XB_TMO], 1u); break; } } } } while (0)
struct XcdBarrier { unsigned* bar; unsigned x; volatile LAS unsigned* st; };
__device__ __forceinline__ XcdBarrier xcd_barrier_post(unsigned* bar, volatile LAS unsigned* st) {
    XcdBarrier b; b.bar = bar; b.x = xb_xcc_id(); b.st = st;
    if (threadIdx.x == 0) (void)xb_add(&bar[XB_XCNT(b.x)], 1u);
    return b;
}
__device__ __forceinline__ void xcd_barrier_complete(unsigned* bar, unsigned x, unsigned& nloc, unsigned& nx) {
    const unsigned G = gridDim.x * gridDim.y * gridDim.z;
    unsigned sum, cnt, mine, sp = 0u;
    for (;;) {
        sum = 0u; cnt = 0u; mine = 0u;
#pragma unroll
        for (unsigned j = 0; j < 16; ++j) { const unsigned c = xb_ld(&bar[XB_XCNT(j)]); sum += c; cnt += (c > 0u) ? 1u : 0u; mine = (j == x) ? c : mine; }
        if (sum == G) break;
        __builtin_amdgcn_s_sleep(1);
        if ((++sp & 255u) == 0u) { if (xb_ld(&bar[XB_TMO])) break; if (sp > XB_SPIN_CAP) { atomicAdd(&bar[XB_TMO], 1u); break; } }
    }
    nloc = mine > 0u ? mine : 1u; nx = cnt > 0u ? cnt : 1u;
}
__device__ __forceinline__ void xcd_barrier(const XcdBarrier& b) {
    asm volatile("s_waitcnt vmcnt(0)" ::: "memory");
    __syncthreads();
    if (threadIdx.x == 0) {
        unsigned* bar = b.bar;
        __builtin_amdgcn_s_waitcnt(0);
        unsigned nloc = b.st[0], nx = b.st[1];
        if (nloc == 0u) { xcd_barrier_complete(bar, b.x, nloc, nx); b.st[0] = nloc; b.st[1] = nx; }
        const unsigned old = xb_add(&bar[XB_XSUB(b.x)], 1u);
        const unsigned gen = old / nloc;
        if (old + 1u == (gen + 1u) * nloc) {
            __builtin_amdgcn_fence(__ATOMIC_RELEASE, "agent");
            asm volatile("s_waitcnt vmcnt(0)" ::: "memory");
            const unsigned og = xb_add(&bar[XB_TOP], 1u);
            const unsigned tg = og / nx;
            if (og + 1u == (tg + 1u) * nx) xb_add(&bar[XB_TOPGEN], 1u);
            else XB_SPIN(xb_ld(&bar[XB_TOPGEN]) == tg, bar);
            __builtin_amdgcn_fence(__ATOMIC_ACQUIRE, "agent");
            xb_add(&bar[XB_XGEN(b.x)], 1u);
            asm volatile("s_waitcnt vmcnt(0)" ::: "memory");
        } else {
            XB_SPIN(xb_ld(&bar[XB_XGEN(b.x)]) == gen, bar);
            __builtin_amdgcn_fence(__ATOMIC_ACQUIRE, "agent");
            asm volatile("s_waitcnt vmcnt(0)" ::: "memory");
        }
    }
    __syncthreads();
}

struct Args { const float* in[31]; float* out; unsigned char* ws; int ph_lo, ph_hi; };
enum { I_X = 0, I_RELB, I_NG1, I_WIN, I_MU, I_W0, I_WUP, I_A0, I_AUP, I_GUP, I_KK, I_KA, I_RK, I_LNG, I_LNB, I_PA, I_CW, I_CB, I_LWA, I_LBA, I_LWX, I_LBX, I_LAM, I_PB,
       I_QG, I_KG, I_PC, I_WOUT, I_NG2, I_UP, I_DOWN };

struct Frame {
    LAS unsigned char* lds;
    int tid, lane, wave, vcu, G;
};

__device__ __forceinline__ void phase_rms(Frame& F, const float* x, const float* g, bf16* out) {
    const int gw = F.vcu * NWAVES + F.wave, NGW = F.G * NWAVES;
    typedef float f32x4 __attribute__((ext_vector_type(4)));
    for (int m = gw; m < M; m += NGW) {
        const f32x4* xr = (const f32x4*)(x + (size_t)m * D) + F.lane;
        f32x4 v[4]; float s = 0.f;
#pragma unroll
        for (int j = 0; j < 4; ++j) { v[j] = xr[64 * j]; s += (v[j].x * v[j].x + v[j].y * v[j].y) + (v[j].z * v[j].z + v[j].w * v[j].w); }
        const float rstd = 1.f / sqrtf(wave_sum(s) * (1.f / D) + RMS_EPS);
        unsigned long long* o8 = (unsigned long long*)(out + (size_t)m * D) + F.lane;
#pragma unroll
        for (int j = 0; j < 4; ++j) {
            const f32x4 gg = *((const f32x4*)g + F.lane + 64 * j);
            const unsigned lo = f2bf(v[j].x * rstd * gg.x) | (f2bf(v[j].y * rstd * gg.y) << 16), hi = f2bf(v[j].z * rstd * gg.z) | (f2bf(v[j].w * rstd * gg.w) << 16);
            o8[64 * j] = (unsigned long long)lo | ((unsigned long long)hi << 32);
        }
    }
}

__device__ __forceinline__ void gemm_tile_acc(LAS float* lds, const bf16* A, int lda, const float* W, int ldw, int N, int K, int tm, int tn, float (&acc)[8][4]) {
    const int tid = threadIdx.x, tx = tid & 31, ty = tid >> 5;
    LAS float* As = lds; LAS float* Bs = lds + 16 * 132;
    const int arow = tid >> 2, akq = (tid & 3) * 4, bk = tid >> 5, bn = (tid & 31) * 4;
    for (int k0 = 0; k0 < K; k0 += 16) {
        const unsigned long long av = *(const unsigned long long*)(A + (size_t)(tm * 128 + arow) * lda + k0 + akq);
#pragma unroll
        for (int e = 0; e < 4; ++e) As[(akq + e) * 132 + arow] = bf2f((unsigned)(av >> (16 * e)) & 0xffffu);
        const int n0 = tn * 128 + bn;
        const float* wp = W + (size_t)(k0 + bk) * ldw + n0;
#pragma unroll
        for (int e = 0; e < 4; ++e) Bs[bk * 132 + bn + e] = (n0 + e < N) ? wp[e] : 0.f;
        __syncthreads();
#pragma unroll 2
        for (int kk = 0; kk < 16; ++kk) {
            float a[8], b[4];
#pragma unroll
            for (int i = 0; i < 8; ++i) a[i] = As[kk * 132 + ty * 8 + i];
#pragma unroll
            for (int j = 0; j < 4; ++j) b[j] = Bs[kk * 132 + tx * 4 + j];
#pragma unroll
            for (int i = 0; i < 8; ++i)
#pragma unroll
                for (int j = 0; j < 4; ++j) acc[i][j] += a[i] * b[j];
        }
        __syncthreads();
    }
}
template <class Epi>
__device__ __forceinline__ void gemm_naive(Frame& F, const bf16* A, int lda, const float* W, int ldw, int N, int K, const Epi& epi) {
    const int tx = F.tid & 31, ty = F.tid >> 5;
    const int ntm = M / 128, ntn = (N + 127) / 128;
    for (int tile = F.vcu; tile < ntm * ntn; tile += F.G) {
        const int tm = tile / ntn, tn = tile % ntn;
        float acc[8][4];
#pragma unroll
        for (int i = 0; i < 8; ++i)
#pragma unroll
            for (int j = 0; j < 4; ++j) acc[i][j] = 0.f;
        gemm_tile_acc((LAS float*)F.lds, A, lda, W, ldw, N, K, tm, tn, acc);
#pragma unroll
        for (int i = 0; i < 8; ++i)
#pragma unroll
            for (int j = 0; j < 4; ++j) { const int m = tm * 128 + ty * 8 + i, n = tn * 128 + tx * 4 + j; if (n < N) epi(m, n, acc[i][j]); }
    }
}

struct EpiMix {
    unsigned char* ws;
    __device__ __forceinline__ void operator()(int m, int n, float v) const {
        bf16* p;
        if (n < 512) p = (bf16*)(ws + Z_R) + (size_t)m * 512 + n;
        else if (n < 1024) p = (bf16*)(ws + Z_K) + (size_t)m * 512 + (n - 512);
        else if (n < 1536) p = (bf16*)(ws + Z_V) + (size_t)m * 512 + (n - 1024);
        else if (n < 1824) p = (bf16*)(ws + Z_L) + (size_t)m * 288 + (n - 1536);
        else if (n < 2336) p = (bf16*)(ws + Z_BX) + (size_t)m * 512 + (n - 1824);
        else if (n < 2848) p = (bf16*)(ws + Z_BY) + (size_t)m * 512 + (n - 2336);
        else if (n < 3616) p = (bf16*)(ws + A_Q) + (size_t)m * 768 + (n - 2848);
        else if (n < 4384) p = (bf16*)(ws + A_K) + (size_t)m * 768 + (n - 3616);
        else p = (bf16*)(ws + A_V) + (size_t)m * 768 + (n - 4384);
        *p = (bf16)f2bf(v);
    }
};
struct EpiGate { bf16* o; __device__ __forceinline__ void operator()(int m, int n, float v) const { o[(size_t)m * NGATE + n] = (bf16)f2bf(sigmoidf_(v)); } };
struct EpiBf { bf16* o; int ld; __device__ __forceinline__ void operator()(int m, int n, float v) const { o[(size_t)m * ld + n] = (bf16)f2bf(v); } };
struct EpiRelu2 { bf16* o; int ld; __device__ __forceinline__ void operator()(int m, int n, float v) const { const float r = v > 0.f ? v : 0.f; o[(size_t)m * ld + n] = (bf16)f2bf(r * r); } };
struct EpiRes { const float* base; float* o; __device__ __forceinline__ void operator()(int m, int n, float v) const { o[(size_t)m * D + n] = base[(size_t)m * D + n] + v; } };

__device__ __forceinline__ void phase_merge_naive(Frame& F, const bf16* OA, const bf16* OB, const bf16* OC, const float* pa, const float* pb, const float* pc, const bf16* gates, bf16* out) {
    const int tx = F.tid & 31, ty = F.tid >> 5;
    const int ntm = M / 128, ntn = D / 128;
    for (int tile = F.vcu; tile < ntm * ntn; tile += F.G) {
        const int tm = tile / ntn, tn = tile % ntn;
        float tot[8][4];
#pragma unroll
        for (int i = 0; i < 8; ++i)
#pragma unroll
            for (int j = 0; j < 4; ++j) tot[i][j] = 0.f;
#pragma unroll 1
        for (int br = 0; br < 3; ++br) {
            float acc[8][4];
#pragma unroll
            for (int i = 0; i < 8; ++i)
#pragma unroll
                for (int j = 0; j < 4; ++j) acc[i][j] = 0.f;
            const bf16* A = br == 0 ? OA : (br == 1 ? OB : OC); const int lda = br == 2 ? 256 : 512; const float* W = br == 0 ? pa : (br == 1 ? pb : pc);
            gemm_tile_acc((LAS float*)F.lds, A, lda, W, D, D, lda, tm, tn, acc);
#pragma unroll
            for (int i = 0; i < 8; ++i)
#pragma unroll
                for (int j = 0; j < 4; ++j) { const int m = tm * 128 + ty * 8 + i, n = tn * 128 + tx * 4 + j; tot[i][j] += bf2f(gates[(size_t)m * NGATE + br * D + n]) * acc[i][j]; }
        }
#pragma unroll
        for (int i = 0; i < 8; ++i)
#pragma unroll
            for (int j = 0; j < 4; ++j) { const int m = tm * 128 + ty * 8 + i, n = tn * 128 + tx * 4 + j; out[(size_t)m * D + n] = (bf16)f2bf(tot[i][j]); }
    }
}

struct RwkvP { const float *mu, *w0, *w_up, *a0, *a_up, *g_up, *k_k, *k_a, *r_k, *ln_g, *ln_b; };
__device__ __forceinline__ void rwkv_naive_item(Frame& F, unsigned char* ws, const RwkvP& P, int b, int h) {
    LAS float* L = (LAS float*)F.lds;
    LAS float* Lr = L;
    LAS float* Lk = L + 1024;
    LAS float* Lv = L + 2048;
    LAS float* Ltw = L + 3072;
    LAS float* Lxa = L + 4096;
    LAS float* Lsg = L + 5120;
    LAS float* Lw = L + 7680;
    LAS float* La = L + 8704;
    LAS float* Lg = L + 9728;
    LAS float* Lan = L + 10752;
    LAS float* Lb = L + 11776;
    LAS float* Lbo = L + 12800;
    const bf16* ZR = (const bf16*)(ws + Z_R); const bf16* ZK = (const bf16*)(ws + Z_K); const bf16* ZV = (const bf16*)(ws + Z_V); const bf16* ZL = (const bf16*)(ws + Z_L);
    bf16* OA = (bf16*)(ws + WS_OA);
    const int tid = F.tid, lane = F.lane, wave = F.wave;
    typedef float f32x4s __attribute__((ext_vector_type(4)));
    LAS f32x4s* Ls = (LAS f32x4s*)(L + 13312);
    if (wave == 0) {
#pragma unroll
        for (int j4 = 0; j4 < 16; ++j4) Ls[j4 * 64 + lane] = (f32x4s){0.f, 0.f, 0.f, 0.f};
    }
#pragma unroll 1
    for (int blk = 0; blk < SEQ / 16; ++blk) {
        const int t0 = blk * 16;
#pragma unroll 1
        for (int idx = tid; idx < 16 * 480; idx += NTHR) {
            const int tt = idx / 480, c = idx % 480; const int t = t0 + tt; const size_t m = (size_t)b * SEQ + t;
            float cur, prev = 0.f, mu;
            if (c < 192) { const int which = c / 64, j = c % 64, col = h * 64 + j; const bf16* Zp = which == 0 ? ZR : (which == 1 ? ZK : ZV);
                cur = bf2f(Zp[m * 512 + col]); if (t > 0) prev = bf2f(Zp[(m - 1) * 512 + col]); mu = P.mu[which * 512 + col];
                const float f = cur + (prev - cur) * mu; (which == 0 ? Lr : (which == 1 ? Lk : Lv))[tt * 64 + j] = f;
            } else { const int cc = c - 192;
                cur = bf2f(ZL[m * 288 + cc]); if (t > 0) prev = bf2f(ZL[(m - 1) * 288 + cc]); mu = P.mu[1536 + cc];
                const float f = cur + (prev - cur) * mu;
                if (cc < 64) Ltw[tt * 64 + cc] = tanhf(f); else if (cc < 128) Lxa[tt * 64 + cc - 64] = f; else Lsg[tt * 160 + cc - 128] = sigmoidf_(f);
            }
        }
        __syncthreads();
#pragma unroll 1
        for (int idx = tid; idx < 1024; idx += NTHR) {
            const int tt = idx >> 6, j = idx & 63, col = h * 64 + j;
            float wl = P.w0[col], al = P.a0[col], gg = 0.f;
#pragma unroll 4
            for (int c = 0; c < 64; ++c) { wl += Ltw[tt * 64 + c] * P.w_up[c * 512 + col]; al += Lxa[tt * 64 + c] * P.a_up[c * 512 + col]; }
#pragma unroll 4
            for (int c = 0; c < 160; ++c) gg += Lsg[tt * 160 + c] * P.g_up[c * 512 + col];
            const float w = -softplusf_(-wl) - 0.5f;
            Lw[idx] = expf(-expf(w)); La[idx] = sigmoidf_(al); Lg[idx] = gg;
        }
        __syncthreads();
#pragma unroll
        for (int q = 0; q < 2; ++q) {
            const int tt = 2 * wave + q, col = h * 64 + lane;
            const float kraw = Lk[tt * 64 + lane], kkv = kraw * P.k_k[col];
            const float n2 = wave_sum(kkv * kkv); const float kkn = kkv / fmaxf(sqrtf(n2), 1e-12f);
            const float a = La[tt * 64 + lane]; const float kmod = kraw * (1.f + (a - 1.f) * P.k_a[col]);
            const float bo = wave_sum(Lr[tt * 64 + lane] * kmod * P.r_k[col]);
            Lk[tt * 64 + lane] = kmod; Lan[tt * 64 + lane] = -kkn; Lb[tt * 64 + lane] = kkn * a;
            if (lane == 0) Lbo[tt] = bo;
        }
        __syncthreads();
        if (wave == 0) {
            const int col = h * 64 + lane; const float lng = P.ln_g[col], lnb = P.ln_b[col];
            float S[64];
#pragma unroll
            for (int j4 = 0; j4 < 16; ++j4) { const f32x4s s4 = Ls[j4 * 64 + lane]; S[4 * j4] = s4.x; S[4 * j4 + 1] = s4.y; S[4 * j4 + 2] = s4.z; S[4 * j4 + 3] = s4.w; }
#pragma unroll 1
            for (int tt = 0; tt < 16; ++tt) {
                typedef float f32x4 __attribute__((ext_vector_type(4)));
                float sa = 0.f;
#pragma unroll
                for (int j4 = 0; j4 < 16; ++j4) { const f32x4 an = *(const LAS f32x4*)(Lan + tt * 64 + 4 * j4);
                    sa += S[4 * j4] * an.x + S[4 * j4 + 1] * an.y + S[4 * j4 + 2] * an.z + S[4 * j4 + 3] * an.w; __builtin_amdgcn_sched_barrier(0); }
                const float vi = Lv[tt * 64 + lane]; float y = 0.f;
#pragma unroll
                for (int j4 = 0; j4 < 16; ++j4) {
                    const f32x4 w4 = *(const LAS f32x4*)(Lw + tt * 64 + 4 * j4), b4 = *(const LAS f32x4*)(Lb + tt * 64 + 4 * j4), k4 = *(const LAS f32x4*)(Lk + tt * 64 + 4 * j4), r4 = *(const LAS f32x4*)(Lr + tt * 64 + 4 * j4);
                    S[4 * j4] = S[4 * j4] * w4.x + sa * b4.x + vi * k4.x; S[4 * j4 + 1] = S[4 * j4 + 1] * w4.y + sa * b4.y + vi * k4.y;
                    S[4 * j4 + 2] = S[4 * j4 + 2] * w4.z + sa * b4.z + vi * k4.z; S[4 * j4 + 3] = S[4 * j4 + 3] * w4.w + sa * b4.w + vi * k4.w;
                    y += S[4 * j4] * r4.x + S[4 * j4 + 1] * r4.y + S[4 * j4 + 2] * r4.z + S[4 * j4 + 3] * r4.w; __builtin_amdgcn_sched_barrier(0); }
                const float mean = wave_sum(y) * (1.f / 64.f); const float dy = y - mean; const float var = wave_sum(dy * dy) * (1.f / 64.f);
                const float o = (dy * (1.f / sqrtf(var + GN_EPS)) * lng + lnb + Lbo[tt] * vi) * Lg[tt * 64 + lane];
                OA[((size_t)b * SEQ + t0 + tt) * 512 + col] = (bf16)f2bf(o);
            }
#pragma unroll
            for (int j4 = 0; j4 < 16; ++j4) Ls[j4 * 64 + lane] = (f32x4s){S[4 * j4], S[4 * j4 + 1], S[4 * j4 + 2], S[4 * j4 + 3]};
        }
        __syncthreads();
    }
}

struct LruP { const float *cw, *cb, *wa, *ba, *wx, *bx, *lam; };
__device__ __forceinline__ float gelu_tanh_(float x) { const float u = 0.7978845608028654f * (x + 0.044715f * x * x * x); return 0.5f * x * (1.f + tanhf(u)); }
__device__ __forceinline__ void lru_naive_item(Frame& F, unsigned char* ws, const LruP& P, int b, int blk) {
    LAS float* L = (LAS float*)F.lds;
    LAS float* Lxc = L;
    LAS float* Lwa = L + 4096;
    LAS float* Lwx = L + 8192;
    LAS float* Laa = L + 12288;
    LAS float* Lbb = L + 16384;
    const bf16* ZBX = (const bf16*)(ws + Z_BX); bf16* ZBY = (bf16*)(ws + Z_BY);
    const int tid = F.tid;
    for (int idx = tid; idx < 4096; idx += NTHR) { Lwa[idx] = P.wa[blk * 4096 + idx]; Lwx[idx] = P.wx[blk * 4096 + idx]; }
    float hcar = 0.f;
    for (int tile = 0; tile < SEQ / 64; ++tile) {
        const int t0 = tile * 64;
        __syncthreads();
        for (int idx = tid; idx < 4096; idx += NTHR) {
            const int tt = idx >> 6, c = idx & 63, ch = blk * 64 + c, t = t0 + tt;
            float s = P.cb[ch];
#pragma unroll
            for (int i = 0; i < 4; ++i) { const int ts = t - 3 + i; if (ts >= 0) s += P.cw[i * 512 + ch] * bf2f(ZBX[((size_t)b * SEQ + ts) * 512 + ch]); }
            Lxc[idx] = s;
        }
        __syncthreads();
        for (int idx = tid; idx < 4096; idx += NTHR) {
            const int tt = idx >> 6, j = idx & 63, ch = blk * 64 + j;
            float sa = P.ba[ch], sx = P.bx[ch];
            for (int i = 0; i < 64; ++i) { const float xv = Lxc[tt * 64 + i]; sa += xv * Lwa[i * 64 + j]; sx += xv * Lwx[i * 64 + j]; }
            const float ga = sigmoidf_(sa), gx = sigmoidf_(sx);
            const float log_a = -8.0f * ga * softplusf_(-P.lam[ch]);
            const float a = expf(log_a); float mult = sqrtf(fmaxf(-expm1f(2.f * log_a), 0.f));
            if (t0 + tt == 0) mult = 1.f;
            Laa[idx] = a; Lbb[idx] = Lxc[idx] * gx * mult;
        }
        __syncthreads();
        if (tid < 64) {
            const int ch = blk * 64 + tid;
            for (int tt = 0; tt < 64; ++tt) {
                hcar = Laa[tt * 64 + tid] * hcar + Lbb[tt * 64 + tid];
                const size_t off = ((size_t)b * SEQ + t0 + tt) * 512 + ch;
                ZBY[off] = (bf16)f2bf(hcar * gelu_tanh_(bf2f(ZBY[off])));
            }
        }
    }
    __syncthreads();
}

__device__ __forceinline__ int t5_bucket(int d) {
    if (d < 16) return d;
    int v = 16 + (int)(logf((float)d / 16.f) / logf(128.f) * 16.f);
    return v > 31 ? 31 : v;
}
__device__ __forceinline__ void attn_naive(Frame& F, unsigned char* ws, const float* relb, const float* qg, const float* kg, int worker, int nworkers) {
    LAS float* Lbias = (LAS float*)F.lds;
    for (int idx = F.tid; idx < 12 * 129; idx += NTHR) { const int hd = idx / 129, rel = idx % 129, g = hd >> 2; const int dil = g == 0 ? 1 : (g == 1 ? 4 : 16);
        Lbias[idx] = relb[t5_bucket(rel * dil) * 12 + hd]; }
    __syncthreads();
    bf16* AQ = (bf16*)(ws + A_Q); const bf16* AK = (const bf16*)(ws + A_K); const bf16* AV = (const bf16*)(ws + A_V); float* LSE = (float*)(ws + WS_LSE);
    for (long it2 = (long)worker * NTHR + F.tid; it2 < (long)M * 24; it2 += (long)nworkers * NTHR) {
        const long it = it2 >> 1; const int half = (int)(it2 & 1);
        const int m = (int)(it / 12), hd = (int)(it % 12), g = hd >> 2; const int dil = g == 0 ? 1 : (g == 1 ? 4 : 16);
        const int t = m % SEQ;
        float q[32]; float s2 = 0.f;
        const unsigned* qp = (const unsigned*)(AQ + (size_t)m * 768 + hd * 64 + half * 32);
#pragma unroll
        for (int j = 0; j < 16; ++j) { const unsigned u = qp[j]; q[2 * j] = bf2f(u & 0xffffu); q[2 * j + 1] = bf2f(u >> 16); s2 += q[2 * j] * q[2 * j] + q[2 * j + 1] * q[2 * j + 1]; }
        s2 += __shfl_xor(s2, 1);
        const float qs = (1.f / sqrtf(s2 * (1.f / 64.f) + RMS_EPS)) * 0.125f;
#pragma unroll
        for (int j = 0; j < 32; ++j) q[j] = q[j] * qs * qg[half * 32 + j] * kg[half * 32 + j];
        float o[32];
#pragma unroll
        for (int j = 0; j < 32; ++j) o[j] = 0.f;
        float mx = -1e30f, l = 0.f;
        for (int rel = 0; rel <= 128; ++rel) {
            const int tk = t - rel * dil; if (tk < 0) break;
            const size_t mk = (size_t)(m - rel * dil);
            const unsigned* kp = (const unsigned*)(AK + mk * 768 + hd * 64 + half * 32);
            float dot = 0.f, k2 = 0.f;
#pragma unroll
            for (int j = 0; j < 16; ++j) { const unsigned u = kp[j]; const float k0 = bf2f(u & 0xffffu), k1 = bf2f(u >> 16); dot += q[2 * j] * k0 + q[2 * j + 1] * k1; k2 += k0 * k0 + k1 * k1; }
            dot += __shfl_xor(dot, 1); k2 += __shfl_xor(k2, 1);
            const float logit = dot * (1.f / sqrtf(k2 * (1.f / 64.f) + RMS_EPS)) + Lbias[hd * 129 + rel];
            const float mn = fmaxf(mx, logit); const float sc = __expf(mx - mn), p = __expf(logit - mn);
            l = l * sc + p; mx = mn;
            const unsigned* vp = (const unsigned*)(AV + mk * 768 + hd * 64 + half * 32);
#pragma unroll
            for (int j = 0; j < 16; ++j) { const unsigned u = vp[j]; o[2 * j] = o[2 * j] * sc + p * bf2f(u & 0xffffu); o[2 * j + 1] = o[2 * j + 1] * sc + p * bf2f(u >> 16); }
        }
        const float il = 1.f / l;
        unsigned* op = (unsigned*)(AQ + (size_t)m * 768 + hd * 64 + half * 32);
#pragma unroll
        for (int j = 0; j < 16; ++j) op[j] = f2bf(o[2 * j] * il) | (f2bf(o[2 * j + 1] * il) << 16);
        if (half == 0) LSE[(size_t)m * 12 + hd] = mx + logf(l);
    }
}
__device__ __forceinline__ void phase_combine(Frame& F, unsigned char* ws) {
    const bf16* AQ = (const bf16*)(ws + A_Q); const float* LSE = (const float*)(ws + WS_LSE); bf16* OC = (bf16*)(ws + WS_OC);
    for (long it = (long)F.vcu * NTHR + F.tid; it < (long)M * 256; it += (long)F.G * NTHR) {
        const int m = (int)(it >> 8), c = (int)(it & 255), hh = c >> 6, d = c & 63;
        const float l0 = LSE[(size_t)m * 12 + hh], l1 = LSE[(size_t)m * 12 + 4 + hh], l2 = LSE[(size_t)m * 12 + 8 + hh];
        const float mx = fmaxf(l0, fmaxf(l1, l2)); const float e0 = __expf(l0 - mx), e1 = __expf(l1 - mx), e2 = __expf(l2 - mx); const float inv = 1.f / (e0 + e1 + e2);
        const float v = (e0 * bf2f(AQ[(size_t)m * 768 + hh * 64 + d]) + e1 * bf2f(AQ[(size_t)m * 768 + (4 + hh) * 64 + d]) + e2 * bf2f(AQ[(size_t)m * 768 + (8 + hh) * 64 + d])) * inv;
        OC[(size_t)m * 256 + c] = (bf16)f2bf(v);
    }
}

constexpr int LDS_BYTES = 147456, MISC_OFF = 131072 + 320;
constexpr int PH_PER_LAYER = 10, NPHASES = DEPTH * PH_PER_LAYER;

template <int PH>
__global__ void __launch_bounds__(NTHR, 2) fwd_kernel(Args args) {
    extern __shared__ __attribute__((aligned(16))) unsigned char lds[];
    Frame F;
    F.lds = (LAS unsigned char*)lds;
    F.tid = threadIdx.x; F.lane = F.tid & 63; F.wave = __builtin_amdgcn_readfirstlane(F.tid >> 6);
    F.G = gridDim.x; { const int bx = blockIdx.x; F.vcu = (F.G % 8 == 0) ? (bx % 8) * (F.G / 8) + bx / 8 : bx; }
    unsigned char* ws = args.ws;
    volatile LAS unsigned* MISC = (volatile LAS unsigned*)(F.lds + MISC_OFF);
    for (int u = F.tid; u < (LDS_BYTES - 131072) / 4; u += NTHR) ((LAS unsigned*)(F.lds + 131072))[u] = 0u;
    __syncthreads();
    XcdBarrier bar; bar.bar = (unsigned*)(ws + WS_CTL) + CW_BAR; bar.x = 0; bar.st = nullptr;
    if (MK_ONE_LAUNCH) bar = xcd_barrier_post((unsigned*)(ws + WS_CTL) + CW_BAR, MISC + 8);
    const int lo = args.ph_lo, hi = args.ph_hi;
#define IN(k) ((PH < 0 || PH == ((k) % PH_PER_LAYER)) && lo <= (k) && (k) < hi)
#define SEAM(k) do { if (MK_ONE_LAUNCH && IN(k) && IN((k) + 1)) xcd_barrier(bar); } while (0)

#pragma unroll 1
    for (int l = 0; l < DEPTH; ++l) {
        const int pb = l * PH_PER_LAYER;
        const float* xin = (l == 0) ? args.in[I_X] : args.out;
        const float* w_in = args.in[I_WIN] + (size_t)l * D * DIN;
        if constexpr (PH < 0 || PH == 0) if (IN(pb + 0)) { unsigned char* ws = launder(args.ws); const float* xin_ = launder(xin); phase_rms(F, xin_, args.in[I_NG1] + l * D, (bf16*)(ws + WS_XB)); } SEAM(pb + 0);
        if constexpr (PH < 0 || PH == 1) if (IN(pb + 1)) { unsigned char* ws = launder(args.ws); float* outp = launder(args.out); (void)outp; EpiMix E{ws}; gemm_naive(F, (const bf16*)(ws + WS_XB), D, w_in, DIN, NMIX, D, E); } SEAM(pb + 1);
        if constexpr (PH < 0 || PH == 2) if (IN(pb + 2)) { unsigned char* ws = launder(args.ws); float* outp = launder(args.out); (void)outp;
            if (F.vcu < 16) {
                RwkvP P{args.in[I_MU] + l * 1824, args.in[I_W0] + l * 512, args.in[I_WUP] + l * 64 * 512, args.in[I_A0] + l * 512, args.in[I_AUP] + l * 64 * 512, args.in[I_GUP] + l * 160 * 512,
                        args.in[I_KK] + l * 512, args.in[I_KA] + l * 512, args.in[I_RK] + l * 512, args.in[I_LNG] + l * 512, args.in[I_LNB] + l * 512};
                rwkv_naive_item(F, ws, P, F.vcu >> 3, F.vcu & 7);
            } else if (F.vcu < 32) {
                LruP P{args.in[I_CW] + l * 4 * 512, args.in[I_CB] + l * 512, args.in[I_LWA] + l * 8 * 4096, args.in[I_LBA] + l * 512, args.in[I_LWX] + l * 8 * 4096, args.in[I_LBX] + l * 512, args.in[I_LAM] + l * 512};
                const int it = F.vcu - 16; lru_naive_item(F, ws, P, it >> 3, it & 7);
            } else {
                attn_naive(F, ws, launder(args.in[I_RELB]), launder(args.in[I_QG] + l * 64), launder(args.in[I_KG] + l * 64), F.vcu - 32, F.G - 32);
            }
        } SEAM(pb + 2);
        if constexpr (PH < 0 || PH == 3) if (IN(pb + 3)) { unsigned char* ws = launder(args.ws); float* outp = launder(args.out); (void)outp; phase_combine(F, ws); } SEAM(pb + 3);
        if constexpr (PH < 0 || PH == 4) if (IN(pb + 4)) { unsigned char* ws = launder(args.ws); float* outp = launder(args.out); (void)outp; EpiGate E{(bf16*)(ws + WS_GATES)}; gemm_naive(F, (const bf16*)(ws + WS_XB), D, w_in + NMIX, DIN, NGATE, D, E); } SEAM(pb + 4);
        if constexpr (PH < 0 || PH == 5) if (IN(pb + 5)) { unsigned char* ws = launder(args.ws); float* outp = launder(args.out); (void)outp; phase_merge_naive(F, (const bf16*)(ws + WS_OA), (const bf16*)(ws + Z_BY), (const bf16*)(ws + WS_OC), args.in[I_PA] + (size_t)l * 512 * D, args.in[I_PB] + (size_t)l * 512 * D,
                                            args.in[I_PC] + (size_t)l * 256 * D, (const bf16*)(ws + WS_GATES), (bf16*)(ws + WS_XB)); } SEAM(pb + 5);
        if constexpr (PH < 0 || PH == 6) if (IN(pb + 6)) { unsigned char* ws = launder(args.ws); float* outp = launder(args.out); (void)outp; EpiRes E{launder(xin), outp}; gemm_naive(F, (const bf16*)(ws + WS_XB), D, args.in[I_WOUT] + (size_t)l * D * D, D, D, D, E); } SEAM(pb + 6);
        if constexpr (PH < 0 || PH == 7) if (IN(pb + 7)) { unsigned char* ws = launder(args.ws); float* outp = launder(args.out); (void)outp; phase_rms(F, outp, args.in[I_NG2] + l * D, (bf16*)(ws + WS_H2)); } SEAM(pb + 7);
        if constexpr (PH < 0 || PH == 8) if (IN(pb + 8)) { unsigned char* ws = launder(args.ws); float* outp = launder(args.out); (void)outp; EpiRelu2 E{(bf16*)(ws + WS_HID), FF}; gemm_naive(F, (const bf16*)(ws + WS_H2), D, args.in[I_UP] + (size_t)l * D * FF, FF, FF, D, E); } SEAM(pb + 8);
        if constexpr (PH < 0 || PH == 9) if (IN(pb + 9)) { unsigned char* ws = launder(args.ws); float* outp = launder(args.out); (void)outp; EpiRes E{outp, outp}; gemm_naive(F, (const bf16*)(ws + WS_HID), FF, args.in[I_DOWN] + (size_t)l * FF * D, D, D, FF, E); }
        if (l + 1 < DEPTH) SEAM(pb + 9);
    }
#undef IN
#undef SEAM
}

extern "C" void kernel_launch(void* const* d_in, const int* in_sizes, int n_in, void* d_out, int out_size, void* d_ws, size_t ws_size, hipStream_t stream) {
    static int grid = 0;
    if (grid == 0) {
        if (n_in != 31 || in_sizes[0] != M * D || out_size != M * D || ws_size < WS_END) { fprintf(stderr, "kernel_launch: unexpected shapes (n_in %d, in0 %d, out %d, ws %zu); nothing launched\n", n_in, n_in > 0 ? in_sizes[0] : -1, out_size, ws_size); grid = -1; return; }
        int dev = 0, cus = 0;
        if (hipGetDevice(&dev) != hipSuccess || hipDeviceGetAttribute(&cus, hipDeviceAttributeMultiprocessorCount, dev) != hipSuccess) { grid = -1; return; }
        bool okattr = true;
#define SETATTR(P) okattr = okattr && (hipFuncSetAttribute((const void*)fwd_kernel<P>, hipFuncAttributeMaxDynamicSharedMemorySize, LDS_BYTES) == hipSuccess)
#if MK_ONE_LAUNCH
        SETATTR(-1);
#else
        SETATTR(0); SETATTR(1); SETATTR(2); SETATTR(3); SETATTR(4); SETATTR(5); SETATTR(6); SETATTR(7); SETATTR(8); SETATTR(9);
#endif
        if (!okattr) { fprintf(stderr, "kernel_launch: hipFuncSetAttribute failed\n"); grid = -1; return; }
        (void)hipGetLastError();
        grid = cus;
    }
    if (grid < 0) return;
    if (hipMemsetAsync((char*)d_ws + WS_CTL, 0, CTL_ZERO_BYTES, stream) != hipSuccess) return;
    Args a{};
    for (int i = 0; i < 31; ++i) a.in[i] = (const float*)d_in[i];
    a.out = (float*)d_out; a.ws = (unsigned char*)d_ws;
#if MK_ONE_LAUNCH
    {
        a.ph_lo = 0; a.ph_hi = NPHASES;
        hipLaunchKernelGGL(fwd_kernel<-1>, dim3(grid), dim3(NTHR), LDS_BYTES, stream, a);
    }
#else
    {
#define LAUNCH(P) case P: hipLaunchKernelGGL(fwd_kernel<P>, dim3(grid), dim3(NTHR), LDS_BYTES, stream, a); break;
        for (int p = 0; p < NPHASES; ++p) { a.ph_lo = p; a.ph_hi = p + 1;
            switch (p % PH_PER_LAYER) { LAUNCH(0) LAUNCH(1) LAUNCH(2) LAUNCH(3) LAUNCH(4) LAUNCH(5) LAUNCH(6) LAUNCH(7) LAUNCH(8) LAUNCH(9) } }
    }
#endif
}
```

```cpp
#include <hip/hip_runtime.h>
#include <cstdio>
#include <cstdint>

#ifndef USE_MFMA
#define USE_MFMA 0x372
#endif
#define MF(k) ((USE_MFMA >> (k)) & 1)
#ifndef FAST_RWKV
#define FAST_RWKV 1
#endif
#ifndef FAST_ATTN
#define FAST_ATTN 1
#endif
#ifndef FAST_LRU
#define FAST_LRU 1
#endif
#ifndef RK_REP
#define RK_REP 0
#endif
#ifndef RK2_REP
#define RK2_REP 0
#endif
#ifndef REP_RWKV
#define REP_RWKV 1
#endif
#ifndef REP_LRUA
#define REP_LRUA 1
#endif
#ifndef REP_ATTN
#define REP_ATTN 1
#endif
#ifndef REP_BAR
#define REP_BAR 1
#endif
#ifndef REP_PH
#define REP_PH -1
#endif
#ifndef REP_MIX
#define REP_MIX 1
#endif
#ifndef REP_RMS
#define REP_RMS 1
#endif
#ifndef MK_ONE_LAUNCH
#define MK_ONE_LAUNCH 1
#endif

constexpr int BATCH = 2, SEQ = 8192, D = 1024, M = BATCH * SEQ, DEPTH = 2;
constexpr int DIN = 8224, FF = 4096;
constexpr int NMIX = 5152;
constexpr int NGATE = 3072;
constexpr float RMS_EPS = 1e-6f, GN_EPS = 64e-5f;
constexpr int NWAVES = 8, NTHR = 512;

constexpr size_t MiB = 1u << 20;
constexpr size_t WS_CTL = 0, CTL_ZERO_BYTES = 64 * 1024;
constexpr size_t WS_SS = 256 * 1024;
constexpr size_t WS_XB = 1 * MiB;
constexpr size_t WS_Z = 33 * MiB;
constexpr size_t Z_R = WS_Z + 0 * MiB, Z_K = WS_Z + 16 * MiB, Z_V = WS_Z + 32 * MiB, Z_L = WS_Z + 48 * MiB  , Z_BX = WS_Z + 57 * MiB;
constexpr size_t A_K = WS_Z + 73 * MiB, A_V = WS_Z + 97 * MiB, Z_BY = WS_Z + 121 * MiB, A_Q = WS_Z + 137 * MiB;
constexpr size_t WS_GATES = WS_Z;
constexpr size_t WS_MERGED = WS_Z;
constexpr size_t WS_GSCR = WS_Z + 32 * MiB;
constexpr size_t WS_H2 = WS_Z;
constexpr size_t WS_HID = WS_Z + 32 * MiB;
constexpr size_t WS_OA = 194 * MiB;
constexpr size_t WS_OC = 210 * MiB;
constexpr size_t WS_WMIX = 218 * MiB;
constexpr size_t WS_WTAIL = WS_WMIX + 5120 * 2048;
constexpr size_t WS_WG = WS_WMIX + 5376 * 2048;
constexpr size_t WS_PA = WS_WG + 6 * MiB, WS_PB = WS_PA + 1 * MiB, WS_PC = WS_PB + 1 * MiB, WS_WOUT = WS_PC + MiB / 2;
constexpr size_t WS_WUP = WS_OA, WS_WDOWN = WS_OA + 8 * MiB;
constexpr size_t WS_LSE = 239 * MiB;
constexpr size_t WS_RKPQ = 240 * MiB;
constexpr size_t WS_LRUAGG = 248 * MiB;
constexpr size_t WS_ZT = 249 * MiB;
constexpr size_t WS_END = 256 * MiB;
static_assert(WS_PB == WS_PA + MiB && WS_PC == WS_PB + MiB && WS_OA == 194 * MiB && Z_BY == 154 * MiB && WS_OC == 210 * MiB, "merge phase operand arithmetic");
static_assert(WS_WOUT + 2 * MiB <= WS_LSE && WS_WDOWN + 8 * MiB <= WS_OC, "ws map (weights)");
static_assert(WS_HID + (size_t)M * FF * 2 <= WS_OA && A_Q + (size_t)M * 768 * 2 <= WS_OA && WS_GATES + (size_t)M * NGATE * 2 <= Z_BY, "ws map");

#define GAS __attribute__((address_space(1)))
#define LAS __attribute__((address_space(3)))
typedef unsigned short bf16;
typedef GAS unsigned gu32;
#define RLX_AGENT __ATOMIC_RELAXED, __HIP_MEMORY_SCOPE_AGENT
__device__ __forceinline__ unsigned f2bf(float f) { unsigned u = __builtin_bit_cast(unsigned, f); return (u + 0x7fffu + ((u >> 16) & 1u)) >> 16; }
__device__ __forceinline__ float bf2f(unsigned h) { return __builtin_bit_cast(float, h << 16); }
__device__ __forceinline__ float shfl_xor_l(float v, int o, int lane) { return __builtin_bit_cast(float, __builtin_amdgcn_ds_bpermute((lane ^ o) << 2, __builtin_bit_cast(int, v))); }
__device__ __forceinline__ float wave_sum(float v, int lane) {
#pragma unroll
    for (int o = 1; o < 64; o <<= 1) v += shfl_xor_l(v, o, lane);
    return v;
}
template <class T> __device__ __forceinline__ T* launder(T* p) { asm volatile("" : "+s"(p)); return p; }
__device__ __forceinline__ float sigmoidf_(float x) { return 1.f / (1.f + __expf(-x)); }
__device__ __forceinline__ float softplusf_(float x) { return x > 20.f ? x : log1pf(expf(x)); }

#define XB_TMO      128
#define XB_XCNT(j)  (256  + 64 * (j))
#define XB_XSUB(j)  (1280 + 64 * (j))
#define XB_XGEN(j)  (2304 + 64 * (j))
#define XB_TOP      3328
#define XB_TOPGEN   3392
#define XCD_BAR_WORDS 3456
#define XB_SPIN_CAP (1u << 22)
constexpr int CW_BAR = 4096;
__device__ __forceinline__ unsigned xb_ld(unsigned* p)              { return __hip_atomic_load(p, __ATOMIC_RELAXED, __HIP_MEMORY_SCOPE_AGENT); }
__device__ __forceinline__ unsigned xb_add(unsigned* p, unsigned v) { return __hip_atomic_fetch_add(p, v, __ATOMIC_RELAXED, __HIP_MEMORY_SCOPE_AGENT); }
__device__ __forceinline__ unsigned xb_xcc_id() { return (unsigned)__builtin_amdgcn_s_getreg((3 << 11) | 20) & 0xFu; }
#define XB_SPIN(cond, bar) do { unsigned _sp = 0; while (cond) { \
    if ((++_sp & 255u) == 0u) { if (xb_ld(&(bar)[XB_TMO])) break; if (_sp > XB_SPIN_CAP) { atomicAdd(&(bar)[XB_TMO], 1u); break; } } } } while (0)
struct XcdBarrier { unsigned* bar; unsigned x; volatile LAS unsigned* st; };
__device__ __forceinline__ XcdBarrier xcd_barrier_post(unsigned* bar, volatile LAS unsigned* st) {
    XcdBarrier b; b.bar = bar; b.x = xb_xcc_id(); b.st = st;
    if (threadIdx.x == 0) (void)xb_add(&bar[XB_XCNT(b.x)], 1u);
    return b;
}
__device__ __forceinline__ void xcd_barrier_complete(unsigned* bar, unsigned x, unsigned& nloc, unsigned& nx) {
    const unsigned G = gridDim.x * gridDim.y * gridDim.z;
    unsigned sum, cnt, mine, sp = 0u;
    for (;;) {
        sum = 0u; cnt = 0u; mine = 0u;
#pragma unroll
        for (unsigned j = 0; j < 16; ++j) { const unsigned c = xb_ld(&bar[XB_XCNT(j)]); sum += c; cnt += (c > 0u) ? 1u : 0u; mine = (j == x) ? c : mine; }
        if (sum == G) break;
        __builtin_amdgcn_s_sleep(1);
        if ((++sp & 255u) == 0u) { if (xb_ld(&bar[XB_TMO])) break; if (sp > XB_SPIN_CAP) { atomicAdd(&bar[XB_TMO], 1u); break; } }
    }
    nloc = mine > 0u ? mine : 1u; nx = cnt > 0u ? cnt : 1u;
}
__device__ __forceinline__ void xcd_barrier(const XcdBarrier& b) {
    asm volatile("s_waitcnt vmcnt(0)" ::: "memory");
    __syncthreads();
    if (threadIdx.x == 0) {
        unsigned* bar = b.bar;
        __builtin_amdgcn_s_waitcnt(0);
        unsigned nloc = b.st[0], nx = b.st[1];
        if (nloc == 0u) { xcd_barrier_complete(bar, b.x, nloc, nx); b.st[0] = nloc; b.st[1] = nx; }
        const unsigned old = xb_add(&bar[XB_XSUB(b.x)], 1u);
        const unsigned gen = old / nloc;
        if (old + 1u == (gen + 1u) * nloc) {
            __builtin_amdgcn_fence(__ATOMIC_RELEASE, "agent");
            asm volatile("s_waitcnt vmcnt(0)" ::: "memory");
            const unsigned og = xb_add(&bar[XB_TOP], 1u);
            const unsigned tg = og / nx;
            if (og + 1u == (tg + 1u) * nx) xb_add(&bar[XB_TOPGEN], 1u);
            else XB_SPIN(xb_ld(&bar[XB_TOPGEN]) == tg, bar);
            __builtin_amdgcn_fence(__ATOMIC_ACQUIRE, "agent");
            xb_add(&bar[XB_XGEN(b.x)], 1u);
            asm volatile("s_waitcnt vmcnt(0)" ::: "memory");
        } else {
            XB_SPIN(xb_ld(&bar[XB_XGEN(b.x)]) == gen, bar);
            __builtin_amdgcn_fence(__ATOMIC_ACQUIRE, "agent");
            asm volatile("s_waitcnt vmcnt(0)" ::: "memory");
        }
    }
    __syncthreads();
}

namespace pg8 {
#define PG8_LAS __attribute__((address_space(3)))
typedef unsigned short bf16_t;
typedef short bf16x8 __attribute__((ext_vector_type(8)));
typedef float f32x4 __attribute__((ext_vector_type(4)));
typedef unsigned u32x4 __attribute__((ext_vector_type(4)));
constexpr int BM = 256, BK = 64, HALF = 128, HTB = HALF * BK * 2  , STAGE_BYTES = 8 * HTB, NXCD = 8, WGM = 8;

__host__ __device__ __forceinline__ int lds_byte(int r, int c) { const int st = (r >> 4) * 2 + (c >> 5), rr = r & 15, cc = c & 31, ob = rr * 64 + cc * 2; return st * 1024 + (ob ^ (((ob >> 9) & 1) << 5)); }
__host__ __device__ __forceinline__ void stage_rc(int b, int& R, int& C) { const int st = b / 1024, sb = b % 1024, swz = sb ^ (((sb >> 9) & 1) << 5); R = (st >> 1) * 16 + swz / 64; C = (st & 1) * 32 + (swz % 64) / 2; }
__host__ __device__ __forceinline__ int perm32(int rho) { const int n = rho >> 4, i = rho & 15; return 8 * (i >> 2) + 4 * n + (i & 3); }

struct Unit { int pm, pn, par; };
struct Gemm { const bf16_t* A; const bf16_t* Bt; int M, N, K; };

struct StaticOrder {
    int nM, nN, nwg, G, c;
    __host__ __device__ __forceinline__ void init(int M, int N, int G_, int c_) { nM = M / BM; nN = N / BM; nwg = nM * nN; G = G_; c = c_; }
    __host__ __device__ __forceinline__ bool next(int i, Unit& u) const {
        const long L = (long)i * G + c; if (L >= nwg) return false;
        int wgid = (int)L; { const int q = nwg / NXCD, r = nwg % NXCD, xcd = wgid % NXCD, off = wgid / NXCD; wgid = (xcd < r ? xcd * (q + 1) : r * (q + 1) + (xcd - r) * q) + off; }
        const int nig = WGM * nN, gid = wgid / nig, fm = gid * WGM, gsz = (nM - fm) < WGM ? (nM - fm) : WGM;
        u.pm = fm + ((wgid % nig) % gsz); u.pn = (wgid % nig) / gsz; u.par = i & 1; return true;
    }
    __device__ __forceinline__ void a_ready(const Unit&) const {}
    __device__ __forceinline__ void done(const Unit&) const {}
};
struct RstdOrder : StaticOrder {
    const float* ss; PG8_LAS float* tab; int tid;
    __device__ __forceinline__ void a_ready(const Unit& u) const { if (tid < 256) tab[u.par * 256 + tid] = __builtin_amdgcn_rsqf(ss[u.pm * BM + tid] * (1.f / 1024.f) + 1e-6f); }
};

typedef float f32x2_c __attribute__((ext_vector_type(2))); typedef __bf16 bf16x2_c __attribute__((ext_vector_type(2)));
__device__ __forceinline__ unsigned cvt_pk_bf16(float lo, float hi) { f32x2_c v = {lo, hi}; bf16x2_c b = __builtin_convertvector(v, bf16x2_c); return __builtin_bit_cast(unsigned, b); }

typedef _Float16 f16x2_c __attribute__((ext_vector_type(2))); typedef _Float16 f16x8 __attribute__((ext_vector_type(8)));
__device__ __forceinline__ unsigned cvt_pk_f16(float lo, float hi) { f32x2_c v = {lo, hi}; f16x2_c h = __builtin_convertvector(v, f16x2_c); return __builtin_bit_cast(unsigned, h); }
__device__ __forceinline__ float hfl(unsigned u) { return (float)__builtin_bit_cast(f16x2_c, u)[0]; }
__device__ __forceinline__ float hfh(unsigned u) { return (float)__builtin_bit_cast(f16x2_c, u)[1]; }
__device__ __forceinline__ u32x4 pack8h(const f32x4& v0, const f32x4& v1) { u32x4 w; w.x = cvt_pk_f16(v0[0], v0[1]); w.y = cvt_pk_f16(v0[2], v0[3]); w.z = cvt_pk_f16(v1[0], v1[1]); w.w = cvt_pk_f16(v1[2], v1[3]); return w; }
__device__ __forceinline__ f32x4 mfma16(bool f16, bf16x8 a, bf16x8 b, f32x4 c) {
    return f16 ? __builtin_amdgcn_mfma_f32_16x16x32_f16(__builtin_bit_cast(f16x8, a), __builtin_bit_cast(f16x8, b), c, 0, 0, 0) : __builtin_amdgcn_mfma_f32_16x16x32_bf16(a, b, c, 0, 0, 0); }
__device__ __forceinline__ u32x4 pack8(const f32x4& v0, const f32x4& v1) { u32x4 w; w.x = cvt_pk_bf16(v0[0], v0[1]); w.y = cvt_pk_bf16(v0[2], v0[3]); w.z = cvt_pk_bf16(v1[0], v1[1]); w.w = cvt_pk_bf16(v1[2], v1[3]); return w; }
__device__ __forceinline__ float bfl(unsigned u) { return __builtin_bit_cast(float, u << 16); }
__device__ __forceinline__ float bfh(unsigned u) { return __builtin_bit_cast(float, u & 0xffff0000u); }
__device__ __forceinline__ void st16_wt(void* base, unsigned byte_off, u32x4 v) {
    const __amdgpu_buffer_rsrc_t rsrc = __builtin_amdgcn_make_buffer_rsrc(base, (short)0, 0x7fffffff, 0x00020000);
    __builtin_amdgcn_raw_buffer_store_b128(v, rsrc, (int)byte_off, 0, 16);
}
__device__ __forceinline__ float fsig(float x) { return __builtin_amdgcn_rcpf(1.f + __builtin_amdgcn_exp2f(-1.4426950408889634f * x)); }
__device__ __forceinline__ float row_rstd(const float* ss, int row) { return __builtin_amdgcn_rsqf(ss[row] * (1.f / 1024.f) + RMS_EPS); }
struct EpiMixMF {
    static constexpr bool PERM = true, AFTER_DRAIN = false;
    unsigned char* ws; const PG8_LAS float* rt;
    __device__ __forceinline__ void operator()(const f32x4 (&acc)[2][2][4][2], const Unit& u, int wr, int wc, int fr, int fq) const {
        const int pn = u.pn; size_t boff; int ld, colt, lim;
        if (pn < 2)       { boff = Z_R;  ld = 512; colt = pn * 256;        lim = 512; }
        else if (pn < 4)  { boff = Z_K;  ld = 512; colt = (pn - 2) * 256;  lim = 512; }
        else if (pn < 6)  { boff = Z_V;  ld = 512; colt = (pn - 4) * 256;  lim = 512; }
        else if (pn < 7)  { boff = Z_L;  ld = 288; colt = 0;               lim = 256; }
        else if (pn < 9)  { boff = Z_BX; ld = 512; colt = (pn - 7) * 256;  lim = 512; }
        else if (pn < 11) { boff = Z_BY; ld = 512; colt = (pn - 9) * 256;  lim = 512; }
        else if (pn < 14) { boff = A_Q;  ld = 768; colt = (pn - 11) * 256; lim = 768; }
        else if (pn < 17) { boff = A_K;  ld = 768; colt = (pn - 14) * 256; lim = 768; }
        else              { boff = A_V;  ld = 768; colt = (pn - 17) * 256; lim = 768; }
        bf16_t* base = (bf16_t*)(ws + boff);
        const int row0 = u.pm * BM + wr * 64 + fr, col0 = colt + wc * 32 + 8 * fq;
#pragma unroll
        for (int ai = 0; ai < 2; ++ai)
#pragma unroll
            for (int m = 0; m < 4; ++m) { const unsigned roff = (unsigned)(((row0 + ai * HALF + m * 16) * ld + col0) * 2); const float rs = rt[u.par * 256 + wr * 64 + fr + ai * HALF + m * 16];
#pragma unroll
                for (int bj = 0; bj < 2; ++bj) if (col0 + bj * HALF < lim) st16_wt(base, roff + bj * HALF * 2, pack8(acc[ai][bj][m][0] * rs, acc[ai][bj][m][1] * rs)); }
    }
};
template <int ACT  > struct EpiActMF {
    static constexpr bool PERM = true, AFTER_DRAIN = false;
    bf16_t* O; int ldc; const PG8_LAS float* rt;
    __device__ __forceinline__ void operator()(const f32x4 (&acc)[2][2][4][2], const Unit& u, int wr, int wc, int fr, int fq) const {
        const int row0 = u.pm * BM + wr * 64 + fr, col0 = u.pn * BM + wc * 32 + 8 * fq;
#pragma unroll
        for (int ai = 0; ai < 2; ++ai)
#pragma unroll
            for (int m = 0; m < 4; ++m) { bf16_t* rowp = O + (size_t)(row0 + ai * HALF + m * 16) * ldc + col0; const float rs = rt[u.par * 256 + wr * 64 + fr + ai * HALF + m * 16] * (ACT == 1 ? -1.4426950408889634f : 1.f);
#pragma unroll
                for (int bj = 0; bj < 2; ++bj) { f32x4 v0 = acc[ai][bj][m][0] * rs, v1 = acc[ai][bj][m][1] * rs;
#pragma unroll
                    for (int e = 0; e < 4; ++e) {
                        if (ACT == 1) { v0[e] = __builtin_amdgcn_rcpf(1.f + __builtin_amdgcn_exp2f(v0[e])); v1[e] = __builtin_amdgcn_rcpf(1.f + __builtin_amdgcn_exp2f(v1[e])); }
                        if (ACT == 2) { const float a = fmaxf(v0[e], 0.f), b = fmaxf(v1[e], 0.f); v0[e] = a * a; v1[e] = b * b; } }
                    if (ACT == 2) st16_wt(O, (unsigned)(((size_t)(row0 + ai * HALF + m * 16) * ldc + col0 + bj * HALF) * 2), pack8(v0, v1)); else *(u32x4*)(rowp + bj * HALF) = pack8(v0, v1); } }
    }
};
template <int BR> struct EpiMergeMF {
    static constexpr bool PERM = true, AFTER_DRAIN = false;
    const bf16_t* gates; bf16_t* O; int gld, goff;
    __device__ __forceinline__ void operator()(const f32x4 (&acc)[2][2][4][2], const Unit& u, int wr, int wc, int fr, int fq) const {
        const int row0 = u.pm * BM + wr * 64 + fr, col0 = u.pn * BM + wc * 32 + 8 * fq;
#pragma unroll
        for (int ai = 0; ai < 2; ++ai) {
            u32x4 gv[4][2], pv[4][2];
#pragma unroll
            for (int m = 0; m < 4; ++m)
#pragma unroll
                for (int bj = 0; bj < 2; ++bj) { const size_t r = (size_t)(row0 + ai * HALF + m * 16);
                    gv[m][bj] = *(const u32x4*)(gates + r * gld + goff + col0 + bj * HALF);
                    if (BR > 0) pv[m][bj] = *(const u32x4*)(O + r * 1024 + col0 + bj * HALF); }
#pragma unroll
            for (int m = 0; m < 4; ++m)
#pragma unroll
                for (int bj = 0; bj < 2; ++bj) { const size_t r = (size_t)(row0 + ai * HALF + m * 16); const u32x4 g = gv[m][bj];
                    f32x4 v0 = acc[ai][bj][m][0], v1 = acc[ai][bj][m][1];
                    v0[0] *= bfl(g.x); v0[1] *= bfh(g.x); v0[2] *= bfl(g.y); v0[3] *= bfh(g.y); v1[0] *= bfl(g.z); v1[1] *= bfh(g.z); v1[2] *= bfl(g.w); v1[3] *= bfh(g.w);
                    if (BR > 0) { const u32x4 p = pv[m][bj];
                        v0[0] += bfl(p.x); v0[1] += bfh(p.x); v0[2] += bfl(p.y); v0[3] += bfh(p.y); v1[0] += bfl(p.z); v1[1] += bfh(p.z); v1[2] += bfl(p.w); v1[3] += bfh(p.w); }
                    *(u32x4*)(O + r * 1024 + col0 + bj * HALF) = pack8(v0, v1); }
            asm volatile("" ::: "memory");
        }
    }
};
struct EpiResMF {
    static constexpr bool PERM = false, AFTER_DRAIN = false;
    const float* base; float* out; bf16_t* xb; float* ss; bool dry = false;
    __device__ __forceinline__ void operator()(const f32x4 (&acc)[2][2][4][2], const Unit& u, int wr, int wc, int fr, int fq) const {
        if (dry && acc[0][0][0][0][0] != 1.2345e30f) return;
        typedef unsigned u32x2e __attribute__((ext_vector_type(2)));
        const int row0 = u.pm * BM + wr * 64 + fr, col0 = u.pn * BM + wc * 32 + 4 * fq, lane = fq * 16 + fr;
#pragma unroll
        for (int ai = 0; ai < 2; ++ai)
#pragma unroll
            for (int m = 0; m < 4; ++m) { const int row = row0 + ai * HALF + m * 16; const size_t off = (size_t)row * 1024 + col0; float s = 0.f;
#pragma unroll
                for (int bj = 0; bj < 2; ++bj)
#pragma unroll
                    for (int n = 0; n < 2; ++n) { const f32x4 b = *(const f32x4*)(base + off + bj * HALF + n * 16); const f32x4 v = b + acc[ai][bj][m][n]; *(f32x4*)(out + off + bj * HALF + n * 16) = v;
                        if (xb) { *(u32x2e*)(xb + off + bj * HALF + n * 16) = (u32x2e){cvt_pk_bf16(v[0], v[1]), cvt_pk_bf16(v[2], v[3])}; s += (v[0] * v[0] + v[1] * v[1]) + (v[2] * v[2] + v[3] * v[3]); } }
                if (ss) { s += __builtin_bit_cast(float, __builtin_amdgcn_ds_bpermute((lane ^ 16) << 2, __builtin_bit_cast(int, s))); s += __builtin_bit_cast(float, __builtin_amdgcn_ds_bpermute((lane ^ 32) << 2, __builtin_bit_cast(int, s)));
                    if (fq == 0) atomicAdd(ss + row, s); }
                if (m & 1) asm volatile("" ::: "memory"); }
    }
};

struct EpiResH {
    static constexpr bool PERM = true, AFTER_DRAIN = false;
    const float* basef; const bf16_t* xbr; bf16_t* xbw; float* outf; float* ss; bool dry = false;
    __device__ __forceinline__ void operator()(const f32x4 (&acc)[2][2][4][2], const Unit& u, int wr, int wc, int fr, int fq) const {
        if (dry && acc[0][0][0][0][0] != 1.2345e30f) return;
        const int row0 = u.pm * BM + wr * 64 + fr, col0 = u.pn * BM + wc * 32 + 8 * fq, lane = fq * 16 + fr;
#pragma unroll
        for (int ai = 0; ai < 2; ++ai)
#pragma unroll
            for (int mp = 0; mp < 2; ++mp) {
                f32x4 b0[2][2], b1[2][2];
#pragma unroll
                for (int mm = 0; mm < 2; ++mm)
#pragma unroll
                    for (int bj = 0; bj < 2; ++bj) { const size_t off = (size_t)(row0 + ai * HALF + (2 * mp + mm) * 16) * 1024 + col0 + bj * HALF;
                        if (basef) { b0[mm][bj] = *(const f32x4*)(basef + off); b1[mm][bj] = *(const f32x4*)(basef + off + 4); }
                        else { const u32x4 p = *(const u32x4*)(xbr + off); b0[mm][bj] = (f32x4){hfl(p.x), hfh(p.x), hfl(p.y), hfh(p.y)}; b1[mm][bj] = (f32x4){hfl(p.z), hfh(p.z), hfl(p.w), hfh(p.w)}; } }
#pragma unroll
                for (int mm = 0; mm < 2; ++mm) { const int m = 2 * mp + mm, row = row0 + ai * HALF + m * 16; float s = 0.f;
#pragma unroll
                    for (int bj = 0; bj < 2; ++bj) { const size_t off = (size_t)row * 1024 + col0 + bj * HALF;
                        const f32x4 v0 = b0[mm][bj] + acc[ai][bj][m][0], v1 = b1[mm][bj] + acc[ai][bj][m][1];
                        if (outf) { *(f32x4*)(outf + off) = v0; *(f32x4*)(outf + off + 4) = v1; }
                        if (xbw) { *(u32x4*)(xbw + off) = pack8h(v0, v1); s += ((v0[0] * v0[0] + v0[1] * v0[1]) + (v0[2] * v0[2] + v0[3] * v0[3])) + ((v1[0] * v1[0] + v1[1] * v1[1]) + (v1[2] * v1[2] + v1[3] * v1[3])); } }
                    if (ss) { s += __builtin_bit_cast(float, __builtin_amdgcn_ds_bpermute((lane ^ 16) << 2, __builtin_bit_cast(int, s))); s += __builtin_bit_cast(float, __builtin_amdgcn_ds_bpermute((lane ^ 32) << 2, __builtin_bit_cast(int, s)));
                        if (fq == 0) atomicAdd(ss + row, s); } }
                asm volatile("" ::: "memory"); }
    }
};

template <class Epi, class Sched, bool ALIGN_EPI = false, bool SP2 = false, bool F16 = false>
__device__ __forceinline__ void gemm_phase(PG8_LAS unsigned char* lds, const Gemm g, const Sched& S, const Epi& E, const int tid) {
    const int wid = __builtin_amdgcn_readfirstlane(tid >> 6), lane = tid & 63, wr = wid >> 2, wc = wid & 3, fr = lane & 15, fq = lane >> 4;
    const int K = g.K, nt = K / BK;
    unsigned voffA[2], voffB[2];
#pragma unroll
    for (int i = 0; i < 2; ++i) { int R, C; stage_rc(tid * 16 + i * 8192, R, C); const int Rb = Epi::PERM ? ((R & ~31) + perm32(R & 31)) : R;
        voffA[i] = (unsigned)(R * K + C) * 2u; voffB[i] = (unsigned)(Rb * K + C) * 2u; }
    const size_t kstep = (size_t)(BK * 2);
    const size_t hstep = (size_t)HALF * K * 2;
    const size_t tstep = 2 * hstep;
    const unsigned ldsw = (unsigned)wid * 1024u;
    const int aoff = lds_byte(wr * 64 + fr, fq * 8), boff = lds_byte(wc * 32 + fr, fq * 8);
#define PG8_SA(b, h) (((b) * 2 + (h)) * HTB)
#define PG8_SB(b, h) ((4 + (b) * 2 + (h)) * HTB)
#define PG8_STAGE(bufoff, gbase, voff) do { _Pragma("unroll") for (int _i = 0; _i < 2; ++_i) \
        __builtin_amdgcn_global_load_lds((const unsigned*)((const char*)(gbase) + (voff)[_i]), (PG8_LAS unsigned*)(lds + (bufoff) + ldsw + _i * 8192), 16, 0, 0); } while (0)
#define PG8_LDA(dst, b, h) do { _Pragma("unroll") for (int m = 0; m < 4; ++m) _Pragma("unroll") for (int k = 0; k < 2; ++k) dst[m][k] = *(const PG8_LAS bf16x8*)(lds + PG8_SA(b, h) + aoff + m * 2048 + k * 1024); } while (0)
#define PG8_LDB(dst, b, h) do { _Pragma("unroll") for (int n = 0; n < 2; ++n) _Pragma("unroll") for (int k = 0; k < 2; ++k) dst[n][k] = *(const PG8_LAS bf16x8*)(lds + PG8_SB(b, h) + boff + n * 2048 + k * 1024); } while (0)
#define PG8_MMA(ai, bj, At, Bt) do { __builtin_amdgcn_s_setprio(1); _Pragma("unroll") for (int m = 0; m < 4; ++m) _Pragma("unroll") for (int n = 0; n < 2; ++n) _Pragma("unroll") for (int k = 0; k < 2; ++k) \
        acc[ai][bj][m][n] = mfma16(F16, Bt[n][k], At[m][k], acc[ai][bj][m][n]); __builtin_amdgcn_s_setprio(0); } while (0)
#define PG8_WAIT_V(n) asm volatile("s_waitcnt vmcnt(" #n ")" ::: "memory")
#define PG8_WAIT_L(n) asm volatile("s_waitcnt lgkmcnt(" #n ")" ::: "memory")
#define PG8_BAR __builtin_amdgcn_s_barrier()
#define PG8_SCHED __builtin_amdgcn_sched_barrier(0)
    Unit cur, nxt; int ui = 0;
    if (!S.next(0, cur)) return;
    f32x4 acc[2][2][4][2];
#pragma unroll
    for (int a = 0; a < 2; ++a)
#pragma unroll
        for (int b = 0; b < 2; ++b)
#pragma unroll
            for (int m = 0; m < 4; ++m)
#pragma unroll
                for (int n = 0; n < 2; ++n) acc[a][b][m][n] = (f32x4){0.f, 0.f, 0.f, 0.f};
    bf16x8 At[4][2], B0[2][2], B1[2][2];
    const char* cA = (const char*)g.A + (size_t)cur.pm * tstep; const char* cB = (const char*)g.Bt + (size_t)cur.pn * tstep;
    S.a_ready(cur);
    if constexpr (SP2) {
        PG8_STAGE(PG8_SB(0, 0), cB, voffB); PG8_STAGE(PG8_SB(0, 1), cB + hstep, voffB); PG8_STAGE(PG8_SA(0, 0), cA, voffA); PG8_STAGE(PG8_SA(0, 1), cA + hstep, voffA);
        if (wr == 1) PG8_BAR;
        PG8_WAIT_V(2); PG8_BAR;
        PG8_STAGE(PG8_SB(1, 0), cB + kstep, voffB); PG8_STAGE(PG8_SA(1, 0), cA + kstep, voffA); PG8_STAGE(PG8_SB(1, 1), cB + hstep + kstep, voffB);
        PG8_WAIT_V(6); PG8_BAR;
    } else {
        PG8_STAGE(PG8_SB(0, 0), cB, voffB); PG8_STAGE(PG8_SA(0, 0), cA, voffA); PG8_STAGE(PG8_SB(0, 1), cB + hstep, voffB); PG8_STAGE(PG8_SA(0, 1), cA + hstep, voffA);
        if (wr == 1) PG8_BAR;
        PG8_WAIT_V(4); PG8_BAR;
        PG8_STAGE(PG8_SB(1, 0), cB + kstep, voffB); PG8_STAGE(PG8_SA(1, 0), cA + kstep, voffA); PG8_STAGE(PG8_SB(1, 1), cB + hstep + kstep, voffB);
        PG8_WAIT_V(6); PG8_BAR;
    }
    for (;;) {
        const bool has_next = S.next(ui + 1, nxt);
        const char* nA = has_next ? (const char*)g.A + (size_t)nxt.pm * tstep : cA; const char* nB = has_next ? (const char*)g.Bt + (size_t)nxt.pn * tstep : cB;
#pragma unroll 1
        for (int t = 0; t < nt; t += 2) {
            const bool last = (t == nt - 2);
            const char* a1 = cA + (size_t)(t + 1) * kstep;
            const char* a2 = last ? nA : cA + (size_t)(t + 2) * kstep; const char* b2 = last ? nB : cB + (size_t)(t + 2) * kstep;
            const char* a3 = a2 + kstep; const char* b3 = b2 + kstep;
            if (last && has_next) S.a_ready(nxt);
            if constexpr (SP2) {
            PG8_LDB(B0, 0, 0); PG8_LDB(B1, 0, 1); PG8_SCHED; PG8_LDA(At, 0, 0); PG8_STAGE(PG8_SA(1, 1), a1 + hstep, voffA);
            PG8_WAIT_V(8); PG8_WAIT_L(0); PG8_BAR; PG8_MMA(0, 0, At, B0); PG8_MMA(0, 1, At, B1); PG8_BAR; PG8_SCHED;
            PG8_LDA(At, 0, 1); PG8_STAGE(PG8_SB(0, 0), b2, voffB); PG8_STAGE(PG8_SB(0, 1), b2 + hstep, voffB); PG8_STAGE(PG8_SA(0, 0), a2, voffA);
            PG8_WAIT_V(8); PG8_WAIT_L(0); PG8_BAR; PG8_MMA(1, 0, At, B0); PG8_MMA(1, 1, At, B1); PG8_BAR; PG8_SCHED;
            PG8_LDB(B0, 1, 0); PG8_LDB(B1, 1, 1); PG8_SCHED; PG8_LDA(At, 1, 0); PG8_STAGE(PG8_SA(0, 1), a2 + hstep, voffA);
            PG8_WAIT_V(8); PG8_WAIT_L(0); PG8_BAR; PG8_MMA(0, 0, At, B0); PG8_MMA(0, 1, At, B1); PG8_BAR; PG8_SCHED;
            PG8_LDA(At, 1, 1); PG8_STAGE(PG8_SB(1, 0), b3, voffB); PG8_STAGE(PG8_SB(1, 1), b3 + hstep, voffB); PG8_STAGE(PG8_SA(1, 0), a3, voffA);
            PG8_WAIT_V(8); PG8_WAIT_L(0); PG8_BAR; PG8_MMA(1, 0, At, B0); PG8_MMA(1, 1, At, B1); PG8_BAR; PG8_SCHED;
            } else {
            PG8_LDB(B0, 0, 0); PG8_SCHED; PG8_LDA(At, 0, 0); PG8_STAGE(PG8_SA(1, 1), a1 + hstep, voffA);
            PG8_WAIT_L(8); PG8_BAR; PG8_WAIT_L(0); PG8_MMA(0, 0, At, B0); PG8_BAR; PG8_SCHED;
            PG8_LDB(B1, 0, 1); PG8_STAGE(PG8_SB(0, 0), b2, voffB);
            PG8_BAR; PG8_WAIT_L(0); PG8_MMA(0, 1, At, B1); PG8_BAR;
            PG8_LDA(At, 0, 1); PG8_STAGE(PG8_SA(0, 0), a2, voffA);
            PG8_BAR; PG8_WAIT_L(0); PG8_MMA(1, 0, At, B0); PG8_BAR; PG8_SCHED;
            PG8_STAGE(PG8_SB(0, 1), b2 + hstep, voffB);
            PG8_WAIT_V(6); PG8_BAR; PG8_MMA(1, 1, At, B1); PG8_BAR;
            PG8_LDB(B0, 1, 0); PG8_SCHED; PG8_LDA(At, 1, 0); PG8_STAGE(PG8_SA(0, 1), a2 + hstep, voffA);
            PG8_WAIT_L(8); PG8_BAR; PG8_WAIT_L(0); PG8_MMA(0, 0, At, B0); PG8_BAR; PG8_SCHED;
            PG8_LDB(B1, 1, 1); PG8_STAGE(PG8_SB(1, 0), b3, voffB);
            PG8_BAR; PG8_WAIT_L(0); PG8_MMA(0, 1, At, B1); PG8_BAR;
            PG8_LDA(At, 1, 1); PG8_STAGE(PG8_SA(1, 0), a3, voffA);
            PG8_BAR; PG8_WAIT_L(0); PG8_MMA(1, 0, At, B0); PG8_BAR; PG8_SCHED;
            PG8_STAGE(PG8_SB(1, 1), b3 + hstep, voffB);
            PG8_WAIT_V(6); PG8_BAR; PG8_MMA(1, 1, At, B1); PG8_BAR;
            }
        }
        if constexpr (ALIGN_EPI) { if (wr == 0) PG8_BAR; }
        if constexpr (!Epi::AFTER_DRAIN) { int fr_e = fr, fq_e = fq; asm volatile("" : "+v"(fr_e), "+v"(fq_e));
            E(acc, cur, wr, wc, fr_e, fq_e); S.done(cur); }
        if (!has_next) break;
#pragma unroll
        for (int a = 0; a < 2; ++a)
#pragma unroll
            for (int b = 0; b < 2; ++b)
#pragma unroll
                for (int m = 0; m < 4; ++m)
#pragma unroll
                    for (int n = 0; n < 2; ++n) acc[a][b][m][n] = (f32x4){0.f, 0.f, 0.f, 0.f};
        cur = nxt; cA = nA; cB = nB; ++ui;
        if constexpr (ALIGN_EPI) { if (wr == 1) PG8_BAR; }
    }
    PG8_WAIT_V(0);
    if constexpr (!ALIGN_EPI) { if (wr == 0) PG8_BAR; }
    PG8_BAR;
    if constexpr (Epi::AFTER_DRAIN) { E.fused(acc, cur, wr, wc, fr, fq, lds, wid, lane); S.done(cur); }
#undef PG8_SA
#undef PG8_SB
#undef PG8_STAGE
#undef PG8_LDA
#undef PG8_LDB
#undef PG8_MMA
#undef PG8_WAIT_V
#undef PG8_WAIT_L
#undef PG8_BAR
#undef PG8_SCHED
}

struct XOp { const char* A; const char* B; int K; };
template <class Disp>
__device__ __forceinline__ void gemm_seq(PG8_LAS unsigned char* lds, const Disp& Dp, const int nsteps, const int pm, const int pn, const int tid) {
    const int wid = __builtin_amdgcn_readfirstlane(tid >> 6), lane = tid & 63, wr = wid >> 2, wc = wid & 3, fr = lane & 15, fq = lane >> 4;
    int RA[2], RB[2], C2[2];
#pragma unroll
    for (int i = 0; i < 2; ++i) { int R, C; stage_rc(tid * 16 + i * 8192, R, C); const int Rb = (R & ~31) + perm32(R & 31); RA[i] = 2 * R; RB[i] = 2 * Rb; C2[i] = 2 * C; }
    const size_t kstep = (size_t)(BK * 2);
    const unsigned ldsw = (unsigned)wid * 1024u;
    const int aoff = lds_byte(wr * 64 + fr, fq * 8), boff = lds_byte(wc * 32 + fr, fq * 8);
#define PG8_SA(b, h) (((b) * 2 + (h)) * HTB)
#define PG8_SB(b, h) ((4 + (b) * 2 + (h)) * HTB)
#define PG8_STAGEX(bufoff, gbase, Rx, KK) do { _Pragma("unroll") for (int _i = 0; _i < 2; ++_i) \
        __builtin_amdgcn_global_load_lds((const unsigned*)((const char*)(gbase) + (unsigned)((Rx)[_i] * (KK) + C2[_i])), (PG8_LAS unsigned*)(lds + (bufoff) + ldsw + _i * 8192), 16, 0, 0); } while (0)
#define PG8_LDA(dst, b, h) do { _Pragma("unroll") for (int m = 0; m < 4; ++m) _Pragma("unroll") for (int k = 0; k < 2; ++k) dst[m][k] = *(const PG8_LAS bf16x8*)(lds + PG8_SA(b, h) + aoff + m * 2048 + k * 1024); } while (0)
#define PG8_LDB(dst, b, h) do { _Pragma("unroll") for (int n = 0; n < 2; ++n) _Pragma("unroll") for (int k = 0; k < 2; ++k) dst[n][k] = *(const PG8_LAS bf16x8*)(lds + PG8_SB(b, h) + boff + n * 2048 + k * 1024); } while (0)
#define PG8_MMA(ai, bj, At, Bt) do { __builtin_amdgcn_s_setprio(1); if (cf16) { _Pragma("unroll") for (int m = 0; m < 4; ++m) _Pragma("unroll") for (int n = 0; n < 2; ++n) _Pragma("unroll") for (int k = 0; k < 2; ++k) \
        acc[ai][bj][m][n] = mfma16(true, Bt[n][k], At[m][k], acc[ai][bj][m][n]); } else { _Pragma("unroll") for (int m = 0; m < 4; ++m) _Pragma("unroll") for (int n = 0; n < 2; ++n) _Pragma("unroll") for (int k = 0; k < 2; ++k) \
        acc[ai][bj][m][n] = mfma16(false, Bt[n][k], At[m][k], acc[ai][bj][m][n]); } __builtin_amdgcn_s_setprio(0); } while (0)
#define PG8_WAIT_V(n) asm volatile("s_waitcnt vmcnt(" #n ")" ::: "memory")
#define PG8_WAIT_L(n) asm volatile("s_waitcnt lgkmcnt(" #n ")" ::: "memory")
#define PG8_BAR __builtin_amdgcn_s_barrier()
#define PG8_SCHED __builtin_amdgcn_sched_barrier(0)
    f32x4 acc[2][2][4][2];
#pragma unroll
    for (int a = 0; a < 2; ++a)
#pragma unroll
        for (int b = 0; b < 2; ++b)
#pragma unroll
            for (int m = 0; m < 4; ++m)
#pragma unroll
                for (int n = 0; n < 2; ++n) acc[a][b][m][n] = (f32x4){0.f, 0.f, 0.f, 0.f};
    bf16x8 At[4][2], B0[2][2], B1[2][2];
    int ui = 0;
    XOp op = Dp.op(0);
    int cK = op.K; size_t ch = (size_t)HALF * cK * 2;
    const char* cA = op.A + (size_t)pm * 2 * ch; const char* cB = op.B + (size_t)pn * 2 * ch;
    Dp.a_ready(0, pm);
    PG8_STAGEX(PG8_SB(0, 0), cB, RB, cK); PG8_STAGEX(PG8_SB(0, 1), cB + ch, RB, cK); PG8_STAGEX(PG8_SA(0, 0), cA, RA, cK); PG8_STAGEX(PG8_SA(0, 1), cA + ch, RA, cK);
    if (wr == 1) PG8_BAR;
    PG8_WAIT_V(2); PG8_BAR;
    PG8_STAGEX(PG8_SB(1, 0), cB + kstep, RB, cK); PG8_STAGEX(PG8_SA(1, 0), cA + kstep, RA, cK); PG8_STAGEX(PG8_SB(1, 1), cB + ch + kstep, RB, cK);
    PG8_WAIT_V(6); PG8_BAR;
#define PG8_SEQ_STEP(F16C) { \
        const bool has_next = ui + 1 < nsteps; \
        int nK = cK; size_t nh = ch; const char* nA = cA; const char* nB = cB; \
        if (has_next) { const XOp nop = Dp.op(ui + 1); nK = nop.K; nh = (size_t)HALF * nK * 2; nA = nop.A + (size_t)pm * 2 * nh; nB = nop.B + (size_t)pn * 2 * nh; } \
        const int nt = cK / BK; constexpr bool cf16 = (F16C); \
_Pragma("unroll 1") \
        for (int t = 0; t < nt; t += 2) { \
            const bool last = (t == nt - 2); \
            const char* a1 = cA + (size_t)(t + 1) * kstep; \
            const char* a2 = last ? nA : cA + (size_t)(t + 2) * kstep; const char* b2 = last ? nB : cB + (size_t)(t + 2) * kstep; \
            const char* a3 = a2 + kstep; const char* b3 = b2 + kstep; \
            const int xK = last ? nK : cK; const size_t xh = last ? nh : ch; \
            if (last && has_next) Dp.a_ready(ui + 1, pm); \
            PG8_LDB(B0, 0, 0); PG8_LDB(B1, 0, 1); PG8_SCHED; PG8_LDA(At, 0, 0); PG8_STAGEX(PG8_SA(1, 1), a1 + ch, RA, cK); \
            PG8_WAIT_V(8); PG8_WAIT_L(0); PG8_BAR; PG8_MMA(0, 0, At, B0); PG8_MMA(0, 1, At, B1); PG8_BAR; PG8_SCHED; \
            PG8_LDA(At, 0, 1); PG8_STAGEX(PG8_SB(0, 0), b2, RB, xK); PG8_STAGEX(PG8_SB(0, 1), b2 + xh, RB, xK); PG8_STAGEX(PG8_SA(0, 0), a2, RA, xK); \
            PG8_WAIT_V(8); PG8_WAIT_L(0); PG8_BAR; PG8_MMA(1, 0, At, B0); PG8_MMA(1, 1, At, B1); PG8_BAR; PG8_SCHED; \
            PG8_LDB(B0, 1, 0); PG8_LDB(B1, 1, 1); PG8_SCHED; PG8_LDA(At, 1, 0); PG8_STAGEX(PG8_SA(0, 1), a2 + xh, RA, xK); \
            PG8_WAIT_V(8); PG8_WAIT_L(0); PG8_BAR; PG8_MMA(0, 0, At, B0); PG8_MMA(0, 1, At, B1); PG8_BAR; PG8_SCHED; \
            PG8_LDA(At, 1, 1); PG8_STAGEX(PG8_SB(1, 0), b3, RB, xK); PG8_STAGEX(PG8_SB(1, 1), b3 + xh, RB, xK); PG8_STAGEX(PG8_SA(1, 0), a3, RA, xK); \
            PG8_WAIT_V(8); PG8_WAIT_L(0); PG8_BAR; PG8_MMA(1, 0, At, B0); PG8_MMA(1, 1, At, B1); PG8_BAR; PG8_SCHED; \
        } \
        if (wr == 0) PG8_BAR; \
        { int fr_e = fr, fq_e = fq; asm volatile("" : "+v"(fr_e), "+v"(fq_e)); Dp.epi(acc, ui, pm, pn, wr, wc, fr_e, fq_e); } \
        if (!has_next) break; \
_Pragma("unroll") \
        for (int a = 0; a < 2; ++a) \
_Pragma("unroll") \
            for (int b = 0; b < 2; ++b) \
_Pragma("unroll") \
                for (int m = 0; m < 4; ++m) \
_Pragma("unroll") \
                    for (int n = 0; n < 2; ++n) acc[a][b][m][n] = (f32x4){0.f, 0.f, 0.f, 0.f}; \
        cK = nK; ch = nh; cA = nA; cB = nB; ++ui; \
        if (wr == 1) PG8_BAR; \
    }
    for (;;) {
        PG8_SEQ_STEP(true)
        PG8_SEQ_STEP(false)
    }
#undef PG8_SEQ_STEP
    PG8_WAIT_V(0);
    PG8_BAR;
#undef PG8_SA
#undef PG8_SB
#undef PG8_STAGEX
#undef PG8_LDA
#undef PG8_LDB
#undef PG8_MMA
#undef PG8_WAIT_V
#undef PG8_WAIT_L
#undef PG8_BAR
#undef PG8_SCHED
}
struct MergeDisp {
    const char *xb, *wg, *wsb, *pa; bf16_t* gscr; bf16_t* merged; const float* ss; PG8_LAS float* tab; int tid;
    __device__ __forceinline__ XOp op(int k) const {
        XOp o; const int br = k >> 1; const bool gate = (k & 1) == 0;
        const char* ab = wsb + (size_t)(194 - 88 * br + 48 * br * br) * 1048576;
        o.A = gate ? xb : ab;
        o.B = gate ? wg + (size_t)br * (1024 * 1024 * 2) : pa + (size_t)br * (1024 * 512 * 2);
        o.K = gate ? 1024 : (br == 2 ? 256 : 512);
        return o; }
    __device__ __forceinline__ bool f16(int k) const { return (k & 1) == 0; }
    __device__ __forceinline__ void a_ready(int k, int pm) const { if ((k & 1) == 0 && tid < 256) tab[((k >> 1) & 1) * 256 + tid] = __builtin_amdgcn_rsqf(ss[pm * BM + tid] * (1.f / 1024.f) + 1e-6f); }
    __device__ __forceinline__ void epi(const f32x4 (&acc)[2][2][4][2], int k, int pm, int pn, int wr, int wc, int fr, int fq) const {
        Unit u; u.pm = pm; u.pn = pn; u.par = (k >> 1) & 1;
        if ((k & 1) == 0) { EpiActMF<1> E{gscr, 1024, tab}; E(acc, u, wr, wc, fr, fq); }
        else if (k == 1) { EpiMergeMF<0> E{gscr, merged, 1024, 0}; E(acc, u, wr, wc, fr, fq); }
        else if (k == 3) { EpiMergeMF<1> E{gscr, merged, 1024, 0}; E(acc, u, wr, wc, fr, fq); }
        else { EpiMergeMF<2> E{gscr, merged, 1024, 0}; E(acc, u, wr, wc, fr, fq); }
    }
};
}

struct Args { const float* in[31]; float* out; unsigned char* ws; int ph_lo, ph_hi; };
enum { I_X = 0, I_RELB, I_NG1, I_WIN, I_MU, I_W0, I_WUP, I_A0, I_AUP, I_GUP, I_KK, I_KA, I_RK, I_LNG, I_LNB, I_PA, I_CW, I_CB, I_LWA, I_LBA, I_LWX, I_LBX, I_LAM, I_PB,
       I_QG, I_KG, I_PC, I_WOUT, I_NG2, I_UP, I_DOWN };

struct Frame {
    LAS unsigned char* lds;
    int tid, lane, wave, vcu, G, bid;
};

__device__ __forceinline__ Frame phase_frame(const Frame& F0) {
    Frame F = F0; asm volatile("" : "+s"(F.vcu), "+s"(F.wave), "+s"(F.G), "+s"(F.bid));
    int ln; asm volatile("v_mbcnt_lo_u32_b32 %0, -1, 0\n\tv_mbcnt_hi_u32_b32 %0, -1, %0" : "=v"(ln));
    F.lane = ln; F.tid = F.wave * 64 + ln; return F;
}

typedef unsigned v4u __attribute__((ext_vector_type(4)));
__device__ __forceinline__ unsigned pk2(float lo, float hi) { return f2bf(lo) | (f2bf(hi) << 16); }
#define LDS_WAIT() asm volatile("s_waitcnt lgkmcnt(0)" ::: "memory")
template <bool SCALE = false, bool F16 = false>
__device__ __forceinline__ void transpose_item(const float* W, int ldw, int K, int nblk, bf16* WT, LAS float* scr, int item, int lane, const float* gk = nullptr) {
    const int kb = item / nblk, nb = item % nblk, k0 = 64 * kb, n0 = 32 * nb;
#pragma unroll 8
    for (int i = 0; i < 32; ++i) { const int kk = 2 * i + (lane >> 5); float w = W[(size_t)(k0 + kk) * ldw + n0 + (lane & 31)]; if (SCALE) w *= gk[k0 + kk]; scr[kk * 33 + (lane & 31)] = w; }
    LDS_WAIT(); asm volatile("" ::: "memory");
    const int c = lane & 7;
#pragma unroll
    for (int j = 0; j < 4; ++j) { const int n = (lane >> 3) + 8 * j; const LAS float* s = scr + (8 * c) * 33 + n;
        v4u o; if (F16) { o.x = pg8::cvt_pk_f16(s[0 * 33], s[1 * 33]); o.y = pg8::cvt_pk_f16(s[2 * 33], s[3 * 33]); o.z = pg8::cvt_pk_f16(s[4 * 33], s[5 * 33]); o.w = pg8::cvt_pk_f16(s[6 * 33], s[7 * 33]); }
        else { o.x = pk2(s[0 * 33], s[1 * 33]); o.y = pk2(s[2 * 33], s[3 * 33]); o.z = pk2(s[4 * 33], s[5 * 33]); o.w = pk2(s[6 * 33], s[7 * 33]); }
        *(v4u*)(WT + (size_t)(n0 + n) * K + k0 + 8 * c) = o; }
    LDS_WAIT(); asm volatile("" ::: "memory");
}
__device__ __forceinline__ void convert_wb1(Frame& F, const Args& args, int l, unsigned char* ws) {
    LAS float* scr = (LAS float*)(F.lds + F.wave * 16384);
    const int gw = F.vcu * NWAVES + F.wave, NGW = F.G * NWAVES;
    const float* w_in = args.in[I_WIN] + (size_t)l * D * DIN; const float* g1 = args.in[I_NG1] + l * D;
    constexpr int J0 = 16 * 56, J1 = 16 * 104, J2 = 16 * 96, J3 = 8 * 32, J4 = 8 * 32, J5 = 4 * 32, J6 = 16 * 32, JZ = 16;
    constexpr int NIT = J0 + J1 + J2 + J3 + J4 + J5 + J6 + JZ;
    for (int it = gw; it < NIT; it += NGW) {
        int r = it;
        if (r < J0) { transpose_item<true, true>(w_in, DIN, D, 56, (bf16*)(ws + WS_WMIX), scr, r, F.lane, g1); continue; } r -= J0;
        if (r < J1) { transpose_item<true, true>(w_in + 1824, DIN, D, 104, (bf16*)(ws + WS_WMIX) + (size_t)1792 * D, scr, r, F.lane, g1); continue; } r -= J1;
        if (r < J2) { transpose_item<true, true>(w_in + NMIX, DIN, D, 96, (bf16*)(ws + WS_WG), scr, r, F.lane, g1); continue; } r -= J2;
        if (r < J3) { transpose_item(args.in[I_PA] + (size_t)l * 512 * D, D, 512, 32, (bf16*)(ws + WS_PA), scr, r, F.lane); continue; } r -= J3;
        if (r < J4) { transpose_item(args.in[I_PB] + (size_t)l * 512 * D, D, 512, 32, (bf16*)(ws + WS_PB), scr, r, F.lane); continue; } r -= J4;
        if (r < J5) { transpose_item(args.in[I_PC] + (size_t)l * 256 * D, D, 256, 32, (bf16*)(ws + WS_PC), scr, r, F.lane); continue; } r -= J5;
        if (r < J6) { transpose_item(args.in[I_WOUT] + (size_t)l * D * D, D, D, 32, (bf16*)(ws + WS_WOUT), scr, r, F.lane); continue; } r -= J6;
        transpose_item<true, true>(w_in + 1792, DIN, D, 1, (bf16*)(ws + WS_WTAIL), scr, r, F.lane, g1);
    }
}
__device__ __forceinline__ void convert_wb2(Frame& F, const Args& args, int l, unsigned char* ws) {
    LAS float* scr = (LAS float*)(F.lds + F.wave * 16384);
    const int gw = F.vcu * NWAVES + F.wave, NGW = F.G * NWAVES;
    constexpr int J0 = 16 * 128, J1 = 64 * 32;
    for (int it = gw; it < J0 + J1; it += NGW) {
        if (it < J0) transpose_item<true, true>(args.in[I_UP] + (size_t)l * D * FF, FF, D, 128, (bf16*)(ws + WS_WUP), scr, it, F.lane, args.in[I_NG2] + l * D);
        else transpose_item(args.in[I_DOWN] + (size_t)l * FF * D, D, FF, 32, (bf16*)(ws + WS_WDOWN), scr, it - J0, F.lane);
    }
}

__device__ __forceinline__ void phase_rms(Frame& F, const float* x, const float* g, bf16* out) {
    const int gw = F.vcu * NWAVES + F.wave, NGW = F.G * NWAVES;
    typedef float f32x4 __attribute__((ext_vector_type(4)));
    for (int m = gw; m < M; m += NGW) {
        const f32x4* xr = (const f32x4*)(x + (size_t)m * D) + F.lane;
        f32x4 v[4]; float s = 0.f;
#pragma unroll
        for (int j = 0; j < 4; ++j) { v[j] = xr[64 * j]; s += (v[j].x * v[j].x + v[j].y * v[j].y) + (v[j].z * v[j].z + v[j].w * v[j].w); }
        const float rstd = 1.f / sqrtf(wave_sum(s, F.lane) * (1.f / D) + RMS_EPS);
        unsigned long long* o8 = (unsigned long long*)(out + (size_t)m * D) + F.lane;
#pragma unroll
        for (int j = 0; j < 4; ++j) {
            const f32x4 gg = *((const f32x4*)g + F.lane + 64 * j);
            const unsigned lo = f2bf(v[j].x * rstd * gg.x) | (f2bf(v[j].y * rstd * gg.y) << 16), hi = f2bf(v[j].z * rstd * gg.z) | (f2bf(v[j].w * rstd * gg.w) << 16);
            o8[64 * j] = (unsigned long long)lo | ((unsigned long long)hi << 32);
        }
    }
}

__device__ __forceinline__ void phase_x2bf(Frame& F, const float* x, bf16* out, float* ss) {
    const int gw = F.vcu * NWAVES + F.wave, NGW = F.G * NWAVES;
    typedef float f32x4 __attribute__((ext_vector_type(4)));
    for (int m = 2 * gw; m < M; m += 2 * NGW) {
        f32x4 v[2][4]; float s[2] = {0.f, 0.f};
#pragma unroll
        for (int rr = 0; rr < 2; ++rr) { const f32x4* xr = (const f32x4*)(x + (size_t)(m + rr) * D) + F.lane;
#pragma unroll
            for (int j = 0; j < 4; ++j) v[rr][j] = xr[64 * j]; }
#pragma unroll
        for (int rr = 0; rr < 2; ++rr) {
#pragma unroll
            for (int j = 0; j < 4; ++j) s[rr] += (v[rr][j].x * v[rr][j].x + v[rr][j].y * v[rr][j].y) + (v[rr][j].z * v[rr][j].z + v[rr][j].w * v[rr][j].w);
            s[rr] = wave_sum(s[rr], F.lane);
            if (F.lane == 0) ss[m + rr] = s[rr];
            unsigned long long* o8 = (unsigned long long*)(out + (size_t)(m + rr) * D) + F.lane;
#pragma unroll
            for (int j = 0; j < 4; ++j) { const unsigned lo = pg8::cvt_pk_f16(v[rr][j].x, v[rr][j].y), hi = pg8::cvt_pk_f16(v[rr][j].z, v[rr][j].w); o8[64 * j] = (unsigned long long)lo | ((unsigned long long)hi << 32); }
        }
    }
}
__device__ __forceinline__ void gemm_tile_acc(int tid, LAS float* lds, const bf16* A, int lda, const float* W, int ldw, int N, int K, int tm, int tn, float (&acc)[8][4]) {
    const int tx = tid & 31, ty = tid >> 5;
    LAS float* As = lds; LAS float* Bs = lds + 16 * 132;
    const int arow = tid >> 2, akq = (tid & 3) * 4, bk = tid >> 5, bn = (tid & 31) * 4;
    for (int k0 = 0; k0 < K; k0 += 16) {
        const unsigned long long av = *(const unsigned long long*)(A + (size_t)(tm * 128 + arow) * lda + k0 + akq);
#pragma unroll
        for (int e = 0; e < 4; ++e) As[(akq + e) * 132 + arow] = bf2f((unsigned)(av >> (16 * e)) & 0xffffu);
        const int n0 = tn * 128 + bn;
        const float* wp = W + (size_t)(k0 + bk) * ldw + n0;
#pragma unroll
        for (int e = 0; e < 4; ++e) Bs[bk * 132 + bn + e] = (n0 + e < N) ? wp[e] : 0.f;
        __syncthreads();
#pragma unroll 2
        for (int kk = 0; kk < 16; ++kk) {
            float a[8], b[4];
#pragma unroll
            for (int i = 0; i < 8; ++i) a[i] = As[kk * 132 + ty * 8 + i];
#pragma unroll
            for (int j = 0; j < 4; ++j) b[j] = Bs[kk * 132 + tx * 4 + j];
#pragma unroll
            for (int i = 0; i < 8; ++i)
#pragma unroll
                for (int j = 0; j < 4; ++j) acc[i][j] += a[i] * b[j];
        }
        __syncthreads();
    }
}
template <class Epi>
__device__ __forceinline__ void gemm_naive(Frame& F, const bf16* A, int lda, const float* W, int ldw, int N, int K, const Epi& epi) {
    const int tx = F.tid & 31, ty = F.tid >> 5;
    const int ntm = M / 128, ntn = (N + 127) / 128;
    for (int tile = F.vcu; tile < ntm * ntn; tile += F.G) {
        const int tm = tile / ntn, tn = tile % ntn;
        float acc[8][4];
#pragma unroll
        for (int i = 0; i < 8; ++i)
#pragma unroll
            for (int j = 0; j < 4; ++j) acc[i][j] = 0.f;
        gemm_tile_acc(F.tid, (LAS float*)F.lds, A, lda, W, ldw, N, K, tm, tn, acc);
#pragma unroll
        for (int i = 0; i < 8; ++i)
#pragma unroll
            for (int j = 0; j < 4; ++j) { const int m = tm * 128 + ty * 8 + i, n = tn * 128 + tx * 4 + j; if (n < N) epi(m, n, acc[i][j]); }
    }
}

struct EpiMix {
    unsigned char* ws;
    __device__ __forceinline__ void operator()(int m, int n, float v) const {
        bf16* p;
        if (n < 512) p = (bf16*)(ws + Z_R) + (size_t)m * 512 + n;
        else if (n < 1024) p = (bf16*)(ws + Z_K) + (size_t)m * 512 + (n - 512);
        else if (n < 1536) p = (bf16*)(ws + Z_V) + (size_t)m * 512 + (n - 1024);
        else if (n < 1824) p = (bf16*)(ws + Z_L) + (size_t)m * 288 + (n - 1536);
        else if (n < 2336) p = (bf16*)(ws + Z_BX) + (size_t)m * 512 + (n - 1824);
        else if (n < 2848) p = (bf16*)(ws + Z_BY) + (size_t)m * 512 + (n - 2336);
        else if (n < 3616) p = (bf16*)(ws + A_Q) + (size_t)m * 768 + (n - 2848);
        else if (n < 4384) p = (bf16*)(ws + A_K) + (size_t)m * 768 + (n - 3616);
        else p = (bf16*)(ws + A_V) + (size_t)m * 768 + (n - 4384);
        *p = (bf16)f2bf(v);
    }
};
struct EpiGate { bf16* o; __device__ __forceinline__ void operator()(int m, int n, float v) const { o[(size_t)m * NGATE + n] = (bf16)f2bf(sigmoidf_(v)); } };
struct EpiBf { bf16* o; int ld; __device__ __forceinline__ void operator()(int m, int n, float v) const { o[(size_t)m * ld + n] = (bf16)f2bf(v); } };
struct EpiRelu2 { bf16* o; int ld; __device__ __forceinline__ void operator()(int m, int n, float v) const { const float r = v > 0.f ? v : 0.f; o[(size_t)m * ld + n] = (bf16)f2bf(r * r); } };
struct EpiRes { const float* base; float* o; __device__ __forceinline__ void operator()(int m, int n, float v) const { o[(size_t)m * D + n] = base[(size_t)m * D + n] + v; } };

__device__ __forceinline__ void phase_merge_naive(Frame& F, const bf16* OA, const bf16* OB, const bf16* OC, const float* pa, const float* pb, const float* pc, const bf16* gates, bf16* out) {
    const int tx = F.tid & 31, ty = F.tid >> 5;
    const int ntm = M / 128, ntn = D / 128;
    for (int tile = F.vcu; tile < ntm * ntn; tile += F.G) {
        const int tm = tile / ntn, tn = tile % ntn;
        float tot[8][4];
#pragma unroll
        for (int i = 0; i < 8; ++i)
#pragma unroll
            for (int j = 0; j < 4; ++j) tot[i][j] = 0.f;
#pragma unroll 1
        for (int br = 0; br < 3; ++br) {
            float acc[8][4];
#pragma unroll
            for (int i = 0; i < 8; ++i)
#pragma unroll
                for (int j = 0; j < 4; ++j) acc[i][j] = 0.f;
            const bf16* A = br == 0 ? OA : (br == 1 ? OB : OC); const int lda = br == 2 ? 256 : 512; const float* W = br == 0 ? pa : (br == 1 ? pb : pc);
            gemm_tile_acc(F.tid, (LAS float*)F.lds, A, lda, W, D, D, lda, tm, tn, acc);
#pragma unroll
            for (int i = 0; i < 8; ++i)
#pragma unroll
                for (int j = 0; j < 4; ++j) { const int m = tm * 128 + ty * 8 + i, n = tn * 128 + tx * 4 + j; tot[i][j] += bf2f(gates[(size_t)m * NGATE + br * D + n]) * acc[i][j]; }
        }
#pragma unroll
        for (int i = 0; i < 8; ++i)
#pragma unroll
            for (int j = 0; j < 4; ++j) { const int m = tm * 128 + ty * 8 + i, n = tn * 128 + tx * 4 + j; out[(size_t)m * D + n] = (bf16)f2bf(tot[i][j]); }
    }
}

struct RwkvP { const float *mu, *w0, *w_up, *a0, *a_up, *g_up, *k_k, *k_a, *r_k, *ln_g, *ln_b; };
__device__ __forceinline__ void rwkv_naive_item(Frame& F, unsigned char* ws, const RwkvP& P, int b, int h) {
    LAS float* L = (LAS float*)F.lds;
    LAS float* Lr = L;
    LAS float* Lk = L + 1024;
    LAS float* Lv = L + 2048;
    LAS float* Ltw = L + 3072;
    LAS float* Lxa = L + 4096;
    LAS float* Lsg = L + 5120;
    LAS float* Lw = L + 7680;
    LAS float* La = L + 8704;
    LAS float* Lg = L + 9728;
    LAS float* Lan = L + 10752;
    LAS float* Lb = L + 11776;
    LAS float* Lbo = L + 12800;
    const bf16* ZR = (const bf16*)(ws + Z_R); const bf16* ZK = (const bf16*)(ws + Z_K); const bf16* ZV = (const bf16*)(ws + Z_V); const bf16* ZL = (const bf16*)(ws + Z_L);
    bf16* OA = (bf16*)(ws + WS_OA);
    const int tid = F.tid, lane = F.lane, wave = F.wave;
    typedef float f32x4s __attribute__((ext_vector_type(4)));
    LAS f32x4s* Ls = (LAS f32x4s*)(L + 13312);
    if (wave == 0) {
#pragma unroll
        for (int j4 = 0; j4 < 16; ++j4) Ls[j4 * 64 + lane] = (f32x4s){0.f, 0.f, 0.f, 0.f};
    }
#pragma unroll 1
    for (int blk = 0; blk < SEQ / 16; ++blk) {
        const int t0 = blk * 16;
#pragma unroll 1
        for (int idx = tid; idx < 16 * 480; idx += NTHR) {
            const int tt = idx / 480, c = idx % 480; const int t = t0 + tt; const size_t m = (size_t)b * SEQ + t;
            float cur, prev = 0.f, mu;
            if (c < 192) { const int which = c / 64, j = c % 64, col = h * 64 + j; const bf16* Zp = which == 0 ? ZR : (which == 1 ? ZK : ZV);
                cur = bf2f(Zp[m * 512 + col]); if (t > 0) prev = bf2f(Zp[(m - 1) * 512 + col]); mu = P.mu[which * 512 + col];
                const float f = cur + (prev - cur) * mu; (which == 0 ? Lr : (which == 1 ? Lk : Lv))[tt * 64 + j] = f;
            } else { const int cc = c - 192;
                cur = bf2f(ZL[m * 288 + cc]); if (t > 0) prev = bf2f(ZL[(m - 1) * 288 + cc]); mu = P.mu[1536 + cc];
                const float f = cur + (prev - cur) * mu;
                if (cc < 64) Ltw[tt * 64 + cc] = tanhf(f); else if (cc < 128) Lxa[tt * 64 + cc - 64] = f; else Lsg[tt * 160 + cc - 128] = sigmoidf_(f);
            }
        }
        __syncthreads();
#pragma unroll 1
        for (int idx = tid; idx < 1024; idx += NTHR) {
            const int tt = idx >> 6, j = idx & 63, col = h * 64 + j;
            float wl = P.w0[col], al = P.a0[col], gg = 0.f;
#pragma unroll 4
            for (int c = 0; c < 64; ++c) { wl += Ltw[tt * 64 + c] * P.w_up[c * 512 + col]; al += Lxa[tt * 64 + c] * P.a_up[c * 512 + col]; }
#pragma unroll 4
            for (int c = 0; c < 160; ++c) gg += Lsg[tt * 160 + c] * P.g_up[c * 512 + col];
            const float w = -softplusf_(-wl) - 0.5f;
            Lw[idx] = expf(-expf(w)); La[idx] = sigmoidf_(al); Lg[idx] = gg;
        }
        __syncthreads();
#pragma unroll
        for (int q = 0; q < 2; ++q) {
            const int tt = 2 * wave + q, col = h * 64 + lane;
            const float kraw = Lk[tt * 64 + lane], kkv = kraw * P.k_k[col];
            const float n2 = wave_sum(kkv * kkv, lane); const float kkn = kkv / fmaxf(sqrtf(n2), 1e-12f);
            const float a = La[tt * 64 + lane]; const float kmod = kraw * (1.f + (a - 1.f) * P.k_a[col]);
            const float bo = wave_sum(Lr[tt * 64 + lane] * kmod * P.r_k[col], lane);
            Lk[tt * 64 + lane] = kmod; Lan[tt * 64 + lane] = -kkn; Lb[tt * 64 + lane] = kkn * a;
            if (lane == 0) Lbo[tt] = bo;
        }
        __syncthreads();
        if (wave == 0) {
            const int col = h * 64 + lane; const float lng = P.ln_g[col], lnb = P.ln_b[col];
            float S[64];
#pragma unroll
            for (int j4 = 0; j4 < 16; ++j4) { const f32x4s s4 = Ls[j4 * 64 + lane]; S[4 * j4] = s4.x; S[4 * j4 + 1] = s4.y; S[4 * j4 + 2] = s4.z; S[4 * j4 + 3] = s4.w; }
#pragma unroll 1
            for (int tt = 0; tt < 16; ++tt) {
                typedef float f32x4 __attribute__((ext_vector_type(4)));
                float sa = 0.f;
#pragma unroll
                for (int j4 = 0; j4 < 16; ++j4) { const f32x4 an = *(const LAS f32x4*)(Lan + tt * 64 + 4 * j4);
                    sa += S[4 * j4] * an.x + S[4 * j4 + 1] * an.y + S[4 * j4 + 2] * an.z + S[4 * j4 + 3] * an.w; __builtin_amdgcn_sched_barrier(0); }
                const float vi = Lv[tt * 64 + lane]; float y = 0.f;
#pragma unroll
                for (int j4 = 0; j4 < 16; ++j4) {
                    const f32x4 w4 = *(const LAS f32x4*)(Lw + tt * 64 + 4 * j4), b4 = *(const LAS f32x4*)(Lb + tt * 64 + 4 * j4), k4 = *(const LAS f32x4*)(Lk + tt * 64 + 4 * j4), r4 = *(const LAS f32x4*)(Lr + tt * 64 + 4 * j4);
                    S[4 * j4] = S[4 * j4] * w4.x + sa * b4.x + vi * k4.x; S[4 * j4 + 1] = S[4 * j4 + 1] * w4.y + sa * b4.y + vi * k4.y;
                    S[4 * j4 + 2] = S[4 * j4 + 2] * w4.z + sa * b4.z + vi * k4.z; S[4 * j4 + 3] = S[4 * j4 + 3] * w4.w + sa * b4.w + vi * k4.w;
                    y += S[4 * j4] * r4.x + S[4 * j4 + 1] * r4.y + S[4 * j4 + 2] * r4.z + S[4 * j4 + 3] * r4.w; __builtin_amdgcn_sched_barrier(0); }
                const float mean = wave_sum(y, lane) * (1.f / 64.f); const float dy = y - mean; const float var = wave_sum(dy * dy, lane) * (1.f / 64.f);
                const float o = (dy * (1.f / sqrtf(var + GN_EPS)) * lng + lnb + Lbo[tt] * vi) * Lg[tt * 64 + lane];
                OA[((size_t)b * SEQ + t0 + tt) * 512 + col] = (bf16)f2bf(o);
            }
#pragma unroll
            for (int j4 = 0; j4 < 16; ++j4) Ls[j4 * 64 + lane] = (f32x4s){S[4 * j4], S[4 * j4 + 1], S[4 * j4 + 2], S[4 * j4 + 3]};
        }
        __syncthreads();
    }
}

__device__ __forceinline__ void lds_barrier() { asm volatile("s_waitcnt lgkmcnt(0)" ::: "memory"); __builtin_amdgcn_s_barrier(); asm volatile("" ::: "memory"); }
namespace rk {
typedef short bf16x8 __attribute__((ext_vector_type(8)));
typedef float f32x4 __attribute__((ext_vector_type(4)));
typedef unsigned u32x4 __attribute__((ext_vector_type(4)));
typedef unsigned u32x2 __attribute__((ext_vector_type(2)));
constexpr int T = 32, SEGLEN = 512, NSEG = SEQ / SEGLEN, TS = 36;
constexpr int O_WUPT = 0, O_AUPT = O_WUPT + 9216, O_GUPT = O_AUPT + 9216, O_VEC = O_GUPT + 21504;
constexpr int O_XR = O_VEC + 3712, O_XK = O_XR + 8192, O_XV = O_XK + 8192, O_LIN = O_XV + 8192;
constexpr int O_TXW = O_LIN, O_XA = O_LIN + 4608, O_SG = O_LIN + 9216;
constexpr int O_AT = O_LIN, O_RT = O_LIN + 4608, O_BT = O_LIN + 9216, O_KT = O_LIN + 13824;
constexpr int O_DEC = O_LIN + 19968, O_AA = O_DEC + 8192, O_GG = O_AA + 8192, O_SC = O_GG + 8192;
constexpr int O_BTT = O_SC + 256, O_KTT = O_BTT + 4608, O_VT = O_KTT + 4608, O_WL = O_VT + 4608;
constexpr int O_NM = O_WL + 512, O_AAK = O_NM + 2048, O_ARB = O_AAK + 2048, O_ARK = O_ARB + 1024, O_AH = O_ARK + 1024, O_AKH = O_AH + 4608, O_ATF = O_AKH + 1024, O_YB = O_ATF + 8192, O_END = O_YB + 8192;
static_assert(O_END <= 163840 - 512, "rwkv LDS map");
constexpr int V_W0 = 0, V_A0 = 64, V_KK = 128, V_KA = 192, V_RK = 256, V_LNG = 320, V_LNB = 384, V_MUR = 448, V_MUL = 640;

__device__ __forceinline__ unsigned cvtpk(float lo, float hi) { return pg8::cvt_pk_bf16(lo, hi); }
__device__ __forceinline__ bf16x8 mk8(u32x2 lo, u32x2 hi) { u32x4 v = {lo.x, lo.y, hi.x, hi.y}; return __builtin_bit_cast(bf16x8, v); }
__device__ __forceinline__ float shx(float v, int o, int lane) { return __builtin_bit_cast(float, __builtin_amdgcn_ds_bpermute((lane ^ o) << 2, __builtin_bit_cast(int, v))); }
__device__ __forceinline__ float row_sum16(float x) {
    x += __builtin_bit_cast(float, __builtin_amdgcn_update_dpp(0, __builtin_bit_cast(int, x), 0x128, 0xf, 0xf, true));
    x += __builtin_bit_cast(float, __builtin_amdgcn_update_dpp(0, __builtin_bit_cast(int, x), 0x124, 0xf, 0xf, true));
    x += __builtin_bit_cast(float, __builtin_amdgcn_update_dpp(0, __builtin_bit_cast(int, x), 0x122, 0xf, 0xf, true));
    x += __builtin_bit_cast(float, __builtin_amdgcn_update_dpp(0, __builtin_bit_cast(int, x), 0x121, 0xf, 0xf, true));
    return x; }
#define RK_MFMA(a, b, c) __builtin_amdgcn_mfma_f32_16x16x32_bf16((a), (b), (c), 0, 0, 0)

template <int PART  >
__device__ __forceinline__ void lora_inputs(Frame& F, unsigned char* ws, const float* mu, const float* ss) {
    const bf16* ZL = (const bf16*)(ws + Z_L); bf16* ZT = (bf16*)(ws + WS_ZT);
    LAS float* Zt = (LAS float*)(F.lds + 67584);
    const int lane = F.lane, wave = F.wave, tid = F.tid, fr = lane & 15, fq = lane >> 4;
    if constexpr (PART == 0) {
    { u32x4 wv[8];
#pragma unroll
      for (int k = 0; k < 8; ++k) { const int i = tid + NTHR * k, n = i >> 7, c = i & 127; wv[k] = *(const u32x4*)((const bf16*)(ws + WS_WTAIL) + (size_t)n * D + 8 * c); }
#pragma unroll
      for (int k = 0; k < 8; ++k) { const int i = tid + NTHR * k, n = i >> 7, c = i & 127; *(LAS u32x4*)(F.lds + n * 2064 + c * 16) = wv[k]; } }
    __syncthreads();
#pragma unroll 1
    for (int blk = F.vcu; blk < M / 64; blk += F.G) {
        const int r0 = 64 * blk;
        if (tid < 32) Zt[tid] = 0.f;
        __syncthreads();
        if (wave < 4) {
            const int mt = wave, row = r0 + 16 * mt + fr;
            const bf16x8* ap = (const bf16x8*)((const bf16*)(ws + WS_XB) + (size_t)row * D + 8 * fq);
            bf16x8 af[32];
#pragma unroll
            for (int s = 0; s < 32; ++s) af[s] = ap[4 * s];
            f32x4 acc0 = (f32x4){0.f, 0.f, 0.f, 0.f}, acc1 = acc0;
#pragma unroll
            for (int s = 0; s < 32; ++s) { acc0 = pg8::mfma16(true, af[s], *(const LAS bf16x8*)(F.lds + fr * 2064 + (32 * s + 8 * fq) * 2), acc0); acc1 = pg8::mfma16(true, af[s], *(const LAS bf16x8*)(F.lds + (16 + fr) * 2064 + (32 * s + 8 * fq) * 2), acc1); }
#pragma unroll
            for (int r = 0; r < 4; ++r) { const int rl = 16 * mt + 4 * fq + r; const float rs = __builtin_amdgcn_rsqf(ss[r0 + rl] * (1.f / 1024.f) + RMS_EPS);
                Zt[(rl + 1) * 33 + fr] = acc0[r] * rs; Zt[(rl + 1) * 33 + 16 + fr] = acc1[r] * rs; }
        } else if ((r0 & (SEQ - 1)) != 0) {
            const int t2 = tid - 256, c = t2 & 31, kc = t2 >> 5;
            const u32x4* xp = (const u32x4*)((const bf16*)(ws + WS_XB) + (size_t)(r0 - 1) * D + 128 * kc);
            float s = 0.f;
#pragma unroll 4
            for (int i = 0; i < 16; ++i) { const u32x4 xv = xp[i]; const u32x4 wv = *(const LAS u32x4*)(F.lds + c * 2064 + (128 * kc + 8 * i) * 2);
#pragma unroll
                for (int e = 0; e < 4; ++e) s += pg8::hfl(xv[e]) * pg8::hfl(wv[e]) + pg8::hfh(xv[e]) * pg8::hfh(wv[e]); }
            s += shx(s, 32, lane);
            if (lane < 32) atomicAdd((float*)&Zt[c], s * __builtin_amdgcn_rsqf(ss[r0 - 1] * (1.f / 1024.f) + RMS_EPS));
        }
        __syncthreads();
        {
            const int i = tid >> 3, c4 = (tid & 7) * 4; const int m = r0 + i;
            float f[4];
#pragma unroll
            for (int e = 0; e < 4; ++e) { const float cur = Zt[(i + 1) * 33 + c4 + e], prev = (m & (SEQ - 1)) ? Zt[i * 33 + c4 + e] : 0.f; const float v = cur + (prev - cur) * mu[1536 + 256 + c4 + e];
                f[e] = __builtin_amdgcn_rcpf(1.f + __expf(-v)); }
            *(u32x2*)(ZT + (size_t)m * 224 + 192 + c4) = (u32x2){cvtpk(f[0], f[1]), cvtpk(f[2], f[3])};
        }
        __syncthreads();
    }
    } else {
    const int stride = F.G * NTHR;
    for (int it0 = F.vcu * NTHR + F.tid; it0 < M * 24; it0 += 3 * stride) {
        u32x4 cuv[3], puv[3];
#pragma unroll
        for (int u = 0; u < 3; ++u) { const int it = it0 + u * stride; cuv[u] = (u32x4){0u, 0u, 0u, 0u}; puv[u] = cuv[u];
            if (it < M * 24) { const int m = it / 24, p = it - m * 24; const int cc = p < 8 ? 8 * p : 128 + 8 * (p - 8);
                cuv[u] = *(const u32x4*)(ZL + (size_t)m * 288 + cc); if ((m & (SEQ - 1)) != 0) puv[u] = *(const u32x4*)(ZL + (size_t)(m - 1) * 288 + cc); } }
#pragma unroll
        for (int u = 0; u < 3; ++u) { const int it = it0 + u * stride; if (it < M * 24) { const int m = it / 24, p = it - m * 24; const int cc = p < 8 ? 8 * p : 128 + 8 * (p - 8);
            const u32x4 cu = cuv[u], pu = puv[u];
            float f[8];
#pragma unroll
            for (int e = 0; e < 4; ++e) { const float c0 = bf2f(cu[e] & 0xffffu), c1 = bf2f(cu[e] >> 16), p0 = bf2f(pu[e] & 0xffffu), p1 = bf2f(pu[e] >> 16);
                f[2 * e] = c0 + (p0 - c0) * mu[1536 + cc + 2 * e]; f[2 * e + 1] = c1 + (p1 - c1) * mu[1536 + cc + 2 * e + 1]; }
            if (p < 8) {
#pragma unroll
                for (int e = 0; e < 8; ++e) f[e] = 1.f - 2.f * __builtin_amdgcn_rcpf(1.f + __expf(2.f * f[e])); }
            else {
#pragma unroll
                for (int e = 0; e < 8; ++e) f[e] = __builtin_amdgcn_rcpf(1.f + __expf(-f[e])); }
            *(u32x4*)(ZT + (size_t)m * 224 + 8 * p) = (u32x4){cvtpk(f[0], f[1]), cvtpk(f[2], f[3]), cvtpk(f[4], f[5]), cvtpk(f[6], f[7])}; } }
    }
    }
}
template <int PASS>
__device__ __forceinline__ void item(Frame& F, unsigned char* ws, const RwkvP& P, int b, int h, int g) {
    LAS unsigned char* L = F.lds;
    const int tid = F.tid, lane = F.lane, wave = F.wave, fr = lane & 15, fq = lane >> 4;
    LAS float* VEC = (LAS float*)(L + O_VEC);
    const bf16* ZR = (const bf16*)(ws + Z_R); const bf16* ZK = (const bf16*)(ws + Z_K); const bf16* ZV = (const bf16*)(ws + Z_V); const bf16* ZL = (const bf16*)(ws + Z_L);
    float* SEGPQ = (float*)(ws + WS_RKPQ);
    const int itm = (b * 8 + h) * NSEG + g;
    {
        const int j = tid & 63, cg = tid >> 6;
        { float v[8];
#pragma unroll
          for (int e = 0; e < 8; ++e) v[e] = P.w_up[(cg * 8 + e) * 512 + h * 64 + j];
          *(LAS u32x4*)(L + O_WUPT + (j * 72 + cg * 8) * 2) = (u32x4){cvtpk(v[0], v[1]), cvtpk(v[2], v[3]), cvtpk(v[4], v[5]), cvtpk(v[6], v[7])};
#pragma unroll
          for (int e = 0; e < 8; ++e) v[e] = P.a_up[(cg * 8 + e) * 512 + h * 64 + j];
          *(LAS u32x4*)(L + O_AUPT + (j * 72 + cg * 8) * 2) = (u32x4){cvtpk(v[0], v[1]), cvtpk(v[2], v[3]), cvtpk(v[4], v[5]), cvtpk(v[6], v[7])}; }
#pragma unroll 1
        for (int c8 = cg; c8 < 20; c8 += 8) { float v[8];
#pragma unroll
          for (int e = 0; e < 8; ++e) v[e] = P.g_up[(c8 * 8 + e) * 512 + h * 64 + j];
          *(LAS u32x4*)(L + O_GUPT + (j * 168 + c8 * 8) * 2) = (u32x4){cvtpk(v[0], v[1]), cvtpk(v[2], v[3]), cvtpk(v[4], v[5]), cvtpk(v[6], v[7])}; }
        if (tid < 64) { const int c = h * 64 + tid; VEC[V_W0 + tid] = P.w0[c]; VEC[V_A0 + tid] = P.a0[c]; VEC[V_KK + tid] = P.k_k[c]; VEC[V_KA + tid] = P.k_a[c]; VEC[V_RK + tid] = P.r_k[c];
            VEC[V_LNG + tid] = P.ln_g[c]; VEC[V_LNB + tid] = P.ln_b[c]; VEC[V_MUR + tid] = P.mu[c]; VEC[V_MUR + 64 + tid] = P.mu[512 + c]; VEC[V_MUR + 128 + tid] = P.mu[1024 + c]; }
        if (tid < 288) VEC[V_MUL + tid] = P.mu[1536 + tid];
    }
    f32x4 Sreg[4];
    const int i0 = 16 * (wave & 3);
#pragma unroll
    for (int jt = 0; jt < 4; ++jt) Sreg[jt] = (f32x4){0.f, 0.f, 0.f, 0.f};
    if (PASS == 0) { if (wave >= 4) {
#pragma unroll
        for (int jt = 0; jt < 4; ++jt)
#pragma unroll
            for (int r = 0; r < 4; ++r) Sreg[jt][r] = (16 * jt + 4 * fq + r == i0 + fr) ? 1.f : 0.f; } }
    else if (wave < 4 && g > 0) {
        const float* Pb = SEGPQ + (size_t)((b * 8 + h) * NSEG) * 8192;
        f32x4 praw[4][2][2]; f32x4 qraw[4];
#define FOLD_LOAD_JT(GP, jt) do { const float* Pm_ = Pb + (size_t)(GP) * 8192; const float* Qm_ = Pm_ + 4096; \
            _Pragma("unroll") for (int r = 0; r < 4; ++r) qraw[jt][r] = Qm_[(16 * (jt) + 4 * fq + r) * 64 + i0 + fr]; \
            _Pragma("unroll") for (int s = 0; s < 2; ++s) { praw[jt][s][0] = *(const f32x4*)(Pm_ + (16 * (jt) + fr) * 64 + 32 * s + 4 * fq); praw[jt][s][1] = *(const f32x4*)(Pm_ + (16 * (jt) + fr) * 64 + 32 * s + 16 + 4 * fq); } } while (0)
#pragma unroll
        for (int jt = 0; jt < 4; ++jt) FOLD_LOAD_JT(0, jt);
#pragma unroll 1
        for (int gp = 0; gp < g; ++gp) {
            bf16x8 Sh[2], Sl[2];
#pragma unroll
            for (int s = 0; s < 2; ++s) { unsigned hi[4], lo[4];
#pragma unroll
                for (int e = 0; e < 4; ++e) { const float x0 = Sreg[2 * s + (e >> 1)][2 * (e & 1)], x1 = Sreg[2 * s + (e >> 1)][2 * (e & 1) + 1];
                    hi[e] = cvtpk(x0, x1); lo[e] = cvtpk(x0 - bf2f(hi[e] & 0xffffu), x1 - bf2f(hi[e] >> 16)); }
                Sh[s] = __builtin_bit_cast(bf16x8, (u32x4){hi[0], hi[1], hi[2], hi[3]}); Sl[s] = __builtin_bit_cast(bf16x8, (u32x4){lo[0], lo[1], lo[2], lo[3]}); }
            f32x4 Sn[4];
#pragma unroll
            for (int jt = 0; jt < 4; ++jt) {
                bf16x8 Ph[2], Pl[2]; Sn[jt] = qraw[jt];
#pragma unroll
                for (int s = 0; s < 2; ++s) { const f32x4 p0 = praw[jt][s][0], p1 = praw[jt][s][1]; unsigned hi[4], lo[4];
                    hi[0] = cvtpk(p0[0], p0[1]); hi[1] = cvtpk(p0[2], p0[3]); hi[2] = cvtpk(p1[0], p1[1]); hi[3] = cvtpk(p1[2], p1[3]);
                    lo[0] = cvtpk(p0[0] - bf2f(hi[0] & 0xffffu), p0[1] - bf2f(hi[0] >> 16)); lo[1] = cvtpk(p0[2] - bf2f(hi[1] & 0xffffu), p0[3] - bf2f(hi[1] >> 16));
                    lo[2] = cvtpk(p1[0] - bf2f(hi[2] & 0xffffu), p1[1] - bf2f(hi[2] >> 16)); lo[3] = cvtpk(p1[2] - bf2f(hi[3] & 0xffffu), p1[3] - bf2f(hi[3] >> 16));
                    Ph[s] = __builtin_bit_cast(bf16x8, (u32x4){hi[0], hi[1], hi[2], hi[3]}); Pl[s] = __builtin_bit_cast(bf16x8, (u32x4){lo[0], lo[1], lo[2], lo[3]}); }
                if (gp + 1 < g) FOLD_LOAD_JT(gp + 1, jt);
#pragma unroll
                for (int s = 0; s < 2; ++s) { Sn[jt] = RK_MFMA(Ph[s], Sh[s], Sn[jt]); Sn[jt] = RK_MFMA(Ph[s], Sl[s], Sn[jt]); Sn[jt] = RK_MFMA(Pl[s], Sh[s], Sn[jt]); }
            }
#pragma unroll
            for (int jt = 0; jt < 4; ++jt) Sreg[jt] = Sn[jt];
        }
#undef FOLD_LOAD_JT
    }
    __syncthreads();
    const int tseg0 = g * SEGLEN;
    u32x4 pre[5];
    {
        int ln0; asm volatile("v_mbcnt_lo_u32_b32 %0, -1, 0\n\tv_mbcnt_hi_u32_b32 %0, -1, %0" : "=v"(ln0));
        const int t0 = wave * 64 + ln0, cp = t0 % 60, rg = t0 / 60;
        const bf16* ZT = (const bf16*)(ws + WS_ZT);
        const bf16* src = cp < 8 ? ZR : (cp < 16 ? ZK : (cp < 24 ? ZV : (cp < 32 ? ZL : ZT))); const int ld = cp < 24 ? 512 : (cp < 32 ? 288 : 224), col = cp < 24 ? h * 64 + 8 * (cp & 7) : (cp < 32 ? 64 + 8 * (cp - 24) : 8 * (cp - 32));
#pragma unroll
        for (int e = 0; e < 5; ++e) { const int tt = tseg0 + 4 * rg - 1 + e; pre[e] = (u32x4){0u, 0u, 0u, 0u};
            if (t0 < 480 && tt >= 0 && (PASS == 1 || cp < 40)) pre[e] = *(const u32x4*)(src + ((size_t)b * SEQ + tt) * ld + col); }
    }
#pragma unroll 1
    for (int ch = 0; ch < SEGLEN / T; ++ch) {
        int lane_c; asm volatile("v_mbcnt_lo_u32_b32 %0, -1, 0\n\tv_mbcnt_hi_u32_b32 %0, -1, %0" : "=v"(lane_c));
        const int lane = lane_c, tid = wave * 64 + lane, fr = lane & 15, fq = lane >> 4;
        const int tc0 = tseg0 + ch * T;
        const size_t m0 = (size_t)b * SEQ + tc0;
        if (PASS == 1 && ch > 0) {
            const int t = tid >> 4, iq = tid & 15;
            const f32x4 y = *(const LAS f32x4*)(L + O_YB + (t * 64 + 4 * iq) * 4);
            float s1 = (y[0] + y[1]) + (y[2] + y[3]);
#pragma unroll
            for (int o = 1; o < 16; o <<= 1) s1 += shx(s1, o, lane);
            const float mean = s1 * (1.f / 64.f); const f32x4 dy = y - mean;
            float s2 = (dy[0] * dy[0] + dy[1] * dy[1]) + (dy[2] * dy[2] + dy[3] * dy[3]);
#pragma unroll
            for (int o = 1; o < 16; o <<= 1) s2 += shx(s2, o, lane);
            const float rstd = __builtin_amdgcn_rsqf(s2 * (1.f / 64.f) + GN_EPS), bo = ((LAS float*)(L + O_SC))[32 + t];
            const f32x4 gg = *(const LAS f32x4*)(L + O_GG + (t * 64 + 4 * iq) * 4);
            float o4[4];
#pragma unroll
            for (int e = 0; e < 4; ++e) { const int i = 4 * iq + e; const float vv = bf2f(((const LAS bf16*)(L + O_VT))[i * TS + t]); o4[e] = (dy[e] * rstd * VEC[V_LNG + i] + VEC[V_LNB + i] + bo * vv) * gg[e]; }
            *(u32x2*)((bf16*)(ws + WS_OA) + (m0 - T + t) * 512 + h * 64 + 4 * iq) = (u32x2){cvtpk(o4[0], o4[1]), cvtpk(o4[2], o4[3])};
        }
        for (int rp_ = 0; rp_ < ((RK_REP == 1) ? 3 : 1); ++rp_) {
        if (tid < 480 && (PASS == 1 || (tid % 60) < 40)) {
            const int cp = tid % 60, rg = tid / 60;
            if (cp < 32) {
                const int which = cp >> 3, p = cp & 7;
                const LAS float* muv = which < 3 ? VEC + V_MUR + which * 64 + 8 * p : VEC + V_MUL + 64 + 8 * p;
                float mu[8];
#pragma unroll
                for (int e = 0; e < 8; ++e) mu[e] = muv[e];
#pragma unroll
                for (int rr = 0; rr < 4; ++rr) { const int t = 4 * rg + rr; const u32x4 cu = pre[rr + 1], pu = pre[rr];
                    float f[8];
#pragma unroll
                    for (int e = 0; e < 4; ++e) { const float c0 = bf2f(cu[e] & 0xffffu), c1 = bf2f(cu[e] >> 16), p0 = bf2f(pu[e] & 0xffffu), p1 = bf2f(pu[e] >> 16);
                        f[2 * e] = c0 + (p0 - c0) * mu[2 * e]; f[2 * e + 1] = c1 + (p1 - c1) * mu[2 * e + 1]; }
                    if (which < 3) { LAS float* dst = (LAS float*)(L + (which == 0 ? O_XR : (which == 1 ? O_XK : O_XV))) + t * 64 + 8 * p;
                        *(LAS f32x4*)dst = (f32x4){f[0], f[1], f[2], f[3]}; *(LAS f32x4*)(dst + 4) = (f32x4){f[4], f[5], f[6], f[7]}; }
                    else *(LAS u32x4*)(L + O_XA + (t * 72 + 8 * p) * 2) = (u32x4){cvtpk(f[0], f[1]), cvtpk(f[2], f[3]), cvtpk(f[4], f[5]), cvtpk(f[6], f[7])};
                }
            } else {
#pragma unroll
                for (int rr = 0; rr < 4; ++rr) { const int t = 4 * rg + rr;
                    if (cp < 40) *(LAS u32x4*)(L + O_TXW + (t * 72 + 8 * (cp - 32)) * 2) = pre[rr + 1];
                    else *(LAS u32x4*)(L + O_SG + (t * 168 + 8 * (cp - 40)) * 2) = pre[rr + 1]; }
            }
            if (ch + 1 < SEGLEN / T && (RK_REP != 1 || rp_ == 2)) {
                const bf16* ZT = (const bf16*)(ws + WS_ZT);
                const bf16* src = cp < 8 ? ZR : (cp < 16 ? ZK : (cp < 24 ? ZV : (cp < 32 ? ZL : ZT))); const int ld = cp < 24 ? 512 : (cp < 32 ? 288 : 224), col = cp < 24 ? h * 64 + 8 * (cp & 7) : (cp < 32 ? 64 + 8 * (cp - 24) : 8 * (cp - 32));
#pragma unroll
                for (int e = 0; e < 5; ++e) pre[e] = *(const u32x4*)(src + (m0 + T + 4 * rg - 1 + e) * ld + col);
            }
        }
        __syncthreads();
        }
        for (int rp_ = 0; rp_ < ((RK_REP == 2) ? 3 : 1); ++rp_) {
        {
            const int nt = wave & 3, jn = 16 * nt + fr;
            if (wave < 4) {
                f32x4 aw[2];
#pragma unroll
                for (int mt = 0; mt < 2; ++mt) aw[mt] = (f32x4){0.f, 0.f, 0.f, 0.f};
#pragma unroll
                for (int s = 0; s < 2; ++s) {
                    const bf16x8 bw = *(const LAS bf16x8*)(L + O_WUPT + (jn * 72 + 32 * s + 8 * fq) * 2);
#pragma unroll
                    for (int mt = 0; mt < 2; ++mt) { const bf16x8 xw = *(const LAS bf16x8*)(L + O_TXW + ((16 * mt + fr) * 72 + 32 * s + 8 * fq) * 2); aw[mt] = RK_MFMA(xw, bw, aw[mt]); }
                }
                const float w0 = VEC[V_W0 + jn];
#pragma unroll
                for (int mt = 0; mt < 2; ++mt) {
                    float ldv[4];
#pragma unroll
                    for (int r = 0; r < 4; ++r) {
                        const float xq = -(aw[mt][r] + w0);
                        const float sp = fmaxf(xq, 0.f) + __logf(1.f + __expf(-fabsf(xq)));
                        ldv[r] = -__expf(-sp - 0.5f); }
                    ldv[1] += ldv[0]; ldv[2] += ldv[1]; ldv[3] += ldv[2];
                    const float tot = ldv[3];
                    const float s1 = shx(tot, 16, lane);
                    const float pair = tot + s1;
                    const float s2 = shx(pair, 32, lane);
                    const float excl = ((fq & 1) ? s1 : 0.f) + ((fq & 2) ? s2 : 0.f);
#pragma unroll
                    for (int r = 0; r < 4; ++r) ((LAS float*)(L + O_DEC))[(16 * mt + 4 * fq + r) * 64 + jn] = ldv[r] + excl;
                }
            } else {
                f32x4 ai[2], ag[2];
#pragma unroll
                for (int mt = 0; mt < 2; ++mt) { ai[mt] = (f32x4){0.f, 0.f, 0.f, 0.f}; ag[mt] = ai[mt]; }
#pragma unroll
                for (int s = 0; s < 2; ++s) {
                    const bf16x8 ba = *(const LAS bf16x8*)(L + O_AUPT + (jn * 72 + 32 * s + 8 * fq) * 2);
#pragma unroll
                    for (int mt = 0; mt < 2; ++mt) { const bf16x8 xa = *(const LAS bf16x8*)(L + O_XA + ((16 * mt + fr) * 72 + 32 * s + 8 * fq) * 2); ai[mt] = RK_MFMA(xa, ba, ai[mt]); }
                }
                if (PASS == 1) {
#pragma unroll
                    for (int s = 0; s < 5; ++s) {
                        const bf16x8 bg = *(const LAS bf16x8*)(L + O_GUPT + (jn * 168 + 32 * s + 8 * fq) * 2);
#pragma unroll
                        for (int mt = 0; mt < 2; ++mt) { const bf16x8 xg = *(const LAS bf16x8*)(L + O_SG + ((16 * mt + fr) * 168 + 32 * s + 8 * fq) * 2); ag[mt] = RK_MFMA(xg, bg, ag[mt]); }
                    }
                }
                const float a0 = VEC[V_A0 + jn];
#pragma unroll
                for (int mt = 0; mt < 2; ++mt)
#pragma unroll
                    for (int r = 0; r < 4; ++r) { const int t = 16 * mt + 4 * fq + r;
                        ((LAS float*)(L + O_AA))[t * 64 + jn] = __builtin_amdgcn_rcpf(1.f + __expf(-(ai[mt][r] + a0)));
                        if (PASS == 1) ((LAS float*)(L + O_GG))[t * 64 + jn] = ag[mt][r]; }
            }
        }
        __syncthreads();
        }
        for (int rp_ = 0; rp_ < ((RK_REP == 3) ? 3 : 1); ++rp_) {
        {
            const int t = tid >> 4, jq = tid & 15, q = t >> 4;
            const f32x4 xk = *(const LAS f32x4*)(L + O_XK + (t * 64 + 4 * jq) * 4), xr = *(const LAS f32x4*)(L + O_XR + (t * 64 + 4 * jq) * 4), aa = *(const LAS f32x4*)(L + O_AA + (t * 64 + 4 * jq) * 4);
            const f32x4 xv = *(const LAS f32x4*)(L + O_XV + (t * 64 + 4 * jq) * 4);
            const f32x4 kkc = *(const LAS f32x4*)(VEC + V_KK + 4 * jq), kac = *(const LAS f32x4*)(VEC + V_KA + 4 * jq), rkc = *(const LAS f32x4*)(VEC + V_RK + 4 * jq);
            f32x4 kkv, kmod; float n2 = 0.f, bo = 0.f;
#pragma unroll
            for (int e = 0; e < 4; ++e) { kkv[e] = xk[e] * kkc[e]; n2 += kkv[e] * kkv[e]; kmod[e] = xk[e] * (1.f + (aa[e] - 1.f) * kac[e]); bo += xr[e] * kmod[e] * rkc[e]; }
#pragma unroll
            for (int o = 1; o < 16; o <<= 1) { n2 += shx(n2, o, lane); bo += shx(bo, o, lane); }
            const float invn = 1.f / fmaxf(sqrtf(n2), 1e-12f);
            if (jq == 0) ((LAS float*)(L + O_SC))[32 + t] = bo;
            const f32x4 cum = *(const LAS f32x4*)(L + O_DEC + (t * 64 + 4 * jq) * 4);
            f32x4 cm1 = (f32x4){0.f, 0.f, 0.f, 0.f}; if (t & 15) cm1 = *(const LAS f32x4*)(L + O_DEC + ((t - 1) * 64 + 4 * jq) * 4);
            float a_t[4], r_t[4], b_t[4], k_t[4], Wv[4];
#pragma unroll
            for (int e = 0; e < 4; ++e) { const float W = __expf(cum[e]), Wm1 = __expf(cm1[e]), iW = __expf(-cum[e]); const float kk = kkv[e] * invn;
                a_t[e] = -kk * Wm1; r_t[e] = xr[e] * W; b_t[e] = kk * aa[e] * iW; k_t[e] = kmod[e] * iW; Wv[e] = W; }
            *(LAS f32x4*)(L + O_ATF + (t * 64 + 4 * jq) * 4) = (f32x4){a_t[0], a_t[1], a_t[2], a_t[3]};
            *(LAS u32x2*)(L + O_AT + (t * 72 + 4 * jq) * 2) = (u32x2){cvtpk(a_t[0], a_t[1]), cvtpk(a_t[2], a_t[3])};
            *(LAS u32x2*)(L + O_RT + (t * 72 + 4 * jq) * 2) = (u32x2){cvtpk(r_t[0], r_t[1]), cvtpk(r_t[2], r_t[3])};
            const unsigned b01 = cvtpk(b_t[0], b_t[1]), b23 = cvtpk(b_t[2], b_t[3]), k01 = cvtpk(k_t[0], k_t[1]), k23 = cvtpk(k_t[2], k_t[3]), v01 = cvtpk(xv[0], xv[1]), v23 = cvtpk(xv[2], xv[3]);
            *(LAS u32x2*)(L + O_BT + (t * 72 + 4 * jq) * 2) = (u32x2){b01, b23};
            *(LAS u32x2*)(L + O_KT + (t * 72 + 4 * jq) * 2) = (u32x2){k01, k23};
            LAS bf16* btt = (LAS bf16*)(L + O_BTT) + (4 * jq) * TS + t; LAS bf16* ktt = (LAS bf16*)(L + O_KTT) + (4 * jq) * TS + t; LAS bf16* vt = (LAS bf16*)(L + O_VT) + (4 * jq) * TS + t;
            btt[0] = (bf16)(b01 & 0xffffu); btt[TS] = (bf16)(b01 >> 16); btt[2 * TS] = (bf16)(b23 & 0xffffu); btt[3 * TS] = (bf16)(b23 >> 16);
            ktt[0] = (bf16)(k01 & 0xffffu); ktt[TS] = (bf16)(k01 >> 16); ktt[2 * TS] = (bf16)(k23 & 0xffffu); ktt[3 * TS] = (bf16)(k23 >> 16);
            vt[0] = (bf16)(v01 & 0xffffu); vt[TS] = (bf16)(v01 >> 16); vt[2 * TS] = (bf16)(v23 & 0xffffu); vt[3 * TS] = (bf16)(v23 >> 16);
            if ((t & 15) == 15) *(LAS f32x4*)(L + O_WL + (q * 64 + 4 * jq) * 4) = (f32x4){Wv[0], Wv[1], Wv[2], Wv[3]};
        }
        __syncthreads();
        }
        for (int rp_ = 0; rp_ < ((RK_REP == 4) ? 3 : 1); ++rp_) {
        {
            const int q = wave >> 2, tile = wave & 3;
            const int ao = (tile & 2) ? O_RT : O_AT, bo = (tile & 1) ? O_KT : O_BT;
            f32x4 acc = (f32x4){0.f, 0.f, 0.f, 0.f};
            if (PASS == 1 || tile < 2)
#pragma unroll
            for (int s = 0; s < 2; ++s) { const bf16x8 av = *(const LAS bf16x8*)(L + ao + ((16 * q + fr) * 72 + 32 * s + 8 * fq) * 2), bv = *(const LAS bf16x8*)(L + bo + ((16 * q + fr) * 72 + 32 * s + 8 * fq) * 2);
                acc = RK_MFMA(av, bv, acc); }
#pragma unroll
            for (int r = 0; r < 4; ++r) { const int t = 4 * fq + r; const bool keep = (tile & 2) ? (fr <= t) : (fr < t); const float v = keep ? acc[r] : 0.f;
                if (tile == 0) ((LAS float*)(L + O_NM))[q * 256 + fr * 16 + t] = v;
                else if (tile == 1) ((LAS float*)(L + O_AAK))[q * 256 + t * 16 + fr] = v;
                else if (tile == 2) ((LAS bf16*)(L + O_ARB))[q * 256 + t * 16 + fr] = (bf16)f2bf(v);
                else ((LAS bf16*)(L + O_ARK))[q * 256 + t * 16 + fr] = (bf16)f2bf(v); }
        }
        __syncthreads();
        }
        for (int rp_ = 0; rp_ < ((RK_REP == 5) ? 3 : 1); ++rp_) {
        if (wave < 2) {
            const int q = wave, j = lane; const LAS float* NT = (const LAS float*)(L + O_NM) + q * 256;
            float X[16];
#pragma unroll
            for (int t = 0; t < 16; ++t) X[t] = ((const LAS float*)(L + O_ATF))[(16 * q + t) * 64 + j];
#pragma unroll
            for (int s = 0; s < 15; ++s) {
#pragma unroll
                for (int t4 = (s + 1) / 4; t4 < 4; ++t4) { const f32x4 n4 = *(const LAS f32x4*)(NT + s * 16 + 4 * t4);
#pragma unroll
                    for (int e = 0; e < 4; ++e) if (4 * t4 + e > s) X[4 * t4 + e] += n4[e] * X[s]; }
            }
#pragma unroll
            for (int t = 0; t < 16; ++t) ((LAS bf16*)(L + O_AH))[(16 * q + t) * 72 + j] = (bf16)f2bf(X[t]);
        } else if (wave == 2) {
            const int q = (lane >> 4) & 1, sc = lane & 15; const LAS float* NT = (const LAS float*)(L + O_NM) + q * 256; const LAS float* Ak = (const LAS float*)(L + O_AAK) + q * 256;
            float X[16];
#pragma unroll
            for (int t = 0; t < 16; ++t) X[t] = Ak[t * 16 + sc];
#pragma unroll
            for (int s = 0; s < 15; ++s) {
#pragma unroll
                for (int t4 = (s + 1) / 4; t4 < 4; ++t4) { const f32x4 n4 = *(const LAS f32x4*)(NT + s * 16 + 4 * t4);
#pragma unroll
                    for (int e = 0; e < 4; ++e) if (4 * t4 + e > s) X[4 * t4 + e] += n4[e] * X[s]; }
            }
            if (lane < 32) {
#pragma unroll
                for (int t = 0; t < 16; ++t) ((LAS bf16*)(L + O_AKH))[q * 256 + t * 16 + sc] = (bf16)f2bf(X[t]); }
        }
        __syncthreads();
        }
        f32x4 Ssave[4];
#pragma unroll
        for (int jt = 0; jt < 4; ++jt) Ssave[jt] = Sreg[jt];
        for (int rp6_ = 0; rp6_ < ((RK_REP == 6) ? 3 : 1); ++rp6_) {
        if (RK_REP == 6) {
#pragma unroll
            for (int jt = 0; jt < 4; ++jt) Sreg[jt] = Ssave[jt]; }
        if (wave < 4 || PASS == 0) {
            const bool qpart = wave < 4;
#pragma unroll
            for (int q = 0; q < 2; ++q) {
                bf16x8 Sf[2];
#pragma unroll
                for (int s = 0; s < 2; ++s) Sf[s] = __builtin_bit_cast(bf16x8, (u32x4){cvtpk(Sreg[2 * s][0], Sreg[2 * s][1]), cvtpk(Sreg[2 * s][2], Sreg[2 * s][3]), cvtpk(Sreg[2 * s + 1][0], Sreg[2 * s + 1][1]), cvtpk(Sreg[2 * s + 1][2], Sreg[2 * s + 1][3])});
                const int rowA = (16 * q + fr) * 72;
                f32x4 U = (f32x4){0.f, 0.f, 0.f, 0.f};
#pragma unroll
                for (int s = 0; s < 2; ++s) { const bf16x8 af = mk8(*(const LAS u32x2*)(L + O_AH + (rowA + 32 * s + 4 * fq) * 2), *(const LAS u32x2*)(L + O_AH + (rowA + 32 * s + 16 + 4 * fq) * 2)); U = RK_MFMA(af, Sf[s], U); }
                u32x2 vv = {0u, 0u};
                if (qpart) { vv = *(const LAS u32x2*)(L + O_VT + ((i0 + fr) * TS + 16 * q + 4 * fq) * 2);
                    const bf16x8 akf = mk8(*(const LAS u32x2*)(L + O_AKH + (q * 256 + fr * 16 + 4 * fq) * 2), (u32x2){0u, 0u}); U = RK_MFMA(akf, mk8(vv, (u32x2){0u, 0u}), U); }
                const bf16x8 UV = mk8((u32x2){cvtpk(U[0], U[1]), cvtpk(U[2], U[3])}, vv);
                if (PASS == 1) {
                    f32x4 Y = (f32x4){0.f, 0.f, 0.f, 0.f};
#pragma unroll
                    for (int s = 0; s < 2; ++s) { const bf16x8 rf = mk8(*(const LAS u32x2*)(L + O_RT + (rowA + 32 * s + 4 * fq) * 2), *(const LAS u32x2*)(L + O_RT + (rowA + 32 * s + 16 + 4 * fq) * 2)); Y = RK_MFMA(rf, Sf[s], Y); }
                    const bf16x8 abf = mk8(*(const LAS u32x2*)(L + O_ARB + (q * 256 + fr * 16 + 4 * fq) * 2), *(const LAS u32x2*)(L + O_ARK + (q * 256 + fr * 16 + 4 * fq) * 2)); Y = RK_MFMA(abf, UV, Y);
#pragma unroll
                    for (int r = 0; r < 4; ++r) ((LAS float*)(L + O_YB))[(16 * q + 4 * fq + r) * 64 + i0 + fr] = Y[r];
                }
#pragma unroll
                for (int jt = 0; jt < 4; ++jt) {
                    const bf16x8 bkf = mk8(*(const LAS u32x2*)(L + O_BTT + ((16 * jt + fr) * TS + 16 * q + 4 * fq) * 2), *(const LAS u32x2*)(L + O_KTT + ((16 * jt + fr) * TS + 16 * q + 4 * fq) * 2));
                    Sreg[jt] = RK_MFMA(bkf, UV, Sreg[jt]);
                    const f32x4 wl = *(const LAS f32x4*)(L + O_WL + (q * 64 + 16 * jt + 4 * fq) * 4);
                    Sreg[jt] = Sreg[jt] * wl;
                }
            }
        }
        __syncthreads();
        }
    }
    if (PASS == 1) {
        int lane_c; asm volatile("v_mbcnt_lo_u32_b32 %0, -1, 0\n\tv_mbcnt_hi_u32_b32 %0, -1, %0" : "=v"(lane_c));
        const int lane = lane_c, tid = wave * 64 + lane;
        const size_t m0 = (size_t)b * SEQ + tseg0 + SEGLEN;
        const int t = tid >> 4, iq = tid & 15;
        const f32x4 y = *(const LAS f32x4*)(L + O_YB + (t * 64 + 4 * iq) * 4);
        float s1 = (y[0] + y[1]) + (y[2] + y[3]);
#pragma unroll
        for (int o = 1; o < 16; o <<= 1) s1 += shx(s1, o, lane);
        const float mean = s1 * (1.f / 64.f); const f32x4 dy = y - mean;
        float s2 = (dy[0] * dy[0] + dy[1] * dy[1]) + (dy[2] * dy[2] + dy[3] * dy[3]);
#pragma unroll
        for (int o = 1; o < 16; o <<= 1) s2 += shx(s2, o, lane);
        const float rstd = __builtin_amdgcn_rsqf(s2 * (1.f / 64.f) + GN_EPS), bo = ((LAS float*)(L + O_SC))[32 + t];
        const f32x4 gg = *(const LAS f32x4*)(L + O_GG + (t * 64 + 4 * iq) * 4);
        float o4[4];
#pragma unroll
        for (int e = 0; e < 4; ++e) { const int i = 4 * iq + e; const float vv = bf2f(((const LAS bf16*)(L + O_VT))[i * TS + t]); o4[e] = (dy[e] * rstd * VEC[V_LNG + i] + VEC[V_LNB + i] + bo * vv) * gg[e]; }
        *(u32x2*)((bf16*)(ws + WS_OA) + (m0 - T + t) * 512 + h * 64 + 4 * iq) = (u32x2){cvtpk(o4[0], o4[1]), cvtpk(o4[2], o4[3])};
    }
    if (PASS == 0) {
        float* dst = SEGPQ + (size_t)itm * 8192 + (wave < 4 ? 4096 : 0);
#pragma unroll
        for (int jt = 0; jt < 4; ++jt)
#pragma unroll
            for (int r = 0; r < 4; ++r) dst[(16 * jt + 4 * fq + r) * 64 + i0 + fr] = Sreg[jt][r];
    }
    __syncthreads();
}
#undef RK_MFMA
}

namespace rk2 {
using rk::bf16x8; using rk::f32x4; using rk::u32x4; using rk::u32x2; using rk::cvtpk; using rk::mk8; using rk::shx;
using rk::V_W0; using rk::V_A0; using rk::V_KK; using rk::V_KA; using rk::V_RK; using rk::V_LNG; using rk::V_LNB; using rk::V_MUR; using rk::V_MUL;
constexpr int T = 32, SEGLEN = 512, NSEG = SEQ / SEGLEN, TS = 36;
constexpr int O_VEC = 0, O_XR = 3712, O_XK = O_XR + 8192, O_XV = O_XK + 8192;
constexpr int O_TXW = O_XV + 8192, O_XA = O_TXW + 4608, O_SG = O_XA + 4608;
constexpr int O_DEC = O_SG + 10752, O_AA = O_DEC + 8192, O_GG = O_AA + 8192  , O_SC = O_GG + 24576  ;
constexpr int O_AT = O_SC + 256, O_RT = O_AT + 4608, O_BT = O_RT + 4608, O_KT = O_BT + 4608;
constexpr int O_VB = O_KT + 4608  , O_WL = O_VB + 9216;
constexpr int O_NM = O_WL + 512, O_AAK = O_NM + 2048, O_ARB = O_AAK + 2048, O_ARK = O_ARB + 1024, O_AH = O_ARK + 1024, O_AKH = O_AH + 4608, O_ATF = O_AKH + 1024, O_YB = O_ATF + 8192  , O_END = O_YB + 16384;
static_assert(O_END <= 163840 - 512, "rk2 LDS map");
#define RK_MFMA(a, b, c) __builtin_amdgcn_mfma_f32_16x16x32_bf16((a), (b), (c), 0, 0, 0)
#define RK2_LANE() int lane_c_; asm volatile("v_mbcnt_lo_u32_b32 %0, -1, 0\n\tv_mbcnt_hi_u32_b32 %0, -1, %0" : "=v"(lane_c_)); const int lane = lane_c_, tid = wave * 64 + lane, fr = lane & 15, fq = lane >> 4; (void)tid; (void)fr; (void)fq;

typedef short v4i16_t __attribute__((ext_vector_type(4)));
__device__ __forceinline__ u32x2 tr4(LAS unsigned char* img, int tok0, int c0, int fr, int fq) {
    const v4i16_t v = __builtin_amdgcn_ds_read_tr16_b64_v4i16((LAS v4i16_t*)(img + ((tok0 + 4 * fq + (fr >> 2)) * 72 + c0 + 4 * (fr & 3)) * 2));
    return __builtin_bit_cast(u32x2, v); }
template <int PASS>
__device__ __forceinline__ void item(Frame& F, unsigned char* ws, const RwkvP& P, int b, int h, int g) {
    LAS unsigned char* L = F.lds;
    const int wave = F.wave;
    LAS float* VEC = (LAS float*)(L + O_VEC);
    const bf16* ZR = (const bf16*)(ws + Z_R); const bf16* ZK = (const bf16*)(ws + Z_K); const bf16* ZV = (const bf16*)(ws + Z_V); const bf16* ZL = (const bf16*)(ws + Z_L); const bf16* ZT = (const bf16*)(ws + WS_ZT);
    float* SEGPQ = (float*)(ws + WS_RKPQ);
    const int itm = (b * 8 + h) * NSEG + g;
    const int tseg0 = g * SEGLEN;
    u32x4 pre[1][5];
#define RK2_TASK(k, id, cp, rg) const int id = tid; int cp, rg; bool on_##k; \
    if (id < 64) { cp = 32 + (id & 7); rg = id >> 3; on_##k = true; } \
    else if (id < 192) { const int k_ = id - 64; cp = 40 + (k_ & 15); rg = k_ >> 4; on_##k = (PASS == 1); } \
    else if (id < 256) { const int k_ = id - 192; cp = 24 + (k_ & 7); rg = k_ >> 3; on_##k = true; } \
    else { const int k_ = id - 256; if (k_ < 192) { cp = k_ % 24; rg = k_ / 24; on_##k = true; } else { const int m_ = k_ - 192; cp = 56 + (m_ & 3); rg = (m_ >> 2) & 7; on_##k = (PASS == 1) && m_ < 32; } }
#define RK2_SRC(cp) const bf16* src = cp < 8 ? ZR : (cp < 16 ? ZK : (cp < 24 ? ZV : (cp < 32 ? ZL : ZT))); const int ld = cp < 24 ? 512 : (cp < 32 ? 288 : 224), col = cp < 24 ? h * 64 + 8 * (cp & 7) : (cp < 32 ? 64 + 8 * (cp - 24) : 8 * (cp - 32));
#define RK2_PREFETCH(k, tc0n) do { RK2_TASK(k, id_, cp_, rg_) if (on_##k) { RK2_SRC(cp_) _Pragma("unroll") for (int e = 0; e < 5; ++e) { const int tt = (tc0n) + 4 * rg_ - 1 + e; pre[k][e] = (u32x4){0u, 0u, 0u, 0u}; \
            if (tt >= 0) pre[k][e] = *(const u32x4*)(src + ((size_t)b * SEQ + tt) * ld + col); } } } while (0)
    { RK2_LANE(); RK2_PREFETCH(0, tseg0); }
    bf16x8 bw[2], ba[2], bg[5];
    f32x4 Sreg[4];
    const int i0 = 16 * (wave & 3);
    {
        RK2_LANE();
        if (tid < 64) { const int c = h * 64 + tid; VEC[V_W0 + tid] = P.w0[c]; VEC[V_A0 + tid] = P.a0[c]; VEC[V_KK + tid] = P.k_k[c]; VEC[V_KA + tid] = P.k_a[c]; VEC[V_RK + tid] = P.r_k[c];
            VEC[V_LNG + tid] = P.ln_g[c]; VEC[V_LNB + tid] = P.ln_b[c]; VEC[V_MUR + tid] = P.mu[c]; VEC[V_MUR + 64 + tid] = P.mu[512 + c]; VEC[V_MUR + 128 + tid] = P.mu[1024 + c]; }
        if (tid < 288) VEC[V_MUL + tid] = P.mu[1536 + tid];
#pragma unroll
        for (int jt = 0; jt < 4; ++jt) Sreg[jt] = (f32x4){0.f, 0.f, 0.f, 0.f};
        if (PASS == 0) { if (wave >= 4) {
#pragma unroll
            for (int jt = 0; jt < 4; ++jt)
#pragma unroll
                for (int r = 0; r < 4; ++r) Sreg[jt][r] = (16 * jt + 4 * fq + r == i0 + fr) ? 1.f : 0.f; } }
        else if (g > 0) {
            const unsigned char* Mb = (const unsigned char*)(SEGPQ + (size_t)((b * 8 + h) * NSEG) * 8192);
            constexpr int RING = 16384;
#define FOLD_ISSUE(GP) do { const unsigned char* m_ = Mb + (size_t)(GP) * 32768 + wave * 4096 + lane * 16; LAS unsigned char* d_ = L + RING + ((GP) & 3) * 32768 + wave * 4096; \
            _Pragma("unroll") for (int c_ = 0; c_ < 4; ++c_) __builtin_amdgcn_global_load_lds((const unsigned*)(m_ + c_ * 1024), (LAS unsigned*)(d_ + c_ * 1024), 16, 0, 0); } while (0)
            FOLD_ISSUE(0); if (g > 1) FOLD_ISSUE(1); if (g > 2) FOLD_ISSUE(2);
#pragma unroll 1
            for (int gp = 0; gp < g; ++gp) {
                const int later = (g < gp + 3 ? g : gp + 3) - gp - 1;
                if (later == 2) asm volatile("s_waitcnt vmcnt(8)" ::: "memory"); else if (later == 1) asm volatile("s_waitcnt vmcnt(4)" ::: "memory"); else asm volatile("s_waitcnt vmcnt(0)" ::: "memory");
                __builtin_amdgcn_s_barrier(); asm volatile("" ::: "memory");
                if (gp + 3 < g) FOLD_ISSUE(gp + 3);
                if (wave < 4) {
                    const LAS unsigned char* sl = L + RING + (gp & 3) * 32768;
                    bf16x8 Sh[2], Sl[2];
#pragma unroll
                    for (int s = 0; s < 2; ++s) { unsigned hi[4], lo[4];
#pragma unroll
                        for (int e = 0; e < 4; ++e) { const float x0 = Sreg[2 * s + (e >> 1)][2 * (e & 1)], x1 = Sreg[2 * s + (e >> 1)][2 * (e & 1) + 1];
                            hi[e] = cvtpk(x0, x1); lo[e] = cvtpk(x0 - bf2f(hi[e] & 0xffffu), x1 - bf2f(hi[e] >> 16)); }
                        Sh[s] = __builtin_bit_cast(bf16x8, (u32x4){hi[0], hi[1], hi[2], hi[3]}); Sl[s] = __builtin_bit_cast(bf16x8, (u32x4){lo[0], lo[1], lo[2], lo[3]}); }
#pragma unroll
                    for (int jt = 0; jt < 4; ++jt) {
                        f32x4 acc = *(const LAS f32x4*)(sl + ((wave * 4 + jt) * 64 + lane) * 16);
#pragma unroll
                        for (int s = 0; s < 2; ++s) { const bf16x8 ph = *(const LAS bf16x8*)(sl + 16384 + ((jt * 2 + s) * 64 + lane) * 16), pl = *(const LAS bf16x8*)(sl + 24576 + ((jt * 2 + s) * 64 + lane) * 16);
                            acc = RK_MFMA(ph, Sh[s], acc); acc = RK_MFMA(ph, Sl[s], acc); acc = RK_MFMA(pl, Sh[s], acc); }
                        Sreg[jt] = acc;
                    }
                }
            }
#undef FOLD_ISSUE
        }
    }
    {
        RK2_LANE();
        const int jn = h * 64 + 16 * (wave & 3) + fr;
#pragma unroll
        for (int s = 0; s < 2; ++s) { bw[s] = (bf16x8){0, 0, 0, 0, 0, 0, 0, 0}; ba[s] = bw[s]; }
#pragma unroll
        for (int s = 0; s < 5; ++s) bg[s] = (bf16x8){0, 0, 0, 0, 0, 0, 0, 0};
        if (wave >= 4) {
            float vw[2][8], va[2][8], vg[5][8];
#pragma unroll
            for (int s = 0; s < 2; ++s)
#pragma unroll
                for (int e = 0; e < 8; ++e) { vw[s][e] = P.w_up[(32 * s + 8 * fq + e) * 512 + jn]; va[s][e] = P.a_up[(32 * s + 8 * fq + e) * 512 + jn]; }
            if (PASS == 1) {
#pragma unroll
                for (int s = 0; s < 5; ++s)
#pragma unroll
                    for (int e = 0; e < 8; ++e) vg[s][e] = P.g_up[(32 * s + 8 * fq + e) * 512 + jn]; }
#pragma unroll
            for (int s = 0; s < 2; ++s) {
                bw[s] = __builtin_bit_cast(bf16x8, (u32x4){cvtpk(vw[s][0], vw[s][1]), cvtpk(vw[s][2], vw[s][3]), cvtpk(vw[s][4], vw[s][5]), cvtpk(vw[s][6], vw[s][7])});
                ba[s] = __builtin_bit_cast(bf16x8, (u32x4){cvtpk(va[s][0], va[s][1]), cvtpk(va[s][2], va[s][3]), cvtpk(va[s][4], va[s][5]), cvtpk(va[s][6], va[s][7])}); }
            if (PASS == 1) {
#pragma unroll
                for (int s = 0; s < 5; ++s) bg[s] = __builtin_bit_cast(bf16x8, (u32x4){cvtpk(vg[s][0], vg[s][1]), cvtpk(vg[s][2], vg[s][3]), cvtpk(vg[s][4], vg[s][5]), cvtpk(vg[s][6], vg[s][7])}); }
        }
    }
#define RK2_S1(k) do { RK2_TASK(k, id_, cp, rg) if (on_##k) { \
        if (cp < 32) { const int which = cp >> 3, p = cp & 7; const LAS float* muv = which < 3 ? VEC + V_MUR + which * 64 + 8 * p : VEC + V_MUL + 64 + 8 * p; float mu[8]; \
            _Pragma("unroll") for (int e = 0; e < 8; ++e) mu[e] = muv[e]; \
            _Pragma("unroll") for (int rr = 0; rr < 4; ++rr) { const int t = 4 * rg + rr; const u32x4 cu = pre[k][rr + 1], pu = pre[k][rr]; float f[8]; \
                _Pragma("unroll") for (int e = 0; e < 4; ++e) { const float c0 = bf2f(cu[e] & 0xffffu), c1 = bf2f(cu[e] >> 16), p0 = bf2f(pu[e] & 0xffffu), p1 = bf2f(pu[e] >> 16); \
                    f[2 * e] = c0 + (p0 - c0) * mu[2 * e]; f[2 * e + 1] = c1 + (p1 - c1) * mu[2 * e + 1]; } \
                if (which < 3) { LAS float* dst = (LAS float*)(L + (which == 0 ? O_XR : (which == 1 ? O_XK : O_XV))) + t * 64 + 8 * p; \
                    *(LAS f32x4*)dst = (f32x4){f[0], f[1], f[2], f[3]}; *(LAS f32x4*)(dst + 4) = (f32x4){f[4], f[5], f[6], f[7]}; } \
                else *(LAS u32x4*)(L + O_XA + (t * 72 + 8 * p) * 2) = (u32x4){cvtpk(f[0], f[1]), cvtpk(f[2], f[3]), cvtpk(f[4], f[5]), cvtpk(f[6], f[7])}; } } \
        else { _Pragma("unroll") for (int rr = 0; rr < 4; ++rr) { const int t = 4 * rg + rr; \
                if (cp < 40) *(LAS u32x4*)(L + O_TXW + (t * 72 + 8 * (cp - 32)) * 2) = pre[k][rr + 1]; else *(LAS u32x4*)(L + O_SG + (t * 168 + 8 * (cp - 40)) * 2) = pre[k][rr + 1]; } } } } while (0)
#define RK2_S2W(cn) do { const int jn = 16 * (wave & 3) + fr; f32x4 aw[2]; \
        _Pragma("unroll") for (int mt = 0; mt < 2; ++mt) aw[mt] = (f32x4){0.f, 0.f, 0.f, 0.f}; \
        _Pragma("unroll") for (int s = 0; s < 2; ++s) _Pragma("unroll") for (int mt = 0; mt < 2; ++mt) { \
            const bf16x8 xw = *(const LAS bf16x8*)(L + O_TXW + ((16 * mt + fr) * 72 + 32 * s + 8 * fq) * 2); aw[mt] = RK_MFMA(xw, bw[s], aw[mt]); } \
        const float w0 = VEC[V_W0 + jn]; \
        _Pragma("unroll") for (int mt = 0; mt < 2; ++mt) { float ldv[4]; \
            _Pragma("unroll") for (int r = 0; r < 4; ++r) ldv[r] = -0.8750387749145276f * __builtin_amdgcn_rcpf(1.f + __expf(-(aw[mt][r] + w0)));     \
            ldv[1] += ldv[0]; ldv[2] += ldv[1]; ldv[3] += ldv[2]; const float tot = ldv[3]; const float s1 = shx(tot, 16, lane); const float pair = tot + s1; const float s2 = shx(pair, 32, lane); \
            const float excl = ((fq & 1) ? s1 : 0.f) + ((fq & 2) ? s2 : 0.f); \
            _Pragma("unroll") for (int r = 0; r < 4; ++r) ((LAS float*)(L + O_DEC))[(16 * mt + 4 * fq + r) * 64 + jn] = ldv[r] + excl; } } while (0)
#define RK2_S2A(cn) do { const int jn = 16 * (wave & 3) + fr; f32x4 ai[2]; \
        _Pragma("unroll") for (int mt = 0; mt < 2; ++mt) ai[mt] = (f32x4){0.f, 0.f, 0.f, 0.f}; \
        _Pragma("unroll") for (int s = 0; s < 2; ++s) _Pragma("unroll") for (int mt = 0; mt < 2; ++mt) { \
            const bf16x8 xa = *(const LAS bf16x8*)(L + O_XA + ((16 * mt + fr) * 72 + 32 * s + 8 * fq) * 2); ai[mt] = RK_MFMA(xa, ba[s], ai[mt]); } \
        const float a0 = VEC[V_A0 + jn]; \
        _Pragma("unroll") for (int mt = 0; mt < 2; ++mt) _Pragma("unroll") for (int r = 0; r < 4; ++r) ((LAS float*)(L + O_AA))[(16 * mt + 4 * fq + r) * 64 + jn] = __builtin_amdgcn_rcpf(1.f + __expf(-(ai[mt][r] + a0))); } while (0)
#define RK2_S2G(cn) do { const int jn = 16 * (wave & 3) + fr; f32x4 ag[2]; \
        _Pragma("unroll") for (int mt = 0; mt < 2; ++mt) ag[mt] = (f32x4){0.f, 0.f, 0.f, 0.f}; \
        _Pragma("unroll") for (int s = 0; s < 5; ++s) _Pragma("unroll") for (int mt = 0; mt < 2; ++mt) { \
            const bf16x8 xg = *(const LAS bf16x8*)(L + O_SG + ((16 * mt + fr) * 168 + 32 * s + 8 * fq) * 2); ag[mt] = RK_MFMA(xg, bg[s], ag[mt]); } \
        _Pragma("unroll") for (int mt = 0; mt < 2; ++mt) _Pragma("unroll") for (int r = 0; r < 4; ++r) ((LAS float*)(L + O_GG + ((cn) % 3) * 8192))[(16 * mt + 4 * fq + r) * 64 + jn] = ag[mt][r]; } while (0)
#define RK2_S7(cp_, t, iq) do { const int bufp = (cp_) & 1; \
        const f32x4 y = *(const LAS f32x4*)(L + O_YB + bufp * 8192 + ((t) * 64 + 4 * (iq)) * 4); float s1 = rk::row_sum16((y[0] + y[1]) + (y[2] + y[3])); \
        const float mean = s1 * (1.f / 64.f); const f32x4 dy = y - mean; const float s2 = rk::row_sum16((dy[0] * dy[0] + dy[1] * dy[1]) + (dy[2] * dy[2] + dy[3] * dy[3])); \
        const float rstd = __builtin_amdgcn_rsqf(s2 * (1.f / 64.f) + GN_EPS), bo = ((LAS float*)(L + O_SC))[bufp * 32 + (t)]; \
        const f32x4 gg = *(const LAS f32x4*)(L + O_GG + ((cp_) % 3) * 8192 + ((t) * 64 + 4 * (iq)) * 4); float o4[4]; \
        const u32x2 vb = *(const LAS u32x2*)(L + O_VB + bufp * 4608 + ((t) * 72 + 4 * (iq)) * 2); const float vf[4] = {bf2f(vb.x & 0xffffu), bf2f(vb.x >> 16), bf2f(vb.y & 0xffffu), bf2f(vb.y >> 16)}; \
        _Pragma("unroll") for (int e = 0; e < 4; ++e) { const int i = 4 * (iq) + e; o4[e] = (dy[e] * rstd * VEC[V_LNG + i] + VEC[V_LNB + i] + bo * vf[e]) * gg[e]; } \
        *(u32x2*)((bf16*)(ws + WS_OA) + ((size_t)b * SEQ + tseg0 + (cp_) * T + (t)) * 512 + h * 64 + 4 * (iq)) = (u32x2){cvtpk(o4[0], o4[1]), cvtpk(o4[2], o4[3])}; } while (0)

    lds_barrier();
    {
        RK2_LANE();
        RK2_S1(0); RK2_PREFETCH(0, tseg0 + T);
        lds_barrier();
        if (wave >= 4) { RK2_S2W(0); RK2_S2A(0); if (PASS == 1) RK2_S2G(0); }
        lds_barrier();
    }
#pragma unroll 1
    for (int ch = 0; ch < SEGLEN / T; ++ch) {
        RK2_LANE();
        const int buf = ch & 1;
        for (int rp1 = 0; rp1 < (RK2_REP == 1 ? 3 : 1); ++rp1) {
        {
            const int t = tid >> 4, jq = tid & 15, q = t >> 4;
            const f32x4 xk = *(const LAS f32x4*)(L + O_XK + (t * 64 + 4 * jq) * 4), xr = *(const LAS f32x4*)(L + O_XR + (t * 64 + 4 * jq) * 4), aa = *(const LAS f32x4*)(L + O_AA + (t * 64 + 4 * jq) * 4);
            const f32x4 xv = *(const LAS f32x4*)(L + O_XV + (t * 64 + 4 * jq) * 4);
            const f32x4 kkc = *(const LAS f32x4*)(VEC + V_KK + 4 * jq), kac = *(const LAS f32x4*)(VEC + V_KA + 4 * jq), rkc = *(const LAS f32x4*)(VEC + V_RK + 4 * jq);
            f32x4 kkv, kmod; float n2 = 0.f, bo = 0.f;
#pragma unroll
            for (int e = 0; e < 4; ++e) { kkv[e] = xk[e] * kkc[e]; n2 += kkv[e] * kkv[e]; kmod[e] = xk[e] * (1.f + (aa[e] - 1.f) * kac[e]); bo += xr[e] * kmod[e] * rkc[e]; }
            n2 = rk::row_sum16(n2); bo = rk::row_sum16(bo);
            const float invn = __builtin_amdgcn_rsqf(fmaxf(n2, 1e-24f));
            if (jq == 0) ((LAS float*)(L + O_SC))[buf * 32 + t] = bo;
            const f32x4 cum = *(const LAS f32x4*)(L + O_DEC + (t * 64 + 4 * jq) * 4);
            f32x4 cm1 = (f32x4){0.f, 0.f, 0.f, 0.f}; if (t & 15) cm1 = *(const LAS f32x4*)(L + O_DEC + ((t - 1) * 64 + 4 * jq) * 4);
            float a_t[4], r_t[4], b_t[4], k_t[4], Wv[4];
#pragma unroll
            for (int e = 0; e < 4; ++e) { const float W = __builtin_amdgcn_exp2f(cum[e]), Wm1 = __builtin_amdgcn_exp2f(cm1[e]), iW = __builtin_amdgcn_exp2f(-cum[e]); const float kk = kkv[e] * invn;
                a_t[e] = -kk * Wm1; r_t[e] = xr[e] * W; b_t[e] = kk * aa[e] * iW; k_t[e] = kmod[e] * iW; Wv[e] = W; }
            *(LAS f32x4*)(L + O_ATF + (t * 64 + 4 * jq) * 4) = (f32x4){a_t[0], a_t[1], a_t[2], a_t[3]};
            *(LAS u32x2*)(L + O_AT + (t * 72 + 4 * jq) * 2) = (u32x2){cvtpk(a_t[0], a_t[1]), cvtpk(a_t[2], a_t[3])};
            *(LAS u32x2*)(L + O_RT + (t * 72 + 4 * jq) * 2) = (u32x2){cvtpk(r_t[0], r_t[1]), cvtpk(r_t[2], r_t[3])};
            const unsigned b01 = cvtpk(b_t[0], b_t[1]), b23 = cvtpk(b_t[2], b_t[3]), k01 = cvtpk(k_t[0], k_t[1]), k23 = cvtpk(k_t[2], k_t[3]), v01 = cvtpk(xv[0], xv[1]), v23 = cvtpk(xv[2], xv[3]);
            *(LAS u32x2*)(L + O_BT + (t * 72 + 4 * jq) * 2) = (u32x2){b01, b23};
            *(LAS u32x2*)(L + O_KT + (t * 72 + 4 * jq) * 2) = (u32x2){k01, k23};
            *(LAS u32x2*)(L + O_VB + buf * 4608 + (t * 72 + 4 * jq) * 2) = (u32x2){v01, v23};
            if ((t & 15) == 15) *(LAS f32x4*)(L + O_WL + (q * 64 + 4 * jq) * 4) = (f32x4){Wv[0], Wv[1], Wv[2], Wv[3]};
        }
        if (wave == 0 && ch + 1 < SEGLEN / T) { RK2_S1(0); if (ch + 2 < SEGLEN / T && (RK2_REP != 1 || rp1 == 2)) RK2_PREFETCH(0, tseg0 + (ch + 2) * T); }
        lds_barrier();
        }
        for (int rp2 = 0; rp2 < (RK2_REP == 2 ? 3 : 1); ++rp2) {
        {
            const int q = wave >> 2, tile = wave & 3;
            const int ao = (tile & 2) ? O_RT : O_AT, bo = (tile & 1) ? O_KT : O_BT;
            f32x4 acc = (f32x4){0.f, 0.f, 0.f, 0.f};
            if (PASS == 1 || tile < 2)
#pragma unroll
            for (int s = 0; s < 2; ++s) { const bf16x8 av = *(const LAS bf16x8*)(L + ao + ((16 * q + fr) * 72 + 32 * s + 8 * fq) * 2), bv = *(const LAS bf16x8*)(L + bo + ((16 * q + fr) * 72 + 32 * s + 8 * fq) * 2);
                acc = RK_MFMA(av, bv, acc); }
#pragma unroll
            for (int r = 0; r < 4; ++r) { const int t = 4 * fq + r; const bool keep = (tile & 2) ? (fr <= t) : (fr < t); const float v = keep ? acc[r] : 0.f;
                if (tile == 0) ((LAS float*)(L + O_NM))[q * 256 + fr * 16 + t] = v;
                else if (tile == 1) ((LAS float*)(L + O_AAK))[q * 256 + t * 16 + fr] = v;
                else if (tile == 2) ((LAS bf16*)(L + O_ARB))[q * 256 + t * 16 + fr] = (bf16)f2bf(v);
                else ((LAS bf16*)(L + O_ARK))[q * 256 + t * 16 + fr] = (bf16)f2bf(v); }
        }
        if (wave >= 1 && wave < 3 && ch + 1 < SEGLEN / T) { RK2_S1(0); if (ch + 2 < SEGLEN / T && (RK2_REP != 2 || rp2 == 2)) RK2_PREFETCH(0, tseg0 + (ch + 2) * T); }
        if (wave >= 4 && ch + 1 < SEGLEN / T) { RK2_S2W(ch + 1); }
        if (PASS == 1 && wave < 4 && ch > 0 && (RK2_REP != 2 || rp2 == 0)) { RK2_S7(ch - 1, tid >> 4, tid & 15); }
        lds_barrier();
        }
        for (int rp3 = 0; rp3 < (RK2_REP == 3 ? 3 : 1); ++rp3) {
        if (wave < 2) {
            const int q = wave, j = lane; const LAS float* NT = (const LAS float*)(L + O_NM) + q * 256;
            float X[16];
#pragma unroll
            for (int t = 0; t < 16; ++t) X[t] = ((const LAS float*)(L + O_ATF))[(16 * q + t) * 64 + j];
#pragma unroll
            for (int s = 0; s < 15; ++s) {
#pragma unroll
                for (int t4 = (s + 1) / 4; t4 < 4; ++t4) { const f32x4 n4 = *(const LAS f32x4*)(NT + s * 16 + 4 * t4);
#pragma unroll
                    for (int e = 0; e < 4; ++e) if (4 * t4 + e > s) X[4 * t4 + e] += n4[e] * X[s]; }
            }
#pragma unroll
            for (int t = 0; t < 16; ++t) ((LAS bf16*)(L + O_AH))[(16 * q + t) * 72 + j] = (bf16)f2bf(X[t]);
        } else if (wave == 2) {
            const int q = (lane >> 4) & 1, sc = lane & 15; const LAS float* NT = (const LAS float*)(L + O_NM) + q * 256; const LAS float* Ak = (const LAS float*)(L + O_AAK) + q * 256;
            float X[16];
#pragma unroll
            for (int t = 0; t < 16; ++t) X[t] = Ak[t * 16 + sc];
#pragma unroll
            for (int s = 0; s < 15; ++s) {
#pragma unroll
                for (int t4 = (s + 1) / 4; t4 < 4; ++t4) { const f32x4 n4 = *(const LAS f32x4*)(NT + s * 16 + 4 * t4);
#pragma unroll
                    for (int e = 0; e < 4; ++e) if (4 * t4 + e > s) X[4 * t4 + e] += n4[e] * X[s]; }
            }
            if (lane < 32) {
#pragma unroll
                for (int t = 0; t < 16; ++t) ((LAS bf16*)(L + O_AKH))[q * 256 + t * 16 + sc] = (bf16)f2bf(X[t]); }
        }
        if (wave >= 3 && ch + 1 < SEGLEN / T) { RK2_S1(0); if (ch + 2 < SEGLEN / T && (RK2_REP != 3 || rp3 == 2)) RK2_PREFETCH(0, tseg0 + (ch + 2) * T); }
        lds_barrier();
        }
        if (wave >= 4) {
            if (PASS == 1 && ch > 0) { const int t2 = tid - 256; RK2_S7(ch - 1, 16 + (t2 >> 4), t2 & 15); }
            if (ch + 1 < SEGLEN / T) { RK2_S2A(ch + 1); if (PASS == 1) RK2_S2G(ch + 1); }
        }
        if (wave < 4 || PASS == 0) {
            const bool qpart = wave < 4;
#pragma unroll
            for (int q = 0; q < 2; ++q) {
                bf16x8 Sf[2];
#pragma unroll
                for (int s = 0; s < 2; ++s) Sf[s] = __builtin_bit_cast(bf16x8, (u32x4){cvtpk(Sreg[2 * s][0], Sreg[2 * s][1]), cvtpk(Sreg[2 * s][2], Sreg[2 * s][3]), cvtpk(Sreg[2 * s + 1][0], Sreg[2 * s + 1][1]), cvtpk(Sreg[2 * s + 1][2], Sreg[2 * s + 1][3])});
                const int rowA = (16 * q + fr) * 72;
                f32x4 U = (f32x4){0.f, 0.f, 0.f, 0.f};
#pragma unroll
                for (int s = 0; s < 2; ++s) { const bf16x8 af = mk8(*(const LAS u32x2*)(L + O_AH + (rowA + 32 * s + 4 * fq) * 2), *(const LAS u32x2*)(L + O_AH + (rowA + 32 * s + 16 + 4 * fq) * 2)); U = RK_MFMA(af, Sf[s], U); }
                u32x2 vv = {0u, 0u};
                if (qpart) { vv = tr4(L + O_VB + buf * 4608, 16 * q, i0, fr, fq);
                    const bf16x8 akf = mk8(*(const LAS u32x2*)(L + O_AKH + (q * 256 + fr * 16 + 4 * fq) * 2), (u32x2){0u, 0u}); U = RK_MFMA(akf, mk8(vv, (u32x2){0u, 0u}), U); }
                const bf16x8 UV = mk8((u32x2){cvtpk(U[0], U[1]), cvtpk(U[2], U[3])}, vv);
                if (PASS == 1) {
                    f32x4 Y = (f32x4){0.f, 0.f, 0.f, 0.f};
#pragma unroll
                    for (int s = 0; s < 2; ++s) { const bf16x8 rf = mk8(*(const LAS u32x2*)(L + O_RT + (rowA + 32 * s + 4 * fq) * 2), *(const LAS u32x2*)(L + O_RT + (rowA + 32 * s + 16 + 4 * fq) * 2)); Y = RK_MFMA(rf, Sf[s], Y); }
                    const bf16x8 abf = mk8(*(const LAS u32x2*)(L + O_ARB + (q * 256 + fr * 16 + 4 * fq) * 2), *(const LAS u32x2*)(L + O_ARK + (q * 256 + fr * 16 + 4 * fq) * 2)); Y = RK_MFMA(abf, UV, Y);
#pragma unroll
                    for (int r = 0; r < 4; ++r) ((LAS float*)(L + O_YB + buf * 8192))[(16 * q + 4 * fq + r) * 64 + i0 + fr] = Y[r];
                }
#pragma unroll
                for (int jt = 0; jt < 4; ++jt) {
                    const bf16x8 bkf = mk8(tr4(L + O_BT, 16 * q, 16 * jt, fr, fq), tr4(L + O_KT, 16 * q, 16 * jt, fr, fq));
                    Sreg[jt] = RK_MFMA(bkf, UV, Sreg[jt]);
                    const f32x4 wl = *(const LAS f32x4*)(L + O_WL + (q * 64 + 16 * jt + 4 * fq) * 4);
                    Sreg[jt] = Sreg[jt] * wl;
                }
            }
        }
        lds_barrier();
    }
    if (PASS == 1) { RK2_LANE(); RK2_S7(SEGLEN / T - 1, tid >> 4, tid & 15); }
    if (PASS == 0) {
        RK2_LANE();
        unsigned char* mp = (unsigned char*)(SEGPQ + (size_t)itm * 8192);
        LAS float* Pt = (LAS float*)L;
        if (wave < 4) {
#pragma unroll
            for (int jt = 0; jt < 4; ++jt) *(f32x4*)(mp + ((wave * 4 + jt) * 64 + lane) * 16) = Sreg[jt];
        } else {
#pragma unroll
            for (int jt = 0; jt < 4; ++jt)
#pragma unroll
                for (int r = 0; r < 4; ++r) Pt[(16 * jt + 4 * fq + r) * 65 + i0 + fr] = Sreg[jt][r];
        }
        lds_barrier();
        {
            const int jt = wave >> 1, s = wave & 1; const LAS float* pr = Pt + (16 * jt + fr) * 65 + 32 * s + 4 * fq;
            float p[8];
#pragma unroll
            for (int e = 0; e < 4; ++e) { p[e] = pr[e]; p[4 + e] = pr[16 + e]; }
            unsigned hi[4], lo[4];
#pragma unroll
            for (int e = 0; e < 4; ++e) { hi[e] = cvtpk(p[2 * e], p[2 * e + 1]); lo[e] = cvtpk(p[2 * e] - bf2f(hi[e] & 0xffffu), p[2 * e + 1] - bf2f(hi[e] >> 16)); }
            *(u32x4*)(mp + 16384 + ((jt * 2 + s) * 64 + lane) * 16) = (u32x4){hi[0], hi[1], hi[2], hi[3]};
            *(u32x4*)(mp + 24576 + ((jt * 2 + s) * 64 + lane) * 16) = (u32x4){lo[0], lo[1], lo[2], lo[3]};
        }
    }
    lds_barrier();
#undef RK2_TASK
#undef RK2_SRC
#undef RK2_PREFETCH
#undef RK2_S1
#undef RK2_S2W
#undef RK2_S2A
#undef RK2_S2G
#undef RK2_S7
}
#undef RK_MFMA
#undef RK2_LANE
}

struct LruP { const float *cw, *cb, *wa, *ba, *wx, *bx, *lam; };
__device__ __forceinline__ float gelu_tanh_(float x) { const float u = 0.7978845608028654f * (x + 0.044715f * x * x * x); return 0.5f * x * (1.f + tanhf(u)); }
__device__ __forceinline__ void lru_naive_item(Frame& F, unsigned char* ws, const LruP& P, int b, int blk) {
    LAS float* L = (LAS float*)F.lds;
    LAS float* Lxc = L;
    LAS float* Lwa = L + 4096;
    LAS float* Lwx = L + 8192;
    LAS float* Laa = L + 12288;
    LAS float* Lbb = L + 16384;
    const bf16* ZBX = (const bf16*)(ws + Z_BX); bf16* ZBY = (bf16*)(ws + Z_BY);
    const int tid = F.tid;
    for (int idx = tid; idx < 4096; idx += NTHR) { Lwa[idx] = P.wa[blk * 4096 + idx]; Lwx[idx] = P.wx[blk * 4096 + idx]; }
    float hcar = 0.f;
    for (int tile = 0; tile < SEQ / 64; ++tile) {
        const int t0 = tile * 64;
        __syncthreads();
        for (int idx = tid; idx < 4096; idx += NTHR) {
            const int tt = idx >> 6, c = idx & 63, ch = blk * 64 + c, t = t0 + tt;
            float s = P.cb[ch];
#pragma unroll
            for (int i = 0; i < 4; ++i) { const int ts = t - 3 + i; if (ts >= 0) s += P.cw[i * 512 + ch] * bf2f(ZBX[((size_t)b * SEQ + ts) * 512 + ch]); }
            Lxc[idx] = s;
        }
        __syncthreads();
        for (int idx = tid; idx < 4096; idx += NTHR) {
            const int tt = idx >> 6, j = idx & 63, ch = blk * 64 + j;
            float sa = P.ba[ch], sx = P.bx[ch];
            for (int i = 0; i < 64; ++i) { const float xv = Lxc[tt * 64 + i]; sa += xv * Lwa[i * 64 + j]; sx += xv * Lwx[i * 64 + j]; }
            const float ga = sigmoidf_(sa), gx = sigmoidf_(sx);
            const float log_a = -8.0f * ga * softplusf_(-P.lam[ch]);
            const float a = expf(log_a); float mult = sqrtf(fmaxf(-expm1f(2.f * log_a), 0.f));
            if (t0 + tt == 0) mult = 1.f;
            Laa[idx] = a; Lbb[idx] = Lxc[idx] * gx * mult;
        }
        __syncthreads();
        if (tid < 64) {
            const int ch = blk * 64 + tid;
            for (int tt = 0; tt < 64; ++tt) {
                hcar = Laa[tt * 64 + tid] * hcar + Lbb[tt * 64 + tid];
                const size_t off = ((size_t)b * SEQ + t0 + tt) * 512 + ch;
                ZBY[off] = (bf16)f2bf(hcar * gelu_tanh_(bf2f(ZBY[off])));
            }
        }
    }
    __syncthreads();
}

__device__ __forceinline__ int t5_bucket(int d) {
    if (d < 16) return d;
    int v = 16 + (int)(logf((float)d / 16.f) / logf(128.f) * 16.f);
    return v > 31 ? 31 : v;
}
__device__ __forceinline__ void attn_naive(Frame& F, unsigned char* ws, const float* relb, const float* qg, const float* kg, int worker, int nworkers) {
    LAS float* Lbias = (LAS float*)F.lds;
    for (int idx = F.tid; idx < 12 * 129; idx += NTHR) { const int hd = idx / 129, rel = idx % 129, g = hd >> 2; const int dil = g == 0 ? 1 : (g == 1 ? 4 : 16);
        Lbias[idx] = relb[t5_bucket(rel * dil) * 12 + hd]; }
    __syncthreads();
    bf16* AQ = (bf16*)(ws + A_Q); const bf16* AK = (const bf16*)(ws + A_K); const bf16* AV = (const bf16*)(ws + A_V); float* LSE = (float*)(ws + WS_LSE);
    for (long it2 = (long)worker * NTHR + F.tid; it2 < (long)M * 24; it2 += (long)nworkers * NTHR) {
        const long it = it2 >> 1; const int half = (int)(it2 & 1);
        const int m = (int)(it / 12), hd = (int)(it % 12), g = hd >> 2; const int dil = g == 0 ? 1 : (g == 1 ? 4 : 16);
        const int t = m % SEQ;
        float q[32]; float s2 = 0.f;
        const unsigned* qp = (const unsigned*)(AQ + (size_t)m * 768 + hd * 64 + half * 32);
#pragma unroll
        for (int j = 0; j < 16; ++j) { const unsigned u = qp[j]; q[2 * j] = bf2f(u & 0xffffu); q[2 * j + 1] = bf2f(u >> 16); s2 += q[2 * j] * q[2 * j] + q[2 * j + 1] * q[2 * j + 1]; }
        s2 += shfl_xor_l(s2, 1, F.lane);
        const float qs = (1.f / sqrtf(s2 * (1.f / 64.f) + RMS_EPS)) * 0.125f;
#pragma unroll
        for (int j = 0; j < 32; ++j) q[j] = q[j] * qs * qg[half * 32 + j] * kg[half * 32 + j];
        float o[32];
#pragma unroll
        for (int j = 0; j < 32; ++j) o[j] = 0.f;
        float mx = -1e30f, l = 0.f;
        for (int rel = 0; rel <= 128; ++rel) {
            const int tk = t - rel * dil; if (tk < 0) break;
            const size_t mk = (size_t)(m - rel * dil);
            const unsigned* kp = (const unsigned*)(AK + mk * 768 + hd * 64 + half * 32);
            float dot = 0.f, k2 = 0.f;
#pragma unroll
            for (int j = 0; j < 16; ++j) { const unsigned u = kp[j]; const float k0 = bf2f(u & 0xffffu), k1 = bf2f(u >> 16); dot += q[2 * j] * k0 + q[2 * j + 1] * k1; k2 += k0 * k0 + k1 * k1; }
            dot += shfl_xor_l(dot, 1, F.lane); k2 += shfl_xor_l(k2, 1, F.lane);
            const float logit = dot * (1.f / sqrtf(k2 * (1.f / 64.f) + RMS_EPS)) + Lbias[hd * 129 + rel];
            const float mn = fmaxf(mx, logit); const float sc = __expf(mx - mn), p = __expf(logit - mn);
            l = l * sc + p; mx = mn;
            const unsigned* vp = (const unsigned*)(AV + mk * 768 + hd * 64 + half * 32);
#pragma unroll
            for (int j = 0; j < 16; ++j) { const unsigned u = vp[j]; o[2 * j] = o[2 * j] * sc + p * bf2f(u & 0xffffu); o[2 * j + 1] = o[2 * j + 1] * sc + p * bf2f(u >> 16); }
        }
        const float il = 1.f / l;
        unsigned* op = (unsigned*)(AQ + (size_t)m * 768 + hd * 64 + half * 32);
#pragma unroll
        for (int j = 0; j < 16; ++j) op[j] = f2bf(o[2 * j] * il) | (f2bf(o[2 * j + 1] * il) << 16);
        if (half == 0) LSE[(size_t)m * 12 + hd] = mx + logf(l);
    }
}
namespace at {
typedef short bf16x8 __attribute__((ext_vector_type(8)));
typedef float f32x4 __attribute__((ext_vector_type(4)));
typedef unsigned u32x4 __attribute__((ext_vector_type(4)));
typedef unsigned u32x2 __attribute__((ext_vector_type(2)));
constexpr int O_KL = 0, O_VT = 36864, O_LB = O_VT + 33792, O_QKG = O_LB + 9216, O_END = O_QKG + 256;
#define AT_MFMA(a, b, c) __builtin_amdgcn_mfma_f32_16x16x32_bf16((a), (b), (c), 0, 0, 0)
__device__ __forceinline__ unsigned cvtpk(float lo, float hi) { return pg8::cvt_pk_bf16(lo, hi); }
__device__ __forceinline__ bf16x8 mk8(u32x2 lo, u32x2 hi) { u32x4 v = {lo.x, lo.y, hi.x, hi.y}; return __builtin_bit_cast(bf16x8, v); }
__device__ __forceinline__ float shx(float v, int o, int lane) { return __builtin_bit_cast(float, __builtin_amdgcn_ds_bpermute((lane ^ o) << 2, __builtin_bit_cast(int, v))); }

__device__ __forceinline__ void bias_table(Frame& F, const float* relb, const float* qg, const float* kg) {
    LAS float* Lb = (LAS float*)(F.lds + O_LB);
    if (F.tid < 64) ((LAS float*)(F.lds + O_QKG))[F.tid] = qg[F.tid] * kg[F.tid] * (0.125f * 1.4426950408889634f);
    for (int idx = F.tid; idx < 12 * 192; idx += NTHR) { const int hd = idx / 192, rel = idx - hd * 192 - 32, g = hd >> 2; const int dil = g == 0 ? 1 : (g == 1 ? 4 : 16);
        Lb[idx] = (rel >= 0 && rel <= 128) ? relb[t5_bucket(rel * dil) * 12 + hd] * 1.4426950408889634f : -1e30f; }
    lds_barrier();
}
struct Raw { u32x4 kv[4], v0[2], v1[2], q0, q1; };
struct Idx { int b, hd, dil, r, n; };
__device__ __forceinline__ Idx decode(int it) { Idx x; const int g = it >> 9, rem = it & 511; x.b = rem >> 8; const int hh = (rem >> 6) & 3, rn = rem & 63;
    x.dil = g == 0 ? 1 : (g == 1 ? 4 : 16); const int nb = 64 / x.dil; x.r = rn / nb; x.n = rn - x.r * nb; x.hd = g * 4 + hh; return x; }
__device__ __forceinline__ void load_raw(Raw& R, const unsigned char* ws, const Idx& x, int tid, int wave, int fr, int fq) {
    const bf16* AQ = (const bf16*)(ws + A_Q); const bf16* AK = (const bf16*)(ws + A_K); const bf16* AV = (const bf16*)(ws + A_V);
    const size_t mb = (size_t)x.b * SEQ;
    { const int key = tid >> 1, half = tid & 1; const int u = (x.n - 1) * 128 + key;
#pragma unroll
      for (int e = 0; e < 4; ++e) R.kv[e] = (u32x4){0u, 0u, 0u, 0u};
      if (u >= 0) { const u32x4* kp = (const u32x4*)(AK + (mb + (size_t)u * x.dil + x.r) * 768 + x.hd * 64 + half * 32);
#pragma unroll
        for (int e = 0; e < 4; ++e) R.kv[e] = kp[e]; } }
    { const int kp = tid >> 2, dq = tid & 3; const int u0 = (x.n - 1) * 128 + 2 * kp;
      R.v0[0] = R.v0[1] = R.v1[0] = R.v1[1] = (u32x4){0u, 0u, 0u, 0u};
      if (u0 >= 0) { const u32x4* p0 = (const u32x4*)(AV + (mb + (size_t)u0 * x.dil + x.r) * 768 + x.hd * 64 + dq * 16); const u32x4* p1 = (const u32x4*)(AV + (mb + (size_t)(u0 + 1) * x.dil + x.r) * 768 + x.hd * 64 + dq * 16);
        R.v0[0] = p0[0]; R.v0[1] = p0[1]; R.v1[0] = p1[0]; R.v1[1] = p1[1]; } }
    { const int qi = 16 * wave + fr; const size_t mq = mb + (size_t)(x.n * 128 + qi) * x.dil + x.r;
      R.q0 = *(const u32x4*)(AQ + mq * 768 + x.hd * 64 + 8 * fq); R.q1 = *(const u32x4*)(AQ + mq * 768 + x.hd * 64 + 32 + 8 * fq); }
}
__device__ __forceinline__ void run(Frame& F0, unsigned char* ws, const float* qg, const float* kg, int first, int stride, int nitems) {
    LAS unsigned char* L = F0.lds; const int wave = F0.wave;
    bf16* AQ = (bf16*)(ws + A_Q); float* LSE = (float*)(ws + WS_LSE);
    Raw R;
    { int ln; asm volatile("v_mbcnt_lo_u32_b32 %0, -1, 0\n\tv_mbcnt_hi_u32_b32 %0, -1, %0" : "=v"(ln));
      if (first < nitems) { const Idx x0 = decode(first); load_raw(R, ws, x0, wave * 64 + ln, wave, ln & 15, ln >> 4); } }
#pragma unroll 1
    for (int it = first; it < nitems; it += stride) {
        int lane_c; asm volatile("v_mbcnt_lo_u32_b32 %0, -1, 0\n\tv_mbcnt_hi_u32_b32 %0, -1, %0" : "=v"(lane_c));
        const int lane = lane_c, tid = wave * 64 + lane, fr = lane & 15, fq = lane >> 4;
        const Idx x = decode(it); const int n = x.n, hd = x.hd;
        const size_t mb = (size_t)x.b * SEQ;
        {
            const int key = tid >> 1, half = tid & 1;
            float s2 = 0.f;
#pragma unroll
            for (int e = 0; e < 4; ++e)
#pragma unroll
                for (int c = 0; c < 4; ++c) { const float a0 = bf2f(R.kv[e][c] & 0xffffu), a1 = bf2f(R.kv[e][c] >> 16); s2 += a0 * a0 + a1 * a1; }
            s2 += shx(s2, 1, lane);
            const float rs = __builtin_amdgcn_rsqf(s2 * (1.f / 64.f) + RMS_EPS);
#pragma unroll
            for (int e = 0; e < 4; ++e) { u32x4 o;
#pragma unroll
                for (int c = 0; c < 4; ++c) o[c] = cvtpk(bf2f(R.kv[e][c] & 0xffffu) * rs, bf2f(R.kv[e][c] >> 16) * rs);
                *(LAS u32x4*)(L + O_KL + (key * 72 + half * 32 + e * 8) * 2) = o; }
        }
        {
            const int kp = tid >> 2, dq = tid & 3;
#pragma unroll
            for (int e = 0; e < 2; ++e)
#pragma unroll
                for (int c = 0; c < 4; ++c) { const int d = dq * 16 + e * 8 + c * 2; const unsigned a = R.v0[e][c], bq = R.v1[e][c];
                    *(LAS unsigned*)(L + O_VT + (d * 264 + 2 * kp) * 2) = (a & 0xffffu) | (bq << 16);
                    *(LAS unsigned*)(L + O_VT + ((d + 1) * 264 + 2 * kp) * 2) = (a >> 16) | (bq & 0xffff0000u); }
        }
        const int qi = 16 * wave + fr; const size_t mq = mb + (size_t)(n * 128 + qi) * x.dil + x.r;
        bf16x8 qf[2];
        {
            const u32x4 q0 = R.q0, q1 = R.q1;
            float s2 = 0.f;
#pragma unroll
            for (int c = 0; c < 4; ++c) { const float a0 = bf2f(q0[c] & 0xffffu), a1 = bf2f(q0[c] >> 16), b0 = bf2f(q1[c] & 0xffffu), b1 = bf2f(q1[c] >> 16); s2 += (a0 * a0 + a1 * a1) + (b0 * b0 + b1 * b1); }
            s2 += shx(s2, 16, lane); s2 += shx(s2, 32, lane);
            const float rs = __builtin_amdgcn_rsqf(s2 * (1.f / 64.f) + RMS_EPS);
            const LAS float* qk = (const LAS float*)(L + O_QKG) + 8 * fq;
            const f32x4 g0 = *(const LAS f32x4*)qk, g1 = *(const LAS f32x4*)(qk + 4), g2 = *(const LAS f32x4*)(qk + 32), g3 = *(const LAS f32x4*)(qk + 36);
            u32x4 o0, o1;
#pragma unroll
            for (int c = 0; c < 4; ++c) { const float ga = c < 2 ? g0[2 * c] : g1[2 * c - 4], gb = c < 2 ? g0[2 * c + 1] : g1[2 * c - 3], gc = c < 2 ? g2[2 * c] : g3[2 * c - 4], gd = c < 2 ? g2[2 * c + 1] : g3[2 * c - 3];
                o0[c] = cvtpk(bf2f(q0[c] & 0xffffu) * rs * ga, bf2f(q0[c] >> 16) * rs * gb);
                o1[c] = cvtpk(bf2f(q1[c] & 0xffffu) * rs * gc, bf2f(q1[c] >> 16) * rs * gd); }
            qf[0] = __builtin_bit_cast(bf16x8, o0); qf[1] = __builtin_bit_cast(bf16x8, o1);
        }
        lds_barrier();
        if (it + stride < nitems) { const Idx xn = decode(it + stride); load_raw(R, ws, xn, tid, wave, fr, fq); }
        const int kt0 = wave & ~1;
        f32x4 sc[10];
#pragma unroll
        for (int j = 0; j < 10; ++j) { sc[j] = (f32x4){0.f, 0.f, 0.f, 0.f};
#pragma unroll
            for (int s = 0; s < 2; ++s) { const bf16x8 kf = *(const LAS bf16x8*)(L + O_KL + (((kt0 + j) * 16 + fr) * 72 + 32 * s + 8 * fq) * 2); sc[j] = AT_MFMA(kf, qf[s], sc[j]); } }
        const LAS float* Lb = (const LAS float*)(L + O_LB) + hd * 192 + (qi + 160 - kt0 * 16 - 4 * fq);
        float mx = -1e30f;
#pragma unroll
        for (int j = 0; j < 10; ++j)
#pragma unroll
            for (int rr = 0; rr < 4; ++rr) sc[j][rr] += Lb[-(16 * j + rr)];
        if (n == 0) {
#pragma unroll
            for (int j = 0; j < 10; ++j)
#pragma unroll
                for (int rr = 0; rr < 4; ++rr) if ((kt0 + j) * 16 + 4 * fq + rr < 128) sc[j][rr] = -1e30f; }
#pragma unroll
        for (int j = 0; j < 10; ++j)
#pragma unroll
            for (int rr = 0; rr < 4; ++rr) mx = fmaxf(mx, sc[j][rr]);
        mx = fmaxf(mx, shx(mx, 16, lane)); mx = fmaxf(mx, shx(mx, 32, lane));
        float l = 0.f;
#pragma unroll
        for (int j = 0; j < 10; ++j)
#pragma unroll
            for (int rr = 0; rr < 4; ++rr) { const float p = __builtin_amdgcn_exp2f(sc[j][rr] - mx); sc[j][rr] = p; l += p; }
        l += shx(l, 16, lane); l += shx(l, 32, lane);
        f32x4 oc[4];
#pragma unroll
        for (int dt = 0; dt < 4; ++dt) oc[dt] = (f32x4){0.f, 0.f, 0.f, 0.f};
#pragma unroll
        for (int s = 0; s < 5; ++s) {
            const bf16x8 pf = mk8((u32x2){cvtpk(sc[2 * s][0], sc[2 * s][1]), cvtpk(sc[2 * s][2], sc[2 * s][3])}, (u32x2){cvtpk(sc[2 * s + 1][0], sc[2 * s + 1][1]), cvtpk(sc[2 * s + 1][2], sc[2 * s + 1][3])});
            const int key0 = (kt0 + 2 * s) * 16 + 4 * fq;
#pragma unroll
            for (int dt = 0; dt < 4; ++dt) { const bf16x8 vf = mk8(*(const LAS u32x2*)(L + O_VT + ((16 * dt + fr) * 264 + key0) * 2), *(const LAS u32x2*)(L + O_VT + ((16 * dt + fr) * 264 + key0 + 16) * 2)); oc[dt] = AT_MFMA(vf, pf, oc[dt]); }
        }
        const float il = __builtin_amdgcn_rcpf(l);
#pragma unroll
        for (int dt = 0; dt < 4; ++dt) *(u32x2*)(AQ + mq * 768 + hd * 64 + 16 * dt + 4 * fq) = (u32x2){cvtpk(oc[dt][0] * il, oc[dt][1] * il), cvtpk(oc[dt][2] * il, oc[dt][3] * il)};
        if (fq == 0) LSE[mq * 12 + hd] = (mx + __builtin_amdgcn_logf(l)) * 0.6931471805599453f;
        lds_barrier();
    }
}
#undef AT_MFMA
}

namespace lr {
typedef short bf16x8 __attribute__((ext_vector_type(8)));
typedef float f32x4 __attribute__((ext_vector_type(4)));
typedef float f32x2 __attribute__((ext_vector_type(2)));
typedef unsigned u32x4 __attribute__((ext_vector_type(4)));
constexpr int O_WAT = 0, O_WXT = 9216, O_XCF = 18432, O_XCB = O_XCF + 16384, O_AF = O_XCB + 9216, O_BF = O_AF + 16384, O_VEC = O_BF + 16384, O_FOLD = O_VEC + 2048, O_HC = O_FOLD + 4096, O_END = O_HC + 256;
constexpr int V_CW = 0, V_CB = 256, V_BA = 320, V_BX = 384, V_SPL = 448;
__device__ __forceinline__ float gelu_fast(float x) { const float u = 0.7978845608028654f * (x + 0.044715f * x * x * x); return x * (1.f - __builtin_amdgcn_rcpf(1.f + __expf(2.f * u))); }
#define LR_MFMA(a, b, c) __builtin_amdgcn_mfma_f32_16x16x32_bf16((a), (b), (c), 0, 0, 0)
template <int PASS>
__device__ __forceinline__ void item(Frame& F, unsigned char* ws, const LruP& P, int b, int blk, int tg) {
    LAS unsigned char* L = F.lds;
    const int wave = F.wave;
    LAS float* VEC = (LAS float*)(L + O_VEC);
    const bf16* ZBX = (const bf16*)(ws + Z_BX); bf16* ZBY = (bf16*)(ws + Z_BY);
    f32x2* AGG = (f32x2*)(ws + WS_LRUAGG);
    {
        const int tid = F.tid, j = tid & 63, ig = tid >> 6;
        float va[8], vx[8];
#pragma unroll
        for (int e = 0; e < 8; ++e) { va[e] = P.wa[blk * 4096 + (ig * 8 + e) * 64 + j]; vx[e] = P.wx[blk * 4096 + (ig * 8 + e) * 64 + j]; }
        *(LAS u32x4*)(L + O_WAT + (j * 72 + ig * 8) * 2) = (u32x4){pg8::cvt_pk_bf16(va[0], va[1]), pg8::cvt_pk_bf16(va[2], va[3]), pg8::cvt_pk_bf16(va[4], va[5]), pg8::cvt_pk_bf16(va[6], va[7])};
        *(LAS u32x4*)(L + O_WXT + (j * 72 + ig * 8) * 2) = (u32x4){pg8::cvt_pk_bf16(vx[0], vx[1]), pg8::cvt_pk_bf16(vx[2], vx[3]), pg8::cvt_pk_bf16(vx[4], vx[5]), pg8::cvt_pk_bf16(vx[6], vx[7])};
        if (tid < 64) { const int ch = blk * 64 + tid;
#pragma unroll
            for (int i = 0; i < 4; ++i) VEC[V_CW + i * 64 + tid] = P.cw[i * 512 + ch];
            VEC[V_CB + tid] = P.cb[ch]; VEC[V_BA + tid] = P.ba[ch]; VEC[V_BX + tid] = P.bx[ch]; VEC[V_SPL + tid] = softplusf_(-P.lam[ch]); }
    }
    float hcar = 0.f;
    if (PASS == 1) {
        const int c = F.lane; float A = 1.f, B = 0.f;
        f32x2 abv[15];
#pragma unroll
        for (int k = 0; k < 15; ++k) { abv[k] = (f32x2){1.f, 0.f}; if (k < tg) abv[k] = AGG[((size_t)b * 128 + wave * tg + k) * 512 + blk * 64 + c]; }
#pragma unroll
        for (int k = 0; k < 15; ++k) { B = abv[k].x * B + abv[k].y; A = abv[k].x * A; }
        ((LAS f32x2*)(L + O_FOLD))[wave * 64 + c] = (f32x2){A, B};
        lds_barrier();
        if (wave == 0) {
#pragma unroll
            for (int w = 0; w < 8; ++w) { const f32x2 ab = ((LAS f32x2*)(L + O_FOLD))[w * 64 + c]; hcar = ab.x * hcar + ab.y; } }
    }
    if (wave == 0) ((LAS float*)(L + O_HC))[F.lane] = hcar;
    u32x4 xq[4], yq = {0u, 0u, 0u, 0u};
#define LR_LOAD(TILE, TID) do { const int tt_ = (TID) >> 3, c8_ = ((TID) & 7) * 8, t0_ = (TILE) * 64; \
        _Pragma("unroll") for (int i = 0; i < 4; ++i) { const int ts = t0_ + tt_ - 3 + i; xq[i] = (u32x4){0u, 0u, 0u, 0u}; if (ts >= 0) xq[i] = *(const u32x4*)(ZBX + ((size_t)b * SEQ + ts) * 512 + blk * 64 + c8_); } \
        if (PASS == 1) yq = *(const u32x4*)(ZBY + ((size_t)b * SEQ + t0_ + tt_) * 512 + blk * 64 + c8_); } while (0)
    { int ln; asm volatile("v_mbcnt_lo_u32_b32 %0, -1, 0\n\tv_mbcnt_hi_u32_b32 %0, -1, %0" : "=v"(ln)); LR_LOAD(tg * 8, wave * 64 + ln); }
    lds_barrier();
#pragma unroll 1
    for (int tl = 0; tl < 8; ++tl) {
        int lane_c; asm volatile("v_mbcnt_lo_u32_b32 %0, -1, 0\n\tv_mbcnt_hi_u32_b32 %0, -1, %0" : "=v"(lane_c));
        const int lane = lane_c, tid = wave * 64 + lane, fr = lane & 15, fq = lane >> 4;
        const int tile = tg * 8 + tl, t0 = tile * 64; const size_t m0 = (size_t)b * SEQ + t0;
        const u32x4 yv = yq;
        {
            const int tt = tid >> 3, c8 = (tid & 7) * 8; float acc[8];
#pragma unroll
            for (int e = 0; e < 8; ++e) acc[e] = VEC[V_CB + c8 + e];
#pragma unroll
            for (int i = 0; i < 4; ++i) { const u32x4 xv = xq[i];
#pragma unroll
                    for (int c = 0; c < 4; ++c) { acc[2 * c] += VEC[V_CW + i * 64 + c8 + 2 * c] * bf2f(xv[c] & 0xffffu); acc[2 * c + 1] += VEC[V_CW + i * 64 + c8 + 2 * c + 1] * bf2f(xv[c] >> 16); } }
            if (tl + 1 < 8) LR_LOAD(tile + 1, tid);
            *(LAS f32x4*)(L + O_XCF + (tt * 64 + c8) * 4) = (f32x4){acc[0], acc[1], acc[2], acc[3]}; *(LAS f32x4*)(L + O_XCF + (tt * 64 + c8 + 4) * 4) = (f32x4){acc[4], acc[5], acc[6], acc[7]};
            *(LAS u32x4*)(L + O_XCB + (tt * 72 + c8) * 2) = (u32x4){pg8::cvt_pk_bf16(acc[0], acc[1]), pg8::cvt_pk_bf16(acc[2], acc[3]), pg8::cvt_pk_bf16(acc[4], acc[5]), pg8::cvt_pk_bf16(acc[6], acc[7])};
        }
        lds_barrier();
        {
            const int nt = wave & 3, mh = wave >> 2, jn = 16 * nt + fr;
            f32x4 ga[2], gx[2];
#pragma unroll
            for (int mm = 0; mm < 2; ++mm) { ga[mm] = (f32x4){0.f, 0.f, 0.f, 0.f}; gx[mm] = ga[mm]; }
#pragma unroll
            for (int s = 0; s < 2; ++s) { const bf16x8 wa = *(const LAS bf16x8*)(L + O_WAT + (jn * 72 + 32 * s + 8 * fq) * 2), wx = *(const LAS bf16x8*)(L + O_WXT + (jn * 72 + 32 * s + 8 * fq) * 2);
#pragma unroll
                for (int mm = 0; mm < 2; ++mm) { const bf16x8 xa = *(const LAS bf16x8*)(L + O_XCB + ((16 * (2 * mh + mm) + fr) * 72 + 32 * s + 8 * fq) * 2); ga[mm] = LR_MFMA(xa, wa, ga[mm]); gx[mm] = LR_MFMA(xa, wx, gx[mm]); } }
            const float ba = VEC[V_BA + jn], bx = VEC[V_BX + jn], spl = VEC[V_SPL + jn];
#pragma unroll
            for (int mm = 0; mm < 2; ++mm)
#pragma unroll
                for (int r = 0; r < 4; ++r) { const int tt = 16 * (2 * mh + mm) + 4 * fq + r;
                    const float xc = ((LAS float*)(L + O_XCF))[tt * 64 + jn];
                    const float g_a = __builtin_amdgcn_rcpf(1.f + __expf(-(ga[mm][r] + ba))), g_x = __builtin_amdgcn_rcpf(1.f + __expf(-(gx[mm][r] + bx)));
                    const float log_a = -8.0f * g_a * spl; const float a = __expf(log_a); float mult = __builtin_amdgcn_sqrtf(fmaxf(1.f - a * a, 0.f));
                    if (t0 + tt == 0) mult = 1.f;
                    ((LAS float*)(L + O_AF))[tt * 64 + jn] = a; ((LAS float*)(L + O_BF))[tt * 64 + jn] = xc * g_x * mult; }
        }
        lds_barrier();
        {
            float al[8], hl[8]; float A = 1.f, B = 0.f;
#pragma unroll
            for (int k = 0; k < 8; ++k) { const int tt = 8 * wave + k; const float a = ((LAS float*)(L + O_AF))[tt * 64 + lane]; B = a * B + ((LAS float*)(L + O_BF))[tt * 64 + lane]; A *= a; al[k] = A; hl[k] = B; }
            ((LAS f32x2*)(L + O_FOLD))[wave * 64 + lane] = (f32x2){A, B};
            lds_barrier();
            float hin = ((LAS float*)(L + O_HC))[lane];
            float At = 1.f;
#pragma unroll
            for (int w = 0; w < 8; ++w) { const f32x2 ab = ((LAS f32x2*)(L + O_FOLD))[w * 64 + lane]; if (w < wave) hin = ab.x * hin + ab.y; At *= ab.x; }
            if (PASS == 0) {
                if (wave == 7) { const float Bt = al[7] * hin + hl[7];
                    AGG[((size_t)b * 128 + tile) * 512 + blk * 64 + lane] = (f32x2){At, Bt}; }
            } else {
#pragma unroll
                for (int k = 0; k < 8; ++k) ((LAS float*)(L + O_BF))[(8 * wave + k) * 64 + lane] = al[k] * hin + hl[k];
                if (wave == 7) hcar = al[7] * hin + hl[7];
            }
        }
        if (PASS == 1) lds_barrier();
        if (PASS == 1 && wave == 7) ((LAS float*)(L + O_HC))[lane] = hcar;
        if (PASS == 1) {
            const int tt = tid >> 3, c8 = (tid & 7) * 8; bf16* yp = ZBY + (m0 + tt) * 512 + blk * 64 + c8;
            const f32x4 h0 = *(const LAS f32x4*)(L + O_BF + (tt * 64 + c8) * 4), h1 = *(const LAS f32x4*)(L + O_BF + (tt * 64 + c8 + 4) * 4);
            u32x4 o;
#pragma unroll
            for (int c = 0; c < 4; ++c) { const float hA = c < 2 ? h0[2 * c] : h1[2 * c - 4], hB = c < 2 ? h0[2 * c + 1] : h1[2 * c - 3];
                o[c] = pg8::cvt_pk_bf16(hA * gelu_fast(bf2f(yv[c] & 0xffffu)), hB * gelu_fast(bf2f(yv[c] >> 16))); }
            *(u32x4*)yp = o;
        }
    }
}
#undef LR_MFMA
#undef LR_LOAD
}

__device__ __forceinline__ void phase_combine(Frame& F, unsigned char* ws) {
    typedef unsigned u32x4c __attribute__((ext_vector_type(4)));
    const bf16* AQ = (const bf16*)(ws + A_Q); const float* LSE = (const float*)(ws + WS_LSE); bf16* OC = (bf16*)(ws + WS_OC);
    const int stride = F.G * NTHR;
    for (int it0 = F.vcu * NTHR + F.tid; it0 < M * 32; it0 += 4 * stride) {
        float l0[4], l1[4], l2[4]; u32x4c a0[4], a1[4], a2[4];
#pragma unroll
        for (int u = 0; u < 4; ++u) { const int it = it0 + u * stride; if (it < M * 32) { const int m = it >> 5, c8 = (it & 31) * 8, hh = c8 >> 6;
            l0[u] = LSE[(size_t)m * 12 + hh]; l1[u] = LSE[(size_t)m * 12 + 4 + hh]; l2[u] = LSE[(size_t)m * 12 + 8 + hh];
            a0[u] = *(const u32x4c*)(AQ + (size_t)m * 768 + c8); a1[u] = *(const u32x4c*)(AQ + (size_t)m * 768 + 256 + c8); a2[u] = *(const u32x4c*)(AQ + (size_t)m * 768 + 512 + c8); } }
#pragma unroll
        for (int u = 0; u < 4; ++u) { const int it = it0 + u * stride; if (it < M * 32) { const int m = it >> 5, c8 = (it & 31) * 8;
            const float mx = fmaxf(l0[u], fmaxf(l1[u], l2[u])); float e0 = __expf(l0[u] - mx), e1 = __expf(l1[u] - mx), e2 = __expf(l2[u] - mx); const float inv = 1.f / (e0 + e1 + e2);
            e0 *= inv; e1 *= inv; e2 *= inv;
            u32x4c o;
#pragma unroll
            for (int c = 0; c < 4; ++c) o[c] = pg8::cvt_pk_bf16(e0 * bf2f(a0[u][c] & 0xffffu) + e1 * bf2f(a1[u][c] & 0xffffu) + e2 * bf2f(a2[u][c] & 0xffffu), e0 * bf2f(a0[u][c] >> 16) + e1 * bf2f(a1[u][c] >> 16) + e2 * bf2f(a2[u][c] >> 16));
            *(u32x4c*)(OC + (size_t)m * 256 + c8) = o; } }
    }
}

constexpr int LDS_BYTES = 163840, LDSCTL_OFF = LDS_BYTES - 512, MISC_OFF = LDSCTL_OFF + 64;
constexpr int PH_PER_LAYER = 10, NPHASES = DEPTH * PH_PER_LAYER;

template <int PH>
__global__ void __launch_bounds__(NTHR, 2) fwd_kernel(Args args) {
    extern __shared__ __attribute__((aligned(16))) unsigned char lds[];
    Frame F0;
    F0.lds = (LAS unsigned char*)lds;
    F0.tid = 0; F0.lane = 0; F0.wave = __builtin_amdgcn_readfirstlane((int)threadIdx.x >> 6);
    F0.bid = blockIdx.x; F0.G = gridDim.x; { const int bx = blockIdx.x; F0.vcu = (F0.G % 8 == 0) ? (bx % 8) * (F0.G / 8) + bx / 8 : bx; }
    unsigned char* ws = args.ws;
    volatile LAS unsigned* MISC = (volatile LAS unsigned*)(F0.lds + MISC_OFF);
    for (int u = threadIdx.x; u < (LDS_BYTES - LDSCTL_OFF) / 4; u += NTHR) ((LAS unsigned*)(F0.lds + LDSCTL_OFF))[u] = 0u;
    __syncthreads();
    XcdBarrier bar; bar.bar = (unsigned*)(ws + WS_CTL) + CW_BAR; bar.x = 0; bar.st = nullptr;
    if (MK_ONE_LAUNCH) bar = xcd_barrier_post((unsigned*)(ws + WS_CTL) + CW_BAR, MISC + 8);
    const int lo = args.ph_lo, hi = args.ph_hi;
#define IN(k) ((PH < 0 || PH == ((k) % PH_PER_LAYER)) && lo <= (k) && (k) < hi)
#define SEAM(k) do { if (MK_ONE_LAUNCH && IN(k) && IN((k) + 1)) { for (int rb_ = 0; rb_ < REP_BAR; ++rb_) xcd_barrier(bar); } } while (0)

#define PHASE(k) if constexpr (PH < 0 || PH == (k)) if (IN(pb + (k)))
#define PHASE_BEGIN Frame F = phase_frame(F0); unsigned char* ws = launder(args.ws); float* outp = launder(args.out); (void)outp; float* ssb = (float*)(ws + WS_CTL + WS_SS); (void)ssb;
#pragma unroll 1
    for (int l = 0; l < DEPTH; ++l) {
        const int pb = l * PH_PER_LAYER;
        const float* xin = (l == 0) ? args.in[I_X] : args.out;
        if (l == 0) { PHASE(0) { PHASE_BEGIN phase_x2bf(F, launder(args.in[I_X]), (bf16*)(ws + WS_XB), ssb); for (int i = F.vcu * NTHR + F.tid; i < 3 * M; i += F.G * NTHR) ssb[M + i] = 0.f;     convert_wb1(F, args, 0, ws); } SEAM(pb + 0); }
        PHASE(1) { { PHASE_BEGIN rk::lora_inputs<0>(F, ws, launder(args.in[I_MU] + l * 1824), launder((const float*)ssb + (size_t)(2 * l) * M)); __syncthreads(); }
          PHASE_BEGIN pg8::Gemm g{(const bf16*)(ws + WS_XB), (const bf16*)(ws + WS_WMIX), M, 5120, D}; pg8::EpiMixMF E{ws, (const LAS float*)(F.lds + 131072)};
            for (int rep = 0; rep < REP_MIX; ++rep) { Frame Fr = phase_frame(F0); pg8::RstdOrder S; S.init(M, 5120, Fr.G, Fr.bid); S.ss = ssb + (size_t)(2 * l) * M; S.tab = (LAS float*)(Fr.lds + 131072); S.tid = Fr.tid;
                pg8::gemm_phase<pg8::EpiMixMF, pg8::RstdOrder, true, true, true>(Fr.lds, g, S, E, Fr.tid); } } SEAM(pb + 1);
        PHASE(2) { PHASE_BEGIN
            RwkvP P{args.in[I_MU] + l * 1824, args.in[I_W0] + l * 512, args.in[I_WUP] + l * 64 * 512, args.in[I_A0] + l * 512, args.in[I_AUP] + l * 64 * 512, args.in[I_GUP] + l * 160 * 512,
                    args.in[I_KK] + l * 512, args.in[I_KA] + l * 512, args.in[I_RK] + l * 512, args.in[I_LNG] + l * 512, args.in[I_LNB] + l * 512};
            LruP PL{args.in[I_CW] + l * 4 * 512, args.in[I_CB] + l * 512, args.in[I_LWA] + l * 8 * 4096, args.in[I_LBA] + l * 512, args.in[I_LWX] + l * 8 * 4096, args.in[I_LBX] + l * 512, args.in[I_LAM] + l * 512};
            { Frame Fi = phase_frame(F); rk::lora_inputs<1>(Fi, launder(ws), launder(P.mu), launder((const float*)ssb + (size_t)(2 * l) * M)); }
            xcd_barrier(bar);
            for (int rep = 0; rep < REP_RWKV; ++rep) for (int it = F.vcu; it < 256; it += F.G) { Frame Fi = phase_frame(F); rk2::item<0>(Fi, launder(ws), P, it >> 7, (it >> 4) & 7, it & 15); }
            for (int rep = 0; rep < REP_LRUA; ++rep) for (int it = F.vcu; it < 256; it += F.G) { Frame Fi = phase_frame(F); lr::item<0>(Fi, launder(ws), PL, it >> 7, (it >> 4) & 7, it & 15); }
            { Frame Fi = phase_frame(F); at::bias_table(Fi, launder(args.in[I_RELB]), launder(args.in[I_QG] + l * 64), launder(args.in[I_KG] + l * 64)); }
            { Frame Fi = phase_frame(F); at::run(Fi, launder(ws), launder(args.in[I_QG] + l * 64), launder(args.in[I_KG] + l * 64), Fi.vcu, Fi.G, 1536); }
        } SEAM(pb + 2);
        PHASE(3) { PHASE_BEGIN
            { RwkvP P{args.in[I_MU] + l * 1824, args.in[I_W0] + l * 512, args.in[I_WUP] + l * 64 * 512, args.in[I_A0] + l * 512, args.in[I_AUP] + l * 64 * 512, args.in[I_GUP] + l * 160 * 512,
                    args.in[I_KK] + l * 512, args.in[I_KA] + l * 512, args.in[I_RK] + l * 512, args.in[I_LNG] + l * 512, args.in[I_LNB] + l * 512};
              for (int rep = 0; rep < REP_RWKV; ++rep) for (int it = F.vcu; it < 256; it += F.G) { Frame Fi = phase_frame(F); rk2::item<1>(Fi, launder(ws), P, it >> 7, (it >> 4) & 7, it & 15); } }
            { LruP PL{args.in[I_CW] + l * 4 * 512, args.in[I_CB] + l * 512, args.in[I_LWA] + l * 8 * 4096, args.in[I_LBA] + l * 512, args.in[I_LWX] + l * 8 * 4096, args.in[I_LBX] + l * 512, args.in[I_LAM] + l * 512};
              for (int it = F.vcu; it < 256; it += F.G) { Frame Fi = phase_frame(F); lr::item<1>(Fi, launder(ws), PL, it >> 7, (it >> 4) & 7, it & 15); } }
            phase_combine(F, ws); } SEAM(pb + 3);
        PHASE(5) { for (int rep = 0; rep < (REP_PH == 5 ? 2 : 1); ++rep) {
            Frame Fa = phase_frame(F0); unsigned char* wsa = launder(args.ws); pg8::StaticOrder S; S.init(M, D, Fa.G, Fa.bid); pg8::Unit u;
            if (S.next(0, u)) {
                pg8::MergeDisp Dp{(const char*)(wsa + WS_XB), (const char*)(wsa + WS_WG), (const char*)wsa, (const char*)(wsa + WS_PA),
                                  (bf16*)(wsa + WS_GSCR), (bf16*)(wsa + WS_MERGED), (const float*)(wsa + WS_CTL + WS_SS) + (size_t)(2 * l) * M, (LAS float*)(Fa.lds + 131072), Fa.tid};
                pg8::gemm_seq<pg8::MergeDisp>(Fa.lds, Dp, 6, u.pm, u.pn, Fa.tid); }
        } } SEAM(pb + 5);
        PHASE(6) { { PHASE_BEGIN convert_wb2(F, args, l, ws); __syncthreads(); }
            { PHASE_BEGIN pg8::Gemm g{(const bf16*)(ws + WS_MERGED), (const bf16*)(ws + WS_WOUT), M, D, D}; pg8::StaticOrder S; S.init(M, D, F.G, F.bid); pg8::EpiResH E{nullptr, (const bf16*)(ws + WS_XB), (bf16*)(ws + WS_XB), nullptr, ssb + (size_t)(2 * l + 1) * M};
              if (REP_PH == 6) { pg8::EpiResH Ed = E; Ed.dry = true; Frame Fr = phase_frame(F0); pg8::gemm_phase<pg8::EpiResH, pg8::StaticOrder, true, true>(Fr.lds, g, S, Ed, Fr.tid); }
              { Frame Fr = phase_frame(F0); pg8::gemm_phase<pg8::EpiResH, pg8::StaticOrder, true, true>(Fr.lds, g, S, E, Fr.tid); } } } SEAM(pb + 6);
        PHASE(8) { if (l + 1 < DEPTH) { PHASE_BEGIN convert_wb1(F, args, l + 1, ws); __syncthreads(); }
            { PHASE_BEGIN pg8::Gemm g{(const bf16*)(ws + WS_XB), (const bf16*)(ws + WS_WUP), M, FF, D}; pg8::EpiActMF<2> E{(bf16*)(ws + WS_HID), FF, (const LAS float*)(F.lds + 131072)};
              for (int rep = 0; rep < (REP_PH == 8 ? 2 : 1); ++rep) { Frame Fr = phase_frame(F0); pg8::RstdOrder S; S.init(M, FF, Fr.G, Fr.bid); S.ss = ssb + (size_t)(2 * l + 1) * M; S.tab = (LAS float*)(Fr.lds + 131072); S.tid = Fr.tid;
                pg8::gemm_phase<pg8::EpiActMF<2>, pg8::RstdOrder, true, true, true>(Fr.lds, g, S, E, Fr.tid); } } } SEAM(pb + 8);
        PHASE(9) { PHASE_BEGIN pg8::Gemm g{(const bf16*)(ws + WS_HID), (const bf16*)(ws + WS_WDOWN), M, D, FF}; pg8::StaticOrder S; S.init(M, D, F.G, F.bid);
            pg8::EpiResH E{nullptr, (const bf16*)(ws + WS_XB), (l + 1 < DEPTH) ? (bf16*)(ws + WS_XB) : nullptr, (l + 1 < DEPTH) ? nullptr : outp, (l + 1 < DEPTH) ? ssb + (size_t)(2 * l + 2) * M : nullptr};
            if (REP_PH == 9) { pg8::EpiResH Ed = E; Ed.dry = true; Frame Fr = phase_frame(F0); pg8::gemm_phase<pg8::EpiResH, pg8::StaticOrder, true, true>(Fr.lds, g, S, Ed, Fr.tid); }
            { Frame Fr = phase_frame(F0); pg8::gemm_phase<pg8::EpiResH, pg8::StaticOrder, true, true>(Fr.lds, g, S, E, Fr.tid); } }
        if (l + 1 < DEPTH) SEAM(pb + 9);
    }
#undef PHASE
#undef PHASE_BEGIN
#undef IN
#undef SEAM
}

extern "C" void kernel_launch(void* const* d_in, const int* in_sizes, int n_in, void* d_out, int out_size, void* d_ws, size_t ws_size, hipStream_t stream) {
    static int grid = 0;
    if (grid == 0) {
        if (n_in != 31 || in_sizes[0] != M * D || out_size != M * D || ws_size < WS_END) { fprintf(stderr, "kernel_launch: unexpected shapes (n_in %d, in0 %d, out %d, ws %zu); nothing launched\n", n_in, n_in > 0 ? in_sizes[0] : -1, out_size, ws_size); grid = -1; return; }
        int dev = 0, cus = 0;
        if (hipGetDevice(&dev) != hipSuccess || hipDeviceGetAttribute(&cus, hipDeviceAttributeMultiprocessorCount, dev) != hipSuccess) { grid = -1; return; }
        bool okattr = true;
#define SETATTR(P) okattr = okattr && (hipFuncSetAttribute((const void*)fwd_kernel<P>, hipFuncAttributeMaxDynamicSharedMemorySize, LDS_BYTES) == hipSuccess)
#if MK_ONE_LAUNCH
        SETATTR(-1);
#else
        SETATTR(0); SETATTR(1); SETATTR(2); SETATTR(3); SETATTR(4); SETATTR(5); SETATTR(6); SETATTR(7); SETATTR(8); SETATTR(9);
#endif
        if (!okattr) { fprintf(stderr, "kernel_launch: hipFuncSetAttribute failed\n"); grid = -1; return; }
        (void)hipGetLastError();
        grid = cus;
    }
    if (grid < 0) return;
    if (hipMemsetAsync((char*)d_ws + WS_CTL, 0, CTL_ZERO_BYTES, stream) != hipSuccess) return;
    Args a{};
    for (int i = 0; i < 31; ++i) a.in[i] = (const float*)d_in[i];
    a.out = (float*)d_out; a.ws = (unsigned char*)d_ws;
#if MK_ONE_LAUNCH
    {
        a.ph_lo = 0; a.ph_hi = NPHASES;
        hipLaunchKernelGGL(fwd_kernel<-1>, dim3(grid), dim3(NTHR), LDS_BYTES, stream, a);
    }
#else
    {
#define LAUNCH(P) case P: hipLaunchKernelGGL(fwd_kernel<P>, dim3(grid), dim3(NTHR), LDS_BYTES, stream, a); break;
        for (int p = 0; p < NPHASES; ++p) { a.ph_lo = p; a.ph_hi = p + 1;
            switch (p % PH_PER_LAYER) { LAUNCH(0) LAUNCH(1) LAUNCH(2) LAUNCH(3) LAUNCH(4) LAUNCH(5) LAUNCH(6) LAUNCH(7) LAUNCH(8) LAUNCH(9) } }
    }
#endif
}
```

```cpp
#include <hip/hip_runtime.h>
#include <cstdio>
#include <cstdint>

#ifndef USE_MFMA
#define USE_MFMA 0x372
#endif
#define MF(k) ((USE_MFMA >> (k)) & 1)
#ifndef FAST_RWKV
#define FAST_RWKV 1
#endif
#ifndef FAST_ATTN
#define FAST_ATTN 1
#endif
#ifndef FAST_LRU
#define FAST_LRU 1
#endif
#ifndef RK_REP
#define RK_REP 0
#endif
#ifndef RK2_REP
#define RK2_REP 0
#endif
#ifndef REP_RWKV
#define REP_RWKV 1
#endif
#ifndef REP_LRUA
#define REP_LRUA 1
#endif
#ifndef REP_ATTN
#define REP_ATTN 1
#endif
#ifndef REP_BAR
#define REP_BAR 1
#endif
#ifndef REP_PH
#define REP_PH -1
#endif
#ifndef REP_MIX
#define REP_MIX 1
#endif
#ifndef REP_RMS
#define REP_RMS 1
#endif
#ifndef MK_ONE_LAUNCH
#define MK_ONE_LAUNCH 1
#endif

constexpr int BATCH = 2, SEQ = 8192, D = 1024, M = BATCH * SEQ, DEPTH = 2;
constexpr int DIN = 8224, FF = 4096;
constexpr int NMIX = 5152;
constexpr int NGATE = 3072;
constexpr float RMS_EPS = 1e-6f, GN_EPS = 64e-5f;
constexpr int NWAVES = 8, NTHR = 512;

constexpr size_t MiB = 1u << 20;
constexpr size_t WS_CTL = 0, CTL_ZERO_BYTES = 64 * 1024;
constexpr size_t WS_SS = 256 * 1024;
constexpr size_t WS_XB = 1 * MiB;
constexpr size_t WS_Z = 33 * MiB;
constexpr size_t Z_R = WS_Z + 0 * MiB, Z_K = WS_Z + 16 * MiB, Z_V = WS_Z + 32 * MiB, Z_L = WS_Z + 48 * MiB  , Z_BX = WS_Z + 57 * MiB;
constexpr size_t A_K = WS_Z + 73 * MiB, A_V = WS_Z + 97 * MiB, Z_BY = WS_Z + 121 * MiB, A_Q = WS_Z + 137 * MiB;
constexpr size_t WS_GATES = WS_Z;
constexpr size_t WS_MERGED = WS_Z;
constexpr size_t WS_GSCR = WS_Z + 32 * MiB;
constexpr size_t WS_H2 = WS_Z;
constexpr size_t WS_HID = WS_Z + 32 * MiB;
constexpr size_t WS_OA = 194 * MiB;
constexpr size_t WS_OC = 210 * MiB;
constexpr size_t WS_WMIX = 218 * MiB;
constexpr size_t WS_WTAIL = WS_WMIX + 5120 * 2048;
constexpr size_t WS_WG = WS_WMIX + 5376 * 2048;
constexpr size_t WS_PA = WS_WG + 6 * MiB, WS_PB = WS_PA + 1 * MiB, WS_PC = WS_PB + 1 * MiB, WS_WOUT = WS_PC + MiB / 2;
constexpr size_t WS_WUP = WS_OA, WS_WDOWN = WS_OA + 8 * MiB;
constexpr size_t WS_LSE = 239 * MiB;
constexpr size_t WS_RKPQ = 240 * MiB;
constexpr size_t WS_LRUAGG = 248 * MiB;
constexpr size_t WS_ZT = 249 * MiB;
constexpr size_t WS_END = 256 * MiB;
static_assert(WS_PB == WS_PA + MiB && WS_PC == WS_PB + MiB && WS_OA == 194 * MiB && Z_BY == 154 * MiB && WS_OC == 210 * MiB, "merge phase operand arithmetic");
static_assert(WS_WOUT + 2 * MiB <= WS_LSE && WS_WDOWN + 8 * MiB <= WS_OC, "ws map (weights)");
static_assert(WS_HID + (size_t)M * FF * 2 <= WS_OA && A_Q + (size_t)M * 768 * 2 <= WS_OA && WS_GATES + (size_t)M * NGATE * 2 <= Z_BY, "ws map");

#define GAS __attribute__((address_space(1)))
#define LAS __attribute__((address_space(3)))
typedef unsigned short bf16;
typedef GAS unsigned gu32;
#define RLX_AGENT __ATOMIC_RELAXED, __HIP_MEMORY_SCOPE_AGENT
__device__ __forceinline__ unsigned f2bf(float f) { unsigned u = __builtin_bit_cast(unsigned, f); return (u + 0x7fffu + ((u >> 16) & 1u)) >> 16; }
__device__ __forceinline__ float bf2f(unsigned h) { return __builtin_bit_cast(float, h << 16); }
__device__ __forceinline__ float shfl_xor_l(float v, int o, int lane) { return __builtin_bit_cast(float, __builtin_amdgcn_ds_bpermute((lane ^ o) << 2, __builtin_bit_cast(int, v))); }
__device__ __forceinline__ float wave_sum(float v, int lane) {
#pragma unroll
    for (int o = 1; o < 64; o <<= 1) v += shfl_xor_l(v, o, lane);
    return v;
}
template <class T> __device__ __forceinline__ T* launder(T* p) { GAS T* g = (GAS T*)p; asm volatile("" : "+s"(g)); return (T*)g; }
__device__ __forceinline__ float sigmoidf_(float x) { return 1.f / (1.f + __expf(-x)); }
__device__ __forceinline__ float softplusf_(float x) { return x > 20.f ? x : log1pf(expf(x)); }

#define XB_TMO      128
#define XB_XCNT(j)  (256  + 64 * (j))
#define XB_XSUB(j)  (1280 + 64 * (j))
#define XB_XGEN(j)  (2304 + 64 * (j))
#define XB_TOP      3328
#define XB_TOPGEN   3392
#define XCD_BAR_WORDS 3456
#define XB_SPIN_CAP (1u << 22)
constexpr int CW_BAR = 4096;
__device__ __forceinline__ unsigned xb_ld(unsigned* p)              { return __hip_atomic_load(p, __ATOMIC_RELAXED, __HIP_MEMORY_SCOPE_AGENT); }
__device__ __forceinline__ unsigned xb_add(unsigned* p, unsigned v) { return __hip_atomic_fetch_add(p, v, __ATOMIC_RELAXED, __HIP_MEMORY_SCOPE_AGENT); }
__device__ __forceinline__ unsigned xb_xcc_id() { return (unsigned)__builtin_amdgcn_s_getreg((3 << 11) | 20) & 0xFu; }
#define XB_SPIN(cond, bar) do { unsigned _sp = 0; while (cond) { \
    if ((++_sp & 255u) == 0u) { if (xb_ld(&(bar)[XB_TMO])) break; if (_sp > XB_SPIN_CAP) { atomicAdd(&(bar)[XB_TMO], 1u); break; } } } } while (0)
struct XcdBarrier { unsigned* bar; unsigned x; volatile LAS unsigned* st; };
__device__ __forceinline__ XcdBarrier xcd_barrier_post(unsigned* bar, volatile LAS unsigned* st) {
    XcdBarrier b; b.bar = bar; b.x = xb_xcc_id(); b.st = st;
    if (threadIdx.x == 0) (void)xb_add(&bar[XB_XCNT(b.x)], 1u);
    return b;
}
__device__ __forceinline__ void xcd_barrier_complete(unsigned* bar, unsigned x, unsigned& nloc, unsigned& nx) {
    const unsigned G = gridDim.x * gridDim.y * gridDim.z;
    unsigned sum, cnt, mine, sp = 0u;
    for (;;) {
        sum = 0u; cnt = 0u; mine = 0u;
#pragma unroll
        for (unsigned j = 0; j < 16; ++j) { const unsigned c = xb_ld(&bar[XB_XCNT(j)]); sum += c; cnt += (c > 0u) ? 1u : 0u; mine = (j == x) ? c : mine; }
        if (sum == G) break;
        __builtin_amdgcn_s_sleep(1);
        if ((++sp & 255u) == 0u) { if (xb_ld(&bar[XB_TMO])) break; if (sp > XB_SPIN_CAP) { atomicAdd(&bar[XB_TMO], 1u); break; } }
    }
    nloc = mine > 0u ? mine : 1u; nx = cnt > 0u ? cnt : 1u;
}
__device__ __forceinline__ void xcd_barrier(const XcdBarrier& b) {
    asm volatile("s_waitcnt vmcnt(0)" ::: "memory");
    __syncthreads();
    if (threadIdx.x == 0) {
        unsigned* bar = b.bar;
        __builtin_amdgcn_s_waitcnt(0);
        unsigned nloc = b.st[0], nx = b.st[1];
        if (nloc == 0u) { xcd_barrier_complete(bar, b.x, nloc, nx); b.st[0] = nloc; b.st[1] = nx; }
        const unsigned old = xb_add(&bar[XB_XSUB(b.x)], 1u);
        const unsigned gen = old / nloc;
        if (old + 1u == (gen + 1u) * nloc) {
            __builtin_amdgcn_fence(__ATOMIC_RELEASE, "agent");
            asm volatile("s_waitcnt vmcnt(0)" ::: "memory");
            const unsigned og = xb_add(&bar[XB_TOP], 1u);
            const unsigned tg = og / nx;
            if (og + 1u == (tg + 1u) * nx) xb_add(&bar[XB_TOPGEN], 1u);
            else XB_SPIN(xb_ld(&bar[XB_TOPGEN]) == tg, bar);
            __builtin_amdgcn_fence(__ATOMIC_ACQUIRE, "agent");
            xb_add(&bar[XB_XGEN(b.x)], 1u);
            asm volatile("s_waitcnt vmcnt(0)" ::: "memory");
        } else {
            XB_SPIN(xb_ld(&bar[XB_XGEN(b.x)]) == gen, bar);
            __builtin_amdgcn_fence(__ATOMIC_ACQUIRE, "agent");
            asm volatile("s_waitcnt vmcnt(0)" ::: "memory");
        }
    }
    __syncthreads();
}

namespace pg8 {
#define PG8_LAS __attribute__((address_space(3)))
typedef unsigned short bf16_t;
typedef short bf16x8 __attribute__((ext_vector_type(8)));
typedef float f32x4 __attribute__((ext_vector_type(4)));
typedef unsigned u32x4 __attribute__((ext_vector_type(4)));
constexpr int BM = 256, BK = 64, HALF = 128, HTB = HALF * BK * 2  , STAGE_BYTES = 8 * HTB, NXCD = 8, WGM = 8;

__host__ __device__ __forceinline__ int lds_byte(int r, int c) { const int st = (r >> 4) * 2 + (c >> 5), rr = r & 15, cc = c & 31, ob = rr * 64 + cc * 2; return st * 1024 + (ob ^ (((ob >> 9) & 1) << 5)); }
__host__ __device__ __forceinline__ void stage_rc(int b, int& R, int& C) { const int st = b / 1024, sb = b % 1024, swz = sb ^ (((sb >> 9) & 1) << 5); R = (st >> 1) * 16 + swz / 64; C = (st & 1) * 32 + (swz % 64) / 2; }
__host__ __device__ __forceinline__ int perm32(int rho) { const int n = rho >> 4, i = rho & 15; return 8 * (i >> 2) + 4 * n + (i & 3); }

struct Unit { int pm, pn, par; };
struct Gemm { const bf16_t* A; const bf16_t* Bt; int M, N, K; };

struct StaticOrder {
    int nM, nN, nwg, G, c;
    __host__ __device__ __forceinline__ void init(int M, int N, int G_, int c_) { nM = M / BM; nN = N / BM; nwg = nM * nN; G = G_; c = c_; }
    __host__ __device__ __forceinline__ bool next(int i, Unit& u) const {
        const long L = (long)i * G + c; if (L >= nwg) return false;
        int wgid = (int)L; { const int q = nwg / NXCD, r = nwg % NXCD, xcd = wgid % NXCD, off = wgid / NXCD; wgid = (xcd < r ? xcd * (q + 1) : r * (q + 1) + (xcd - r) * q) + off; }
        const int nig = WGM * nN, gid = wgid / nig, fm = gid * WGM, gsz = (nM - fm) < WGM ? (nM - fm) : WGM;
        u.pm = fm + ((wgid % nig) % gsz); u.pn = (wgid % nig) / gsz; u.par = i & 1; return true;
    }
    __device__ __forceinline__ void a_ready(const Unit&) const {}
    __device__ __forceinline__ void done(const Unit&) const {}
};
struct RstdOrder : StaticOrder {
    const float* ss; PG8_LAS float* tab; int tid;
    __device__ __forceinline__ void a_ready(const Unit& u) const { if (tid < 256) tab[u.par * 256 + tid] = __builtin_amdgcn_rsqf(ss[u.pm * BM + tid] * (1.f / 1024.f) + 1e-6f); }
};

typedef float f32x2_c __attribute__((ext_vector_type(2))); typedef __bf16 bf16x2_c __attribute__((ext_vector_type(2)));
__device__ __forceinline__ unsigned cvt_pk_bf16(float lo, float hi) { f32x2_c v = {lo, hi}; bf16x2_c b = __builtin_convertvector(v, bf16x2_c); return __builtin_bit_cast(unsigned, b); }

typedef _Float16 f16x2_c __attribute__((ext_vector_type(2))); typedef _Float16 f16x8 __attribute__((ext_vector_type(8)));
__device__ __forceinline__ unsigned cvt_pk_f16(float lo, float hi) { f32x2_c v = {lo, hi}; f16x2_c h = __builtin_convertvector(v, f16x2_c); return __builtin_bit_cast(unsigned, h); }
__device__ __forceinline__ float hfl(unsigned u) { return (float)__builtin_bit_cast(f16x2_c, u)[0]; }
__device__ __forceinline__ float hfh(unsigned u) { return (float)__builtin_bit_cast(f16x2_c, u)[1]; }
__device__ __forceinline__ u32x4 pack8h(const f32x4& v0, const f32x4& v1) { u32x4 w; w.x = cvt_pk_f16(v0[0], v0[1]); w.y = cvt_pk_f16(v0[2], v0[3]); w.z = cvt_pk_f16(v1[0], v1[1]); w.w = cvt_pk_f16(v1[2], v1[3]); return w; }
__device__ __forceinline__ f32x4 mfma16(bool f16, bf16x8 a, bf16x8 b, f32x4 c) {
    return f16 ? __builtin_amdgcn_mfma_f32_16x16x32_f16(__builtin_bit_cast(f16x8, a), __builtin_bit_cast(f16x8, b), c, 0, 0, 0) : __builtin_amdgcn_mfma_f32_16x16x32_bf16(a, b, c, 0, 0, 0); }
__device__ __forceinline__ u32x4 pack8(const f32x4& v0, const f32x4& v1) { u32x4 w; w.x = cvt_pk_bf16(v0[0], v0[1]); w.y = cvt_pk_bf16(v0[2], v0[3]); w.z = cvt_pk_bf16(v1[0], v1[1]); w.w = cvt_pk_bf16(v1[2], v1[3]); return w; }
__device__ __forceinline__ float bfl(unsigned u) { return __builtin_bit_cast(float, u << 16); }
__device__ __forceinline__ float bfh(unsigned u) { return __builtin_bit_cast(float, u & 0xffff0000u); }
__device__ __forceinline__ void st16_wt(void* base, unsigned byte_off, u32x4 v) {
    const __amdgpu_buffer_rsrc_t rsrc = __builtin_amdgcn_make_buffer_rsrc(base, (short)0, 0x7fffffff, 0x00020000);
    __builtin_amdgcn_raw_buffer_store_b128(v, rsrc, (int)byte_off, 0, 16);
}
__device__ __forceinline__ float fsig(float x) { return __builtin_amdgcn_rcpf(1.f + __builtin_amdgcn_exp2f(-1.4426950408889634f * x)); }
__device__ __forceinline__ float row_rstd(const float* ss, int row) { return __builtin_amdgcn_rsqf(ss[row] * (1.f / 1024.f) + RMS_EPS); }
struct EpiMixMF {
    static constexpr bool PERM = true, AFTER_DRAIN = false;
    unsigned char* ws; const PG8_LAS float* rt;
    __device__ __forceinline__ void operator()(const f32x4 (&acc)[2][2][4][2], const Unit& u, int wr, int wc, int fr, int fq) const {
        const int pn = u.pn; size_t boff; int ld, colt, lim;
        if (pn < 2)       { boff = Z_R;  ld = 512; colt = pn * 256;        lim = 512; }
        else if (pn < 4)  { boff = Z_K;  ld = 512; colt = (pn - 2) * 256;  lim = 512; }
        else if (pn < 6)  { boff = Z_V;  ld = 512; colt = (pn - 4) * 256;  lim = 512; }
        else if (pn < 7)  { boff = Z_L;  ld = 288; colt = 0;               lim = 256; }
        else if (pn < 9)  { boff = Z_BX; ld = 512; colt = (pn - 7) * 256;  lim = 512; }
        else if (pn < 11) { boff = Z_BY; ld = 512; colt = (pn - 9) * 256;  lim = 512; }
        else if (pn < 14) { boff = A_Q;  ld = 768; colt = (pn - 11) * 256; lim = 768; }
        else if (pn < 17) { boff = A_K;  ld = 768; colt = (pn - 14) * 256; lim = 768; }
        else              { boff = A_V;  ld = 768; colt = (pn - 17) * 256; lim = 768; }
        bf16_t* base = (bf16_t*)(ws + boff);
        const int row0 = u.pm * BM + wr * 64 + fr, col0 = colt + wc * 32 + 8 * fq;
#pragma unroll
        for (int ai = 0; ai < 2; ++ai)
#pragma unroll
            for (int m = 0; m < 4; ++m) { const unsigned roff = (unsigned)(((row0 + ai * HALF + m * 16) * ld + col0) * 2); const float rs = rt[u.par * 256 + wr * 64 + fr + ai * HALF + m * 16];
#pragma unroll
                for (int bj = 0; bj < 2; ++bj) if (col0 + bj * HALF < lim) st16_wt(base, roff + bj * HALF * 2, pack8(acc[ai][bj][m][0] * rs, acc[ai][bj][m][1] * rs)); }
    }
};
template <int ACT  > struct EpiActMF {
    static constexpr bool PERM = true, AFTER_DRAIN = false;
    bf16_t* O; int ldc; const PG8_LAS float* rt;
    __device__ __forceinline__ void operator()(const f32x4 (&acc)[2][2][4][2], const Unit& u, int wr, int wc, int fr, int fq) const {
        const int row0 = u.pm * BM + wr * 64 + fr, col0 = u.pn * BM + wc * 32 + 8 * fq;
#pragma unroll
        for (int ai = 0; ai < 2; ++ai)
#pragma unroll
            for (int m = 0; m < 4; ++m) { bf16_t* rowp = O + (size_t)(row0 + ai * HALF + m * 16) * ldc + col0; const float rs = rt[u.par * 256 + wr * 64 + fr + ai * HALF + m * 16] * (ACT == 1 ? -1.4426950408889634f : 1.f);
#pragma unroll
                for (int bj = 0; bj < 2; ++bj) { f32x4 v0 = acc[ai][bj][m][0] * rs, v1 = acc[ai][bj][m][1] * rs;
#pragma unroll
                    for (int e = 0; e < 4; ++e) {
                        if (ACT == 1) { v0[e] = __builtin_amdgcn_rcpf(1.f + __builtin_amdgcn_exp2f(v0[e])); v1[e] = __builtin_amdgcn_rcpf(1.f + __builtin_amdgcn_exp2f(v1[e])); }
                        if (ACT == 2) { const float a = fmaxf(v0[e], 0.f), b = fmaxf(v1[e], 0.f); v0[e] = a * a; v1[e] = b * b; } }
                    if (ACT == 2) st16_wt(O, (unsigned)(((size_t)(row0 + ai * HALF + m * 16) * ldc + col0 + bj * HALF) * 2), pack8(v0, v1)); else *(u32x4*)(rowp + bj * HALF) = pack8(v0, v1); } }
    }
};
template <int BR> struct EpiMergeMF {
    static constexpr bool PERM = true, AFTER_DRAIN = false;
    const bf16_t* gates; bf16_t* O; int gld, goff;
    __device__ __forceinline__ void operator()(const f32x4 (&acc)[2][2][4][2], const Unit& u, int wr, int wc, int fr, int fq) const {
        const int row0 = u.pm * BM + wr * 64 + fr, col0 = u.pn * BM + wc * 32 + 8 * fq;
#pragma unroll
        for (int ai = 0; ai < 2; ++ai) {
            u32x4 gv[4][2], pv[4][2];
#pragma unroll
            for (int m = 0; m < 4; ++m)
#pragma unroll
                for (int bj = 0; bj < 2; ++bj) { const size_t r = (size_t)(row0 + ai * HALF + m * 16);
                    gv[m][bj] = *(const u32x4*)(gates + r * gld + goff + col0 + bj * HALF);
                    if (BR > 0) pv[m][bj] = *(const u32x4*)(O + r * 1024 + col0 + bj * HALF); }
#pragma unroll
            for (int m = 0; m < 4; ++m)
#pragma unroll
                for (int bj = 0; bj < 2; ++bj) { const size_t r = (size_t)(row0 + ai * HALF + m * 16); const u32x4 g = gv[m][bj];
                    f32x4 v0 = acc[ai][bj][m][0], v1 = acc[ai][bj][m][1];
                    v0[0] *= bfl(g.x); v0[1] *= bfh(g.x); v0[2] *= bfl(g.y); v0[3] *= bfh(g.y); v1[0] *= bfl(g.z); v1[1] *= bfh(g.z); v1[2] *= bfl(g.w); v1[3] *= bfh(g.w);
                    if (BR > 0) { const u32x4 p = pv[m][bj];
                        v0[0] += bfl(p.x); v0[1] += bfh(p.x); v0[2] += bfl(p.y); v0[3] += bfh(p.y); v1[0] += bfl(p.z); v1[1] += bfh(p.z); v1[2] += bfl(p.w); v1[3] += bfh(p.w); }
                    *(u32x4*)(O + r * 1024 + col0 + bj * HALF) = pack8(v0, v1); }
            asm volatile("" ::: "memory");
        }
    }
};
struct EpiResMF {
    static constexpr bool PERM = false, AFTER_DRAIN = false;
    const float* base; float* out; bf16_t* xb; float* ss; bool dry = false;
    __device__ __forceinline__ void operator()(const f32x4 (&acc)[2][2][4][2], const Unit& u, int wr, int wc, int fr, int fq) const {
        if (dry && acc[0][0][0][0][0] != 1.2345e30f) return;
        typedef unsigned u32x2e __attribute__((ext_vector_type(2)));
        const int row0 = u.pm * BM + wr * 64 + fr, col0 = u.pn * BM + wc * 32 + 4 * fq, lane = fq * 16 + fr;
#pragma unroll
        for (int ai = 0; ai < 2; ++ai)
#pragma unroll
            for (int m = 0; m < 4; ++m) { const int row = row0 + ai * HALF + m * 16; const size_t off = (size_t)row * 1024 + col0; float s = 0.f;
#pragma unroll
                for (int bj = 0; bj < 2; ++bj)
#pragma unroll
                    for (int n = 0; n < 2; ++n) { const f32x4 b = *(const f32x4*)(base + off + bj * HALF + n * 16); const f32x4 v = b + acc[ai][bj][m][n]; *(f32x4*)(out + off + bj * HALF + n * 16) = v;
                        if (xb) { *(u32x2e*)(xb + off + bj * HALF + n * 16) = (u32x2e){cvt_pk_bf16(v[0], v[1]), cvt_pk_bf16(v[2], v[3])}; s += (v[0] * v[0] + v[1] * v[1]) + (v[2] * v[2] + v[3] * v[3]); } }
                if (ss) { s += __builtin_bit_cast(float, __builtin_amdgcn_ds_bpermute((lane ^ 16) << 2, __builtin_bit_cast(int, s))); s += __builtin_bit_cast(float, __builtin_amdgcn_ds_bpermute((lane ^ 32) << 2, __builtin_bit_cast(int, s)));
                    if (fq == 0) atomicAdd(ss + row, s); }
                if (m & 1) asm volatile("" ::: "memory"); }
    }
};

struct EpiResH {
    static constexpr bool PERM = true, AFTER_DRAIN = false;
    const float* basef; const bf16_t* xbr; bf16_t* xbw; float* outf; float* ss; bool dry = false;
    __device__ __forceinline__ void operator()(const f32x4 (&acc)[2][2][4][2], const Unit& u, int wr, int wc, int fr, int fq) const {
        if (dry && acc[0][0][0][0][0] != 1.2345e30f) return;
        const int row0 = u.pm * BM + wr * 64 + fr, col0 = u.pn * BM + wc * 32 + 8 * fq, lane = fq * 16 + fr;
#pragma unroll
        for (int ai = 0; ai < 2; ++ai)
#pragma unroll
            for (int mp = 0; mp < 2; ++mp) {
                f32x4 b0[2][2], b1[2][2];
#pragma unroll
                for (int mm = 0; mm < 2; ++mm)
#pragma unroll
                    for (int bj = 0; bj < 2; ++bj) { const size_t off = (size_t)(row0 + ai * HALF + (2 * mp + mm) * 16) * 1024 + col0 + bj * HALF;
                        if (basef) { b0[mm][bj] = *(const f32x4*)(basef + off); b1[mm][bj] = *(const f32x4*)(basef + off + 4); }
                        else { const u32x4 p = *(const u32x4*)(xbr + off); b0[mm][bj] = (f32x4){hfl(p.x), hfh(p.x), hfl(p.y), hfh(p.y)}; b1[mm][bj] = (f32x4){hfl(p.z), hfh(p.z), hfl(p.w), hfh(p.w)}; } }
#pragma unroll
                for (int mm = 0; mm < 2; ++mm) { const int m = 2 * mp + mm, row = row0 + ai * HALF + m * 16; float s = 0.f;
#pragma unroll
                    for (int bj = 0; bj < 2; ++bj) { const size_t off = (size_t)row * 1024 + col0 + bj * HALF;
                        const f32x4 v0 = b0[mm][bj] + acc[ai][bj][m][0], v1 = b1[mm][bj] + acc[ai][bj][m][1];
                        if (outf) { *(f32x4*)(outf + off) = v0; *(f32x4*)(outf + off + 4) = v1; }
                        if (xbw) { *(u32x4*)(xbw + off) = pack8h(v0, v1); s += ((v0[0] * v0[0] + v0[1] * v0[1]) + (v0[2] * v0[2] + v0[3] * v0[3])) + ((v1[0] * v1[0] + v1[1] * v1[1]) + (v1[2] * v1[2] + v1[3] * v1[3])); } }
                    if (ss) { s += __builtin_bit_cast(float, __builtin_amdgcn_ds_bpermute((lane ^ 16) << 2, __builtin_bit_cast(int, s))); s += __builtin_bit_cast(float, __builtin_amdgcn_ds_bpermute((lane ^ 32) << 2, __builtin_bit_cast(int, s)));
                        if (fq == 0) atomicAdd(ss + row, s); } }
                asm volatile("" ::: "memory"); }
    }
};

template <class Epi, class Sched, bool ALIGN_EPI = false, bool SP2 = false, bool F16 = false>
__device__ __forceinline__ void gemm_phase(PG8_LAS unsigned char* lds, const Gemm g, const Sched& S, const Epi& E, const int tid) {
    const int wid = __builtin_amdgcn_readfirstlane(tid >> 6), lane = tid & 63, wr = wid >> 2, wc = wid & 3, fr = lane & 15, fq = lane >> 4;
    const int K = g.K, nt = K / BK;
    unsigned voffA[2], voffB[2];
#pragma unroll
    for (int i = 0; i < 2; ++i) { int R, C; stage_rc(tid * 16 + i * 8192, R, C); const int Rb = Epi::PERM ? ((R & ~31) + perm32(R & 31)) : R;
        voffA[i] = (unsigned)(R * K + C) * 2u; voffB[i] = (unsigned)(Rb * K + C) * 2u; }
    const size_t kstep = (size_t)(BK * 2);
    const size_t hstep = (size_t)HALF * K * 2;
    const size_t tstep = 2 * hstep;
    const unsigned ldsw = (unsigned)wid * 1024u;
    const int aoff = lds_byte(wr * 64 + fr, fq * 8), boff = lds_byte(wc * 32 + fr, fq * 8);
#define PG8_SA(b, h) (((b) * 2 + (h)) * HTB)
#define PG8_SB(b, h) ((4 + (b) * 2 + (h)) * HTB)
#define PG8_STAGE(bufoff, gbase, voff) do { _Pragma("unroll") for (int _i = 0; _i < 2; ++_i) \
        __builtin_amdgcn_global_load_lds((const unsigned*)((const char*)(gbase) + (voff)[_i]), (PG8_LAS unsigned*)(lds + (bufoff) + ldsw + _i * 8192), 16, 0, 0); } while (0)
#define PG8_LDA(dst, b, h) do { _Pragma("unroll") for (int m = 0; m < 4; ++m) _Pragma("unroll") for (int k = 0; k < 2; ++k) dst[m][k] = *(const PG8_LAS bf16x8*)(lds + PG8_SA(b, h) + aoff + m * 2048 + k * 1024); } while (0)
#define PG8_LDB(dst, b, h) do { _Pragma("unroll") for (int n = 0; n < 2; ++n) _Pragma("unroll") for (int k = 0; k < 2; ++k) dst[n][k] = *(const PG8_LAS bf16x8*)(lds + PG8_SB(b, h) + boff + n * 2048 + k * 1024); } while (0)
#define PG8_MMA(ai, bj, At, Bt) do { __builtin_amdgcn_s_setprio(1); _Pragma("unroll") for (int m = 0; m < 4; ++m) _Pragma("unroll") for (int n = 0; n < 2; ++n) _Pragma("unroll") for (int k = 0; k < 2; ++k) \
        acc[ai][bj][m][n] = mfma16(F16, Bt[n][k], At[m][k], acc[ai][bj][m][n]); __builtin_amdgcn_s_setprio(0); } while (0)
#define PG8_WAIT_V(n) asm volatile("s_waitcnt vmcnt(" #n ")" ::: "memory")
#define PG8_WAIT_L(n) asm volatile("s_waitcnt lgkmcnt(" #n ")" ::: "memory")
#define PG8_BAR __builtin_amdgcn_s_barrier()
#define PG8_SCHED __builtin_amdgcn_sched_barrier(0)
    Unit cur, nxt; int ui = 0;
    if (!S.next(0, cur)) return;
    f32x4 acc[2][2][4][2];
#pragma unroll
    for (int a = 0; a < 2; ++a)
#pragma unroll
        for (int b = 0; b < 2; ++b)
#pragma unroll
            for (int m = 0; m < 4; ++m)
#pragma unroll
                for (int n = 0; n < 2; ++n) acc[a][b][m][n] = (f32x4){0.f, 0.f, 0.f, 0.f};
    bf16x8 At[4][2], B0[2][2], B1[2][2];
    const char* cA = (const char*)g.A + (size_t)cur.pm * tstep; const char* cB = (const char*)g.Bt + (size_t)cur.pn * tstep;
    S.a_ready(cur);
    if constexpr (SP2) {
        PG8_STAGE(PG8_SB(0, 0), cB, voffB); PG8_STAGE(PG8_SB(0, 1), cB + hstep, voffB); PG8_STAGE(PG8_SA(0, 0), cA, voffA); PG8_STAGE(PG8_SA(0, 1), cA + hstep, voffA);
        if (wr == 1) PG8_BAR;
        PG8_WAIT_V(2); PG8_BAR;
        PG8_STAGE(PG8_SB(1, 0), cB + kstep, voffB); PG8_STAGE(PG8_SA(1, 0), cA + kstep, voffA); PG8_STAGE(PG8_SB(1, 1), cB + hstep + kstep, voffB);
        PG8_WAIT_V(6); PG8_BAR;
    } else {
        PG8_STAGE(PG8_SB(0, 0), cB, voffB); PG8_STAGE(PG8_SA(0, 0), cA, voffA); PG8_STAGE(PG8_SB(0, 1), cB + hstep, voffB); PG8_STAGE(PG8_SA(0, 1), cA + hstep, voffA);
        if (wr == 1) PG8_BAR;
        PG8_WAIT_V(4); PG8_BAR;
        PG8_STAGE(PG8_SB(1, 0), cB + kstep, voffB); PG8_STAGE(PG8_SA(1, 0), cA + kstep, voffA); PG8_STAGE(PG8_SB(1, 1), cB + hstep + kstep, voffB);
        PG8_WAIT_V(6); PG8_BAR;
    }
    for (;;) {
        const bool has_next = S.next(ui + 1, nxt);
        const char* nA = has_next ? (const char*)g.A + (size_t)nxt.pm * tstep : cA; const char* nB = has_next ? (const char*)g.Bt + (size_t)nxt.pn * tstep : cB;
#pragma unroll 1
        for (int t = 0; t < nt; t += 2) {
            const bool last = (t == nt - 2);
            const char* a1 = cA + (size_t)(t + 1) * kstep;
            const char* a2 = last ? nA : cA + (size_t)(t + 2) * kstep; const char* b2 = last ? nB : cB + (size_t)(t + 2) * kstep;
            const char* a3 = a2 + kstep; const char* b3 = b2 + kstep;
            if (last && has_next) S.a_ready(nxt);
            if constexpr (SP2) {
            PG8_LDB(B0, 0, 0); PG8_LDB(B1, 0, 1); PG8_SCHED; PG8_LDA(At, 0, 0); PG8_STAGE(PG8_SA(1, 1), a1 + hstep, voffA);
            PG8_WAIT_V(8); PG8_WAIT_L(0); PG8_BAR; PG8_MMA(0, 0, At, B0); PG8_MMA(0, 1, At, B1); PG8_BAR; PG8_SCHED;
            PG8_LDA(At, 0, 1); PG8_STAGE(PG8_SB(0, 0), b2, voffB); PG8_STAGE(PG8_SB(0, 1), b2 + hstep, voffB); PG8_STAGE(PG8_SA(0, 0), a2, voffA);
            PG8_WAIT_V(8); PG8_WAIT_L(0); PG8_BAR; PG8_MMA(1, 0, At, B0); PG8_MMA(1, 1, At, B1); PG8_BAR; PG8_SCHED;
            PG8_LDB(B0, 1, 0); PG8_LDB(B1, 1, 1); PG8_SCHED; PG8_LDA(At, 1, 0); PG8_STAGE(PG8_SA(0, 1), a2 + hstep, voffA);
            PG8_WAIT_V(8); PG8_WAIT_L(0); PG8_BAR; PG8_MMA(0, 0, At, B0); PG8_MMA(0, 1, At, B1); PG8_BAR; PG8_SCHED;
            PG8_LDA(At, 1, 1); PG8_STAGE(PG8_SB(1, 0), b3, voffB); PG8_STAGE(PG8_SB(1, 1), b3 + hstep, voffB); PG8_STAGE(PG8_SA(1, 0), a3, voffA);
            PG8_WAIT_V(8); PG8_WAIT_L(0); PG8_BAR; PG8_MMA(1, 0, At, B0); PG8_MMA(1, 1, At, B1); PG8_BAR; PG8_SCHED;
            } else {
            PG8_LDB(B0, 0, 0); PG8_SCHED; PG8_LDA(At, 0, 0); PG8_STAGE(PG8_SA(1, 1), a1 + hstep, voffA);
            PG8_WAIT_L(8); PG8_BAR; PG8_WAIT_L(0); PG8_MMA(0, 0, At, B0); PG8_BAR; PG8_SCHED;
            PG8_LDB(B1, 0, 1); PG8_STAGE(PG8_SB(0, 0), b2, voffB);
            PG8_BAR; PG8_WAIT_L(0); PG8_MMA(0, 1, At, B1); PG8_BAR;
            PG8_LDA(At, 0, 1); PG8_STAGE(PG8_SA(0, 0), a2, voffA);
            PG8_BAR; PG8_WAIT_L(0); PG8_MMA(1, 0, At, B0); PG8_BAR; PG8_SCHED;
            PG8_STAGE(PG8_SB(0, 1), b2 + hstep, voffB);
            PG8_WAIT_V(6); PG8_BAR; PG8_MMA(1, 1, At, B1); PG8_BAR;
            PG8_LDB(B0, 1, 0); PG8_SCHED; PG8_LDA(At, 1, 0); PG8_STAGE(PG8_SA(0, 1), a2 + hstep, voffA);
            PG8_WAIT_L(8); PG8_BAR; PG8_WAIT_L(0); PG8_MMA(0, 0, At, B0); PG8_BAR; PG8_SCHED;
            PG8_LDB(B1, 1, 1); PG8_STAGE(PG8_SB(1, 0), b3, voffB);
            PG8_BAR; PG8_WAIT_L(0); PG8_MMA(0, 1, At, B1); PG8_BAR;
            PG8_LDA(At, 1, 1); PG8_STAGE(PG8_SA(1, 0), a3, voffA);
            PG8_BAR; PG8_WAIT_L(0); PG8_MMA(1, 0, At, B0); PG8_BAR; PG8_SCHED;
            PG8_STAGE(PG8_SB(1, 1), b3 + hstep, voffB);
            PG8_WAIT_V(6); PG8_BAR; PG8_MMA(1, 1, At, B1); PG8_BAR;
            }
        }
        if constexpr (ALIGN_EPI) { if (wr == 0) PG8_BAR; }
        if constexpr (!Epi::AFTER_DRAIN) { int fr_e = fr, fq_e = fq; asm volatile("" : "+v"(fr_e), "+v"(fq_e));
            E(acc, cur, wr, wc, fr_e, fq_e); S.done(cur); }
        if (!has_next) break;
#pragma unroll
        for (int a = 0; a < 2; ++a)
#pragma unroll
            for (int b = 0; b < 2; ++b)
#pragma unroll
                for (int m = 0; m < 4; ++m)
#pragma unroll
                    for (int n = 0; n < 2; ++n) acc[a][b][m][n] = (f32x4){0.f, 0.f, 0.f, 0.f};
        cur = nxt; cA = nA; cB = nB; ++ui;
        if constexpr (ALIGN_EPI) { if (wr == 1) PG8_BAR; }
    }
    PG8_WAIT_V(0);
    if constexpr (!ALIGN_EPI) { if (wr == 0) PG8_BAR; }
    PG8_BAR;
    if constexpr (Epi::AFTER_DRAIN) { E.fused(acc, cur, wr, wc, fr, fq, lds, wid, lane); S.done(cur); }
#undef PG8_SA
#undef PG8_SB
#undef PG8_STAGE
#undef PG8_LDA
#undef PG8_LDB
#undef PG8_MMA
#undef PG8_WAIT_V
#undef PG8_WAIT_L
#undef PG8_BAR
#undef PG8_SCHED
}

struct XOp { const char* A; const char* B; int K; };
template <class Disp>
__device__ __forceinline__ void gemm_seq(PG8_LAS unsigned char* lds, const Disp& Dp, const int nsteps, const int pm, const int pn, const int tid) {
    const int wid = __builtin_amdgcn_readfirstlane(tid >> 6), lane = tid & 63, wr = wid >> 2, wc = wid & 3, fr = lane & 15, fq = lane >> 4;
    int RA[2], RB[2], C2[2];
#pragma unroll
    for (int i = 0; i < 2; ++i) { int R, C; stage_rc(tid * 16 + i * 8192, R, C); const int Rb = (R & ~31) + perm32(R & 31); RA[i] = 2 * R; RB[i] = 2 * Rb; C2[i] = 2 * C; }
    const size_t kstep = (size_t)(BK * 2);
    const unsigned ldsw = (unsigned)wid * 1024u;
    const int aoff = lds_byte(wr * 64 + fr, fq * 8), boff = lds_byte(wc * 32 + fr, fq * 8);
#define PG8_SA(b, h) (((b) * 2 + (h)) * HTB)
#define PG8_SB(b, h) ((4 + (b) * 2 + (h)) * HTB)
#define PG8_STAGEX(bufoff, gbase, Rx, KK) do { _Pragma("unroll") for (int _i = 0; _i < 2; ++_i) \
        __builtin_amdgcn_global_load_lds((const unsigned*)((const char*)(gbase) + (unsigned)((Rx)[_i] * (KK) + C2[_i])), (PG8_LAS unsigned*)(lds + (bufoff) + ldsw + _i * 8192), 16, 0, 0); } while (0)
#define PG8_LDA(dst, b, h) do { _Pragma("unroll") for (int m = 0; m < 4; ++m) _Pragma("unroll") for (int k = 0; k < 2; ++k) dst[m][k] = *(const PG8_LAS bf16x8*)(lds + PG8_SA(b, h) + aoff + m * 2048 + k * 1024); } while (0)
#define PG8_LDB(dst, b, h) do { _Pragma("unroll") for (int n = 0; n < 2; ++n) _Pragma("unroll") for (int k = 0; k < 2; ++k) dst[n][k] = *(const PG8_LAS bf16x8*)(lds + PG8_SB(b, h) + boff + n * 2048 + k * 1024); } while (0)
#define PG8_MMA(ai, bj, At, Bt) do { __builtin_amdgcn_s_setprio(1); if (cf16) { _Pragma("unroll") for (int m = 0; m < 4; ++m) _Pragma("unroll") for (int n = 0; n < 2; ++n) _Pragma("unroll") for (int k = 0; k < 2; ++k) \
        acc[ai][bj][m][n] = mfma16(true, Bt[n][k], At[m][k], acc[ai][bj][m][n]); } else { _Pragma("unroll") for (int m = 0; m < 4; ++m) _Pragma("unroll") for (int n = 0; n < 2; ++n) _Pragma("unroll") for (int k = 0; k < 2; ++k) \
        acc[ai][bj][m][n] = mfma16(false, Bt[n][k], At[m][k], acc[ai][bj][m][n]); } __builtin_amdgcn_s_setprio(0); } while (0)
#define PG8_WAIT_V(n) asm volatile("s_waitcnt vmcnt(" #n ")" ::: "memory")
#define PG8_WAIT_L(n) asm volatile("s_waitcnt lgkmcnt(" #n ")" ::: "memory")
#define PG8_BAR __builtin_amdgcn_s_barrier()
#define PG8_SCHED __builtin_amdgcn_sched_barrier(0)
    f32x4 acc[2][2][4][2];
#pragma unroll
    for (int a = 0; a < 2; ++a)
#pragma unroll
        for (int b = 0; b < 2; ++b)
#pragma unroll
            for (int m = 0; m < 4; ++m)
#pragma unroll
                for (int n = 0; n < 2; ++n) acc[a][b][m][n] = (f32x4){0.f, 0.f, 0.f, 0.f};
    bf16x8 At[4][2], B0[2][2], B1[2][2];
    int ui = 0;
    XOp op = Dp.op(0);
    int cK = op.K; size_t ch = (size_t)HALF * cK * 2;
    const char* cA = op.A + (size_t)pm * 2 * ch; const char* cB = op.B + (size_t)pn * 2 * ch;
    Dp.a_ready(0, pm);
    PG8_STAGEX(PG8_SB(0, 0), cB, RB, cK); PG8_STAGEX(PG8_SB(0, 1), cB + ch, RB, cK); PG8_STAGEX(PG8_SA(0, 0), cA, RA, cK); PG8_STAGEX(PG8_SA(0, 1), cA + ch, RA, cK);
    if (wr == 1) PG8_BAR;
    PG8_WAIT_V(2); PG8_BAR;
    PG8_STAGEX(PG8_SB(1, 0), cB + kstep, RB, cK); PG8_STAGEX(PG8_SA(1, 0), cA + kstep, RA, cK); PG8_STAGEX(PG8_SB(1, 1), cB + ch + kstep, RB, cK);
    PG8_WAIT_V(6); PG8_BAR;
#define PG8_SEQ_STEP(F16C) { \
        const bool has_next = ui + 1 < nsteps; \
        int nK = cK; size_t nh = ch; const char* nA = cA; const char* nB = cB; \
        if (has_next) { const XOp nop = Dp.op(ui + 1); nK = nop.K; nh = (size_t)HALF * nK * 2; nA = nop.A + (size_t)pm * 2 * nh; nB = nop.B + (size_t)pn * 2 * nh; } \
        const int nt = cK / BK; constexpr bool cf16 = (F16C); \
_Pragma("unroll 1") \
        for (int t = 0; t < nt; t += 2) { \
            const bool last = (t == nt - 2); \
            const char* a1 = cA + (size_t)(t + 1) * kstep; \
            const char* a2 = last ? nA : cA + (size_t)(t + 2) * kstep; const char* b2 = last ? nB : cB + (size_t)(t + 2) * kstep; \
            const char* a3 = a2 + kstep; const char* b3 = b2 + kstep; \
            const int xK = last ? nK : cK; const size_t xh = last ? nh : ch; \
            if (last && has_next) Dp.a_ready(ui + 1, pm); \
            PG8_LDB(B0, 0, 0); PG8_LDB(B1, 0, 1); PG8_SCHED; PG8_LDA(At, 0, 0); PG8_STAGEX(PG8_SA(1, 1), a1 + ch, RA, cK); \
            PG8_WAIT_V(8); PG8_WAIT_L(0); PG8_BAR; PG8_MMA(0, 0, At, B0); PG8_MMA(0, 1, At, B1); PG8_BAR; PG8_SCHED; \
            PG8_LDA(At, 0, 1); PG8_STAGEX(PG8_SB(0, 0), b2, RB, xK); PG8_STAGEX(PG8_SB(0, 1), b2 + xh, RB, xK); PG8_STAGEX(PG8_SA(0, 0), a2, RA, xK); \
            PG8_WAIT_V(8); PG8_WAIT_L(0); PG8_BAR; PG8_MMA(1, 0, At, B0); PG8_MMA(1, 1, At, B1); PG8_BAR; PG8_SCHED; \
            PG8_LDB(B0, 1, 0); PG8_LDB(B1, 1, 1); PG8_SCHED; PG8_LDA(At, 1, 0); PG8_STAGEX(PG8_SA(0, 1), a2 + xh, RA, xK); \
            PG8_WAIT_V(8); PG8_WAIT_L(0); PG8_BAR; PG8_MMA(0, 0, At, B0); PG8_MMA(0, 1, At, B1); PG8_BAR; PG8_SCHED; \
            PG8_LDA(At, 1, 1); PG8_STAGEX(PG8_SB(1, 0), b3, RB, xK); PG8_STAGEX(PG8_SB(1, 1), b3 + xh, RB, xK); PG8_STAGEX(PG8_SA(1, 0), a3, RA, xK); \
            PG8_WAIT_V(8); PG8_WAIT_L(0); PG8_BAR; PG8_MMA(1, 0, At, B0); PG8_MMA(1, 1, At, B1); PG8_BAR; PG8_SCHED; \
        } \
        if (wr == 0) PG8_BAR; \
        { int fr_e = fr, fq_e = fq; asm volatile("" : "+v"(fr_e), "+v"(fq_e)); Dp.epi(acc, ui, pm, pn, wr, wc, fr_e, fq_e); } \
        if (!has_next) break; \
_Pragma("unroll") \
        for (int a = 0; a < 2; ++a) \
_Pragma("unroll") \
            for (int b = 0; b < 2; ++b) \
_Pragma("unroll") \
                for (int m = 0; m < 4; ++m) \
_Pragma("unroll") \
                    for (int n = 0; n < 2; ++n) acc[a][b][m][n] = (f32x4){0.f, 0.f, 0.f, 0.f}; \
        cK = nK; ch = nh; cA = nA; cB = nB; ++ui; \
        if (wr == 1) PG8_BAR; \
    }
    for (;;) {
        PG8_SEQ_STEP(true)
        PG8_SEQ_STEP(false)
    }
#undef PG8_SEQ_STEP
    PG8_WAIT_V(0);
    PG8_BAR;
#undef PG8_SA
#undef PG8_SB
#undef PG8_STAGEX
#undef PG8_LDA
#undef PG8_LDB
#undef PG8_MMA
#undef PG8_WAIT_V
#undef PG8_WAIT_L
#undef PG8_BAR
#undef PG8_SCHED
}
struct MergeDisp {
    const char *xb, *wg, *wsb, *pa; bf16_t* gscr; bf16_t* merged; const float* ss; PG8_LAS float* tab; int tid;
    __device__ __forceinline__ XOp op(int k) const {
        XOp o; const int br = k >> 1; const bool gate = (k & 1) == 0;
        const char* ab = wsb + (size_t)(194 - 88 * br + 48 * br * br) * 1048576;
        o.A = gate ? xb : ab;
        o.B = gate ? wg + (size_t)br * (1024 * 1024 * 2) : pa + (size_t)br * (1024 * 512 * 2);
        o.K = gate ? 1024 : (br == 2 ? 256 : 512);
        return o; }
    __device__ __forceinline__ bool f16(int k) const { return (k & 1) == 0; }
    __device__ __forceinline__ void a_ready(int k, int pm) const { if ((k & 1) == 0 && tid < 256) tab[((k >> 1) & 1) * 256 + tid] = __builtin_amdgcn_rsqf(ss[pm * BM + tid] * (1.f / 1024.f) + 1e-6f); }
    __device__ __forceinline__ void epi(const f32x4 (&acc)[2][2][4][2], int k, int pm, int pn, int wr, int wc, int fr, int fq) const {
        Unit u; u.pm = pm; u.pn = pn; u.par = (k >> 1) & 1;
        if ((k & 1) == 0) { EpiActMF<1> E{gscr, 1024, tab}; E(acc, u, wr, wc, fr, fq); }
        else if (k == 1) { EpiMergeMF<0> E{gscr, merged, 1024, 0}; E(acc, u, wr, wc, fr, fq); }
        else if (k == 3) { EpiMergeMF<1> E{gscr, merged, 1024, 0}; E(acc, u, wr, wc, fr, fq); }
        else { EpiMergeMF<2> E{gscr, merged, 1024, 0}; E(acc, u, wr, wc, fr, fq); }
    }
};
}

struct Args { const float* in[31]; float* out; unsigned char* ws; int ph_lo, ph_hi; };
enum { I_X = 0, I_RELB, I_NG1, I_WIN, I_MU, I_W0, I_WUP, I_A0, I_AUP, I_GUP, I_KK, I_KA, I_RK, I_LNG, I_LNB, I_PA, I_CW, I_CB, I_LWA, I_LBA, I_LWX, I_LBX, I_LAM, I_PB,
       I_QG, I_KG, I_PC, I_WOUT, I_NG2, I_UP, I_DOWN };

struct Frame {
    LAS unsigned char* lds;
    int tid, lane, wave, vcu, G, bid;
};

__device__ __forceinline__ Frame phase_frame(const Frame& F0) {
    Frame F = F0; asm volatile("" : "+s"(F.vcu), "+s"(F.wave), "+s"(F.G), "+s"(F.bid));
    int ln; asm volatile("v_mbcnt_lo_u32_b32 %0, -1, 0\n\tv_mbcnt_hi_u32_b32 %0, -1, %0" : "=v"(ln));
    F.lane = ln; F.tid = F.wave * 64 + ln; return F;
}

typedef unsigned v4u __attribute__((ext_vector_type(4)));
__device__ __forceinline__ unsigned pk2(float lo, float hi) { return f2bf(lo) | (f2bf(hi) << 16); }
#define LDS_WAIT() asm volatile("s_waitcnt lgkmcnt(0)" ::: "memory")
template <bool SCALE = false, bool F16 = false>
__device__ __forceinline__ void transpose_item(const float* W, int ldw, int K, int nblk, bf16* WT, LAS float* scr, int item, int lane, const float* gk = nullptr) {
    const int kb = item / nblk, nb = item % nblk, k0 = 64 * kb, n0 = 32 * nb;
#pragma unroll 8
    for (int i = 0; i < 32; ++i) { const int kk = 2 * i + (lane >> 5); float w = W[(size_t)(k0 + kk) * ldw + n0 + (lane & 31)]; if (SCALE) w *= gk[k0 + kk]; scr[kk * 33 + (lane & 31)] = w; }
    LDS_WAIT(); asm volatile("" ::: "memory");
    const int c = lane & 7;
#pragma unroll
    for (int j = 0; j < 4; ++j) { const int n = (lane >> 3) + 8 * j; const LAS float* s = scr + (8 * c) * 33 + n;
        v4u o; if (F16) { o.x = pg8::cvt_pk_f16(s[0 * 33], s[1 * 33]); o.y = pg8::cvt_pk_f16(s[2 * 33], s[3 * 33]); o.z = pg8::cvt_pk_f16(s[4 * 33], s[5 * 33]); o.w = pg8::cvt_pk_f16(s[6 * 33], s[7 * 33]); }
        else { o.x = pk2(s[0 * 33], s[1 * 33]); o.y = pk2(s[2 * 33], s[3 * 33]); o.z = pk2(s[4 * 33], s[5 * 33]); o.w = pk2(s[6 * 33], s[7 * 33]); }
        *(v4u*)(WT + (size_t)(n0 + n) * K + k0 + 8 * c) = o; }
    LDS_WAIT(); asm volatile("" ::: "memory");
}
__device__ __forceinline__ void convert_wb1(Frame& F, const Args& args, int l, unsigned char* ws) {
    LAS float* scr = (LAS float*)(F.lds + F.wave * 16384);
    const int gw = F.vcu * NWAVES + F.wave, NGW = F.G * NWAVES;
    const float* w_in = args.in[I_WIN] + (size_t)l * D * DIN; const float* g1 = args.in[I_NG1] + l * D;
    constexpr int J0 = 16 * 56, J1 = 16 * 104, J2 = 16 * 96, J3 = 8 * 32, J4 = 8 * 32, J5 = 4 * 32, J6 = 16 * 32, JZ = 16;
    constexpr int NIT = J0 + J1 + J2 + J3 + J4 + J5 + J6 + JZ;
    for (int it = gw; it < NIT; it += NGW) {
        int r = it;
        if (r < J0) { transpose_item<true, true>(w_in, DIN, D, 56, (bf16*)(ws + WS_WMIX), scr, r, F.lane, g1); continue; } r -= J0;
        if (r < J1) { transpose_item<true, true>(w_in + 1824, DIN, D, 104, (bf16*)(ws + WS_WMIX) + (size_t)1792 * D, scr, r, F.lane, g1); continue; } r -= J1;
        if (r < J2) { transpose_item<true, true>(w_in + NMIX, DIN, D, 96, (bf16*)(ws + WS_WG), scr, r, F.lane, g1); continue; } r -= J2;
        if (r < J3) { transpose_item(args.in[I_PA] + (size_t)l * 512 * D, D, 512, 32, (bf16*)(ws + WS_PA), scr, r, F.lane); continue; } r -= J3;
        if (r < J4) { transpose_item(args.in[I_PB] + (size_t)l * 512 * D, D, 512, 32, (bf16*)(ws + WS_PB), scr, r, F.lane); continue; } r -= J4;
        if (r < J5) { transpose_item(args.in[I_PC] + (size_t)l * 256 * D, D, 256, 32, (bf16*)(ws + WS_PC), scr, r, F.lane); continue; } r -= J5;
        if (r < J6) { transpose_item(args.in[I_WOUT] + (size_t)l * D * D, D, D, 32, (bf16*)(ws + WS_WOUT), scr, r, F.lane); continue; } r -= J6;
        transpose_item<true, true>(w_in + 1792, DIN, D, 1, (bf16*)(ws + WS_WTAIL), scr, r, F.lane, g1);
    }
}
__device__ __forceinline__ void convert_wb2(Frame& F, const Args& args, int l, unsigned char* ws) {
    LAS float* scr = (LAS float*)(F.lds + F.wave * 16384);
    const int gw = F.vcu * NWAVES + F.wave, NGW = F.G * NWAVES;
    constexpr int J0 = 16 * 128, J1 = 64 * 32;
    for (int it = gw; it < J0 + J1; it += NGW) {
        if (it < J0) transpose_item<true, true>(args.in[I_UP] + (size_t)l * D * FF, FF, D, 128, (bf16*)(ws + WS_WUP), scr, it, F.lane, args.in[I_NG2] + l * D);
        else transpose_item(args.in[I_DOWN] + (size_t)l * FF * D, D, FF, 32, (bf16*)(ws + WS_WDOWN), scr, it - J0, F.lane);
    }
}

__device__ __forceinline__ void phase_rms(Frame& F, const float* x, const float* g, bf16* out) {
    const int gw = F.vcu * NWAVES + F.wave, NGW = F.G * NWAVES;
    typedef float f32x4 __attribute__((ext_vector_type(4)));
    for (int m = gw; m < M; m += NGW) {
        const f32x4* xr = (const f32x4*)(x + (size_t)m * D) + F.lane;
        f32x4 v[4]; float s = 0.f;
#pragma unroll
        for (int j = 0; j < 4; ++j) { v[j] = xr[64 * j]; s += (v[j].x * v[j].x + v[j].y * v[j].y) + (v[j].z * v[j].z + v[j].w * v[j].w); }
        const float rstd = 1.f / sqrtf(wave_sum(s, F.lane) * (1.f / D) + RMS_EPS);
        unsigned long long* o8 = (unsigned long long*)(out + (size_t)m * D) + F.lane;
#pragma unroll
        for (int j = 0; j < 4; ++j) {
            const f32x4 gg = *((const f32x4*)g + F.lane + 64 * j);
            const unsigned lo = f2bf(v[j].x * rstd * gg.x) | (f2bf(v[j].y * rstd * gg.y) << 16), hi = f2bf(v[j].z * rstd * gg.z) | (f2bf(v[j].w * rstd * gg.w) << 16);
            o8[64 * j] = (unsigned long long)lo | ((unsigned long long)hi << 32);
        }
    }
}

__device__ __forceinline__ void phase_x2bf(Frame& F, const float* x, bf16* out, float* ss) {
    const int gw = F.vcu * NWAVES + F.wave, NGW = F.G * NWAVES;
    typedef float f32x4 __attribute__((ext_vector_type(4)));
    for (int m = 2 * gw; m < M; m += 2 * NGW) {
        f32x4 v[2][4]; float s[2] = {0.f, 0.f};
#pragma unroll
        for (int rr = 0; rr < 2; ++rr) { const f32x4* xr = (const f32x4*)(x + (size_t)(m + rr) * D) + F.lane;
#pragma unroll
            for (int j = 0; j < 4; ++j) v[rr][j] = xr[64 * j]; }
#pragma unroll
        for (int rr = 0; rr < 2; ++rr) {
#pragma unroll
            for (int j = 0; j < 4; ++j) s[rr] += (v[rr][j].x * v[rr][j].x + v[rr][j].y * v[rr][j].y) + (v[rr][j].z * v[rr][j].z + v[rr][j].w * v[rr][j].w);
            s[rr] = wave_sum(s[rr], F.lane);
            if (F.lane == 0) ss[m + rr] = s[rr];
            unsigned long long* o8 = (unsigned long long*)(out + (size_t)(m + rr) * D) + F.lane;
#pragma unroll
            for (int j = 0; j < 4; ++j) { const unsigned lo = pg8::cvt_pk_f16(v[rr][j].x, v[rr][j].y), hi = pg8::cvt_pk_f16(v[rr][j].z, v[rr][j].w); o8[64 * j] = (unsigned long long)lo | ((unsigned long long)hi << 32); }
        }
    }
}
__device__ __forceinline__ void gemm_tile_acc(int tid, LAS float* lds, const bf16* A, int lda, const float* W, int ldw, int N, int K, int tm, int tn, float (&acc)[8][4]) {
    const int tx = tid & 31, ty = tid >> 5;
    LAS float* As = lds; LAS float* Bs = lds + 16 * 132;
    const int arow = tid >> 2, akq = (tid & 3) * 4, bk = tid >> 5, bn = (tid & 31) * 4;
    for (int k0 = 0; k0 < K; k0 += 16) {
        const unsigned long long av = *(const unsigned long long*)(A + (size_t)(tm * 128 + arow) * lda + k0 + akq);
#pragma unroll
        for (int e = 0; e < 4; ++e) As[(akq + e) * 132 + arow] = bf2f((unsigned)(av >> (16 * e)) & 0xffffu);
        const int n0 = tn * 128 + bn;
        const float* wp = W + (size_t)(k0 + bk) * ldw + n0;
#pragma unroll
        for (int e = 0; e < 4; ++e) Bs[bk * 132 + bn + e] = (n0 + e < N) ? wp[e] : 0.f;
        __syncthreads();
#pragma unroll 2
        for (int kk = 0; kk < 16; ++kk) {
            float a[8], b[4];
#pragma unroll
            for (int i = 0; i < 8; ++i) a[i] = As[kk * 132 + ty * 8 + i];
#pragma unroll
            for (int j = 0; j < 4; ++j) b[j] = Bs[kk * 132 + tx * 4 + j];
#pragma unroll
            for (int i = 0; i < 8; ++i)
#pragma unroll
                for (int j = 0; j < 4; ++j) acc[i][j] += a[i] * b[j];
        }
        __syncthreads();
    }
}
template <class Epi>
__device__ __forceinline__ void gemm_naive(Frame& F, const bf16* A, int lda, const float* W, int ldw, int N, int K, const Epi& epi) {
    const int tx = F.tid & 31, ty = F.tid >> 5;
    const int ntm = M / 128, ntn = (N + 127) / 128;
    for (int tile = F.vcu; tile < ntm * ntn; tile += F.G) {
        const int tm = tile / ntn, tn = tile % ntn;
        float acc[8][4];
#pragma unroll
        for (int i = 0; i < 8; ++i)
#pragma unroll
            for (int j = 0; j < 4; ++j) acc[i][j] = 0.f;
        gemm_tile_acc(F.tid, (LAS float*)F.lds, A, lda, W, ldw, N, K, tm, tn, acc);
#pragma unroll
        for (int i = 0; i < 8; ++i)
#pragma unroll
            for (int j = 0; j < 4; ++j) { const int m = tm * 128 + ty * 8 + i, n = tn * 128 + tx * 4 + j; if (n < N) epi(m, n, acc[i][j]); }
    }
}

struct EpiMix {
    unsigned char* ws;
    __device__ __forceinline__ void operator()(int m, int n, float v) const {
        bf16* p;
        if (n < 512) p = (bf16*)(ws + Z_R) + (size_t)m * 512 + n;
        else if (n < 1024) p = (bf16*)(ws + Z_K) + (size_t)m * 512 + (n - 512);
        else if (n < 1536) p = (bf16*)(ws + Z_V) + (size_t)m * 512 + (n - 1024);
        else if (n < 1824) p = (bf16*)(ws + Z_L) + (size_t)m * 288 + (n - 1536);
        else if (n < 2336) p = (bf16*)(ws + Z_BX) + (size_t)m * 512 + (n - 1824);
        else if (n < 2848) p = (bf16*)(ws + Z_BY) + (size_t)m * 512 + (n - 2336);
        else if (n < 3616) p = (bf16*)(ws + A_Q) + (size_t)m * 768 + (n - 2848);
        else if (n < 4384) p = (bf16*)(ws + A_K) + (size_t)m * 768 + (n - 3616);
        else p = (bf16*)(ws + A_V) + (size_t)m * 768 + (n - 4384);
        *p = (bf16)f2bf(v);
    }
};
struct EpiGate { bf16* o; __device__ __forceinline__ void operator()(int m, int n, float v) const { o[(size_t)m * NGATE + n] = (bf16)f2bf(sigmoidf_(v)); } };
struct EpiBf { bf16* o; int ld; __device__ __forceinline__ void operator()(int m, int n, float v) const { o[(size_t)m * ld + n] = (bf16)f2bf(v); } };
struct EpiRelu2 { bf16* o; int ld; __device__ __forceinline__ void operator()(int m, int n, float v) const { const float r = v > 0.f ? v : 0.f; o[(size_t)m * ld + n] = (bf16)f2bf(r * r); } };
struct EpiRes { const float* base; float* o; __device__ __forceinline__ void operator()(int m, int n, float v) const { o[(size_t)m * D + n] = base[(size_t)m * D + n] + v; } };

__device__ __forceinline__ void phase_merge_naive(Frame& F, const bf16* OA, const bf16* OB, const bf16* OC, const float* pa, const float* pb, const float* pc, const bf16* gates, bf16* out) {
    const int tx = F.tid & 31, ty = F.tid >> 5;
    const int ntm = M / 128, ntn = D / 128;
    for (int tile = F.vcu; tile < ntm * ntn; tile += F.G) {
        const int tm = tile / ntn, tn = tile % ntn;
        float tot[8][4];
#pragma unroll
        for (int i = 0; i < 8; ++i)
#pragma unroll
            for (int j = 0; j < 4; ++j) tot[i][j] = 0.f;
#pragma unroll 1
        for (int br = 0; br < 3; ++br) {
            float acc[8][4];
#pragma unroll
            for (int i = 0; i < 8; ++i)
#pragma unroll
                for (int j = 0; j < 4; ++j) acc[i][j] = 0.f;
            const bf16* A = br == 0 ? OA : (br == 1 ? OB : OC); const int lda = br == 2 ? 256 : 512; const float* W = br == 0 ? pa : (br == 1 ? pb : pc);
            gemm_tile_acc(F.tid, (LAS float*)F.lds, A, lda, W, D, D, lda, tm, tn, acc);
#pragma unroll
            for (int i = 0; i < 8; ++i)
#pragma unroll
                for (int j = 0; j < 4; ++j) { const int m = tm * 128 + ty * 8 + i, n = tn * 128 + tx * 4 + j; tot[i][j] += bf2f(gates[(size_t)m * NGATE + br * D + n]) * acc[i][j]; }
        }
#pragma unroll
        for (int i = 0; i < 8; ++i)
#pragma unroll
            for (int j = 0; j < 4; ++j) { const int m = tm * 128 + ty * 8 + i, n = tn * 128 + tx * 4 + j; out[(size_t)m * D + n] = (bf16)f2bf(tot[i][j]); }
    }
}

struct RwkvP { const float *mu, *w0, *w_up, *a0, *a_up, *g_up, *k_k, *k_a, *r_k, *ln_g, *ln_b; };
__device__ __forceinline__ void rwkv_naive_item(Frame& F, unsigned char* ws, const RwkvP& P, int b, int h) {
    LAS float* L = (LAS float*)F.lds;
    LAS float* Lr = L;
    LAS float* Lk = L + 1024;
    LAS float* Lv = L + 2048;
    LAS float* Ltw = L + 3072;
    LAS float* Lxa = L + 4096;
    LAS float* Lsg = L + 5120;
    LAS float* Lw = L + 7680;
    LAS float* La = L + 8704;
    LAS float* Lg = L + 9728;
    LAS float* Lan = L + 10752;
    LAS float* Lb = L + 11776;
    LAS float* Lbo = L + 12800;
    const bf16* ZR = (const bf16*)(ws + Z_R); const bf16* ZK = (const bf16*)(ws + Z_K); const bf16* ZV = (const bf16*)(ws + Z_V); const bf16* ZL = (const bf16*)(ws + Z_L);
    bf16* OA = (bf16*)(ws + WS_OA);
    const int tid = F.tid, lane = F.lane, wave = F.wave;
    typedef float f32x4s __attribute__((ext_vector_type(4)));
    LAS f32x4s* Ls = (LAS f32x4s*)(L + 13312);
    if (wave == 0) {
#pragma unroll
        for (int j4 = 0; j4 < 16; ++j4) Ls[j4 * 64 + lane] = (f32x4s){0.f, 0.f, 0.f, 0.f};
    }
#pragma unroll 1
    for (int blk = 0; blk < SEQ / 16; ++blk) {
        const int t0 = blk * 16;
#pragma unroll 1
        for (int idx = tid; idx < 16 * 480; idx += NTHR) {
            const int tt = idx / 480, c = idx % 480; const int t = t0 + tt; const size_t m = (size_t)b * SEQ + t;
            float cur, prev = 0.f, mu;
            if (c < 192) { const int which = c / 64, j = c % 64, col = h * 64 + j; const bf16* Zp = which == 0 ? ZR : (which == 1 ? ZK : ZV);
                cur = bf2f(Zp[m * 512 + col]); if (t > 0) prev = bf2f(Zp[(m - 1) * 512 + col]); mu = P.mu[which * 512 + col];
                const float f = cur + (prev - cur) * mu; (which == 0 ? Lr : (which == 1 ? Lk : Lv))[tt * 64 + j] = f;
            } else { const int cc = c - 192;
                cur = bf2f(ZL[m * 288 + cc]); if (t > 0) prev = bf2f(ZL[(m - 1) * 288 + cc]); mu = P.mu[1536 + cc];
                const float f = cur + (prev - cur) * mu;
                if (cc < 64) Ltw[tt * 64 + cc] = tanhf(f); else if (cc < 128) Lxa[tt * 64 + cc - 64] = f; else Lsg[tt * 160 + cc - 128] = sigmoidf_(f);
            }
        }
        __syncthreads();
#pragma unroll 1
        for (int idx = tid; idx < 1024; idx += NTHR) {
            const int tt = idx >> 6, j = idx & 63, col = h * 64 + j;
            float wl = P.w0[col], al = P.a0[col], gg = 0.f;
#pragma unroll 4
            for (int c = 0; c < 64; ++c) { wl += Ltw[tt * 64 + c] * P.w_up[c * 512 + col]; al += Lxa[tt * 64 + c] * P.a_up[c * 512 + col]; }
#pragma unroll 4
            for (int c = 0; c < 160; ++c) gg += Lsg[tt * 160 + c] * P.g_up[c * 512 + col];
            const float w = -softplusf_(-wl) - 0.5f;
            Lw[idx] = expf(-expf(w)); La[idx] = sigmoidf_(al); Lg[idx] = gg;
        }
        __syncthreads();
#pragma unroll
        for (int q = 0; q < 2; ++q) {
            const int tt = 2 * wave + q, col = h * 64 + lane;
            const float kraw = Lk[tt * 64 + lane], kkv = kraw * P.k_k[col];
            const float n2 = wave_sum(kkv * kkv, lane); const float kkn = kkv / fmaxf(sqrtf(n2), 1e-12f);
            const float a = La[tt * 64 + lane]; const float kmod = kraw * (1.f + (a - 1.f) * P.k_a[col]);
            const float bo = wave_sum(Lr[tt * 64 + lane] * kmod * P.r_k[col], lane);
            Lk[tt * 64 + lane] = kmod; Lan[tt * 64 + lane] = -kkn; Lb[tt * 64 + lane] = kkn * a;
            if (lane == 0) Lbo[tt] = bo;
        }
        __syncthreads();
        if (wave == 0) {
            const int col = h * 64 + lane; const float lng = P.ln_g[col], lnb = P.ln_b[col];
            float S[64];
#pragma unroll
            for (int j4 = 0; j4 < 16; ++j4) { const f32x4s s4 = Ls[j4 * 64 + lane]; S[4 * j4] = s4.x; S[4 * j4 + 1] = s4.y; S[4 * j4 + 2] = s4.z; S[4 * j4 + 3] = s4.w; }
#pragma unroll 1
            for (int tt = 0; tt < 16; ++tt) {
                typedef float f32x4 __attribute__((ext_vector_type(4)));
                float sa = 0.f;
#pragma unroll
                for (int j4 = 0; j4 < 16; ++j4) { const f32x4 an = *(const LAS f32x4*)(Lan + tt * 64 + 4 * j4);
                    sa += S[4 * j4] * an.x + S[4 * j4 + 1] * an.y + S[4 * j4 + 2] * an.z + S[4 * j4 + 3] * an.w; __builtin_amdgcn_sched_barrier(0); }
                const float vi = Lv[tt * 64 + lane]; float y = 0.f;
#pragma unroll
                for (int j4 = 0; j4 < 16; ++j4) {
                    const f32x4 w4 = *(const LAS f32x4*)(Lw + tt * 64 + 4 * j4), b4 = *(const LAS f32x4*)(Lb + tt * 64 + 4 * j4), k4 = *(const LAS f32x4*)(Lk + tt * 64 + 4 * j4), r4 = *(const LAS f32x4*)(Lr + tt * 64 + 4 * j4);
                    S[4 * j4] = S[4 * j4] * w4.x + sa * b4.x + vi * k4.x; S[4 * j4 + 1] = S[4 * j4 + 1] * w4.y + sa * b4.y + vi * k4.y;
                    S[4 * j4 + 2] = S[4 * j4 + 2] * w4.z + sa * b4.z + vi * k4.z; S[4 * j4 + 3] = S[4 * j4 + 3] * w4.w + sa * b4.w + vi * k4.w;
                    y += S[4 * j4] * r4.x + S[4 * j4 + 1] * r4.y + S[4 * j4 + 2] * r4.z + S[4 * j4 + 3] * r4.w; __builtin_amdgcn_sched_barrier(0); }
                const float mean = wave_sum(y, lane) * (1.f / 64.f); const float dy = y - mean; const float var = wave_sum(dy * dy, lane) * (1.f / 64.f);
                const float o = (dy * (1.f / sqrtf(var + GN_EPS)) * lng + lnb + Lbo[tt] * vi) * Lg[tt * 64 + lane];
                OA[((size_t)b * SEQ + t0 + tt) * 512 + col] = (bf16)f2bf(o);
            }
#pragma unroll
            for (int j4 = 0; j4 < 16; ++j4) Ls[j4 * 64 + lane] = (f32x4s){S[4 * j4], S[4 * j4 + 1], S[4 * j4 + 2], S[4 * j4 + 3]};
        }
        __syncthreads();
    }
}

__device__ __forceinline__ void lds_barrier() { asm volatile("s_waitcnt lgkmcnt(0)" ::: "memory"); __builtin_amdgcn_s_barrier(); asm volatile("" ::: "memory"); }
namespace rk {
typedef short bf16x8 __attribute__((ext_vector_type(8)));
typedef float f32x4 __attribute__((ext_vector_type(4)));
typedef unsigned u32x4 __attribute__((ext_vector_type(4)));
typedef unsigned u32x2 __attribute__((ext_vector_type(2)));
constexpr int T = 32, SEGLEN = 512, NSEG = SEQ / SEGLEN, TS = 36;
constexpr int O_WUPT = 0, O_AUPT = O_WUPT + 9216, O_GUPT = O_AUPT + 9216, O_VEC = O_GUPT + 21504;
constexpr int O_XR = O_VEC + 3712, O_XK = O_XR + 8192, O_XV = O_XK + 8192, O_LIN = O_XV + 8192;
constexpr int O_TXW = O_LIN, O_XA = O_LIN + 4608, O_SG = O_LIN + 9216;
constexpr int O_AT = O_LIN, O_RT = O_LIN + 4608, O_BT = O_LIN + 9216, O_KT = O_LIN + 13824;
constexpr int O_DEC = O_LIN + 19968, O_AA = O_DEC + 8192, O_GG = O_AA + 8192, O_SC = O_GG + 8192;
constexpr int O_BTT = O_SC + 256, O_KTT = O_BTT + 4608, O_VT = O_KTT + 4608, O_WL = O_VT + 4608;
constexpr int O_NM = O_WL + 512, O_AAK = O_NM + 2048, O_ARB = O_AAK + 2048, O_ARK = O_ARB + 1024, O_AH = O_ARK + 1024, O_AKH = O_AH + 4608, O_ATF = O_AKH + 1024, O_YB = O_ATF + 8192, O_END = O_YB + 8192;
static_assert(O_END <= 163840 - 512, "rwkv LDS map");
constexpr int V_W0 = 0, V_A0 = 64, V_KK = 128, V_KA = 192, V_RK = 256, V_LNG = 320, V_LNB = 384, V_MUR = 448, V_MUL = 640;

__device__ __forceinline__ unsigned cvtpk(float lo, float hi) { return pg8::cvt_pk_bf16(lo, hi); }
__device__ __forceinline__ bf16x8 mk8(u32x2 lo, u32x2 hi) { u32x4 v = {lo.x, lo.y, hi.x, hi.y}; return __builtin_bit_cast(bf16x8, v); }
__device__ __forceinline__ float shx(float v, int o, int lane) { return __builtin_bit_cast(float, __builtin_amdgcn_ds_bpermute((lane ^ o) << 2, __builtin_bit_cast(int, v))); }
__device__ __forceinline__ float row_sum16(float x) {
    x += __builtin_bit_cast(float, __builtin_amdgcn_update_dpp(0, __builtin_bit_cast(int, x), 0x128, 0xf, 0xf, true));
    x += __builtin_bit_cast(float, __builtin_amdgcn_update_dpp(0, __builtin_bit_cast(int, x), 0x124, 0xf, 0xf, true));
    x += __builtin_bit_cast(float, __builtin_amdgcn_update_dpp(0, __builtin_bit_cast(int, x), 0x122, 0xf, 0xf, true));
    x += __builtin_bit_cast(float, __builtin_amdgcn_update_dpp(0, __builtin_bit_cast(int, x), 0x121, 0xf, 0xf, true));
    return x; }
#define RK_MFMA(a, b, c) __builtin_amdgcn_mfma_f32_16x16x32_bf16((a), (b), (c), 0, 0, 0)

template <int PART  >
__device__ __forceinline__ void lora_inputs(Frame& F, unsigned char* ws, const float* mu, const float* ss) {
    const bf16* ZL = (const bf16*)(ws + Z_L); bf16* ZT = (bf16*)(ws + WS_ZT);
    LAS float* Zt = (LAS float*)(F.lds + 67584);
    const int lane = F.lane, wave = F.wave, tid = F.tid, fr = lane & 15, fq = lane >> 4;
    if constexpr (PART == 0) {
    { u32x4 wv[8];
#pragma unroll
      for (int k = 0; k < 8; ++k) { const int i = tid + NTHR * k, n = i >> 7, c = i & 127; wv[k] = *(const u32x4*)((const bf16*)(ws + WS_WTAIL) + (size_t)n * D + 8 * c); }
#pragma unroll
      for (int k = 0; k < 8; ++k) { const int i = tid + NTHR * k, n = i >> 7, c = i & 127; *(LAS u32x4*)(F.lds + n * 2064 + c * 16) = wv[k]; } }
    __syncthreads();
#pragma unroll 1
    for (int blk = F.vcu; blk < M / 64; blk += F.G) {
        const int r0 = 64 * blk;
        if (tid < 32) Zt[tid] = 0.f;
        __syncthreads();
        if (wave < 4) {
            const int mt = wave, row = r0 + 16 * mt + fr;
            const bf16x8* ap = (const bf16x8*)((const bf16*)(ws + WS_XB) + (size_t)row * D + 8 * fq);
            bf16x8 af[32];
#pragma unroll
            for (int s = 0; s < 32; ++s) af[s] = ap[4 * s];
            f32x4 acc0 = (f32x4){0.f, 0.f, 0.f, 0.f}, acc1 = acc0;
#pragma unroll
            for (int s = 0; s < 32; ++s) { acc0 = pg8::mfma16(true, af[s], *(const LAS bf16x8*)(F.lds + fr * 2064 + (32 * s + 8 * fq) * 2), acc0); acc1 = pg8::mfma16(true, af[s], *(const LAS bf16x8*)(F.lds + (16 + fr) * 2064 + (32 * s + 8 * fq) * 2), acc1); }
#pragma unroll
            for (int r = 0; r < 4; ++r) { const int rl = 16 * mt + 4 * fq + r; const float rs = __builtin_amdgcn_rsqf(ss[r0 + rl] * (1.f / 1024.f) + RMS_EPS);
                Zt[(rl + 1) * 33 + fr] = acc0[r] * rs; Zt[(rl + 1) * 33 + 16 + fr] = acc1[r] * rs; }
        } else if ((r0 & (SEQ - 1)) != 0) {
            const int t2 = tid - 256, c = t2 & 31, kc = t2 >> 5;
            const u32x4* xp = (const u32x4*)((const bf16*)(ws + WS_XB) + (size_t)(r0 - 1) * D + 128 * kc);
            float s = 0.f;
#pragma unroll 4
            for (int i = 0; i < 16; ++i) { const u32x4 xv = xp[i]; const u32x4 wv = *(const LAS u32x4*)(F.lds + c * 2064 + (128 * kc + 8 * i) * 2);
#pragma unroll
                for (int e = 0; e < 4; ++e) s += pg8::hfl(xv[e]) * pg8::hfl(wv[e]) + pg8::hfh(xv[e]) * pg8::hfh(wv[e]); }
            s += shx(s, 32, lane);
            if (lane < 32) atomicAdd((float*)&Zt[c], s * __builtin_amdgcn_rsqf(ss[r0 - 1] * (1.f / 1024.f) + RMS_EPS));
        }
        __syncthreads();
        {
            const int i = tid >> 3, c4 = (tid & 7) * 4; const int m = r0 + i;
            float f[4];
#pragma unroll
            for (int e = 0; e < 4; ++e) { const float cur = Zt[(i + 1) * 33 + c4 + e], prev = (m & (SEQ - 1)) ? Zt[i * 33 + c4 + e] : 0.f; const float v = cur + (prev - cur) * mu[1536 + 256 + c4 + e];
                f[e] = __builtin_amdgcn_rcpf(1.f + __expf(-v)); }
            *(u32x2*)(ZT + (size_t)m * 224 + 192 + c4) = (u32x2){cvtpk(f[0], f[1]), cvtpk(f[2], f[3])};
        }
        __syncthreads();
    }
    } else {
    const int stride = F.G * NTHR;
    for (int it0 = F.vcu * NTHR + F.tid; it0 < M * 24; it0 += 3 * stride) {
        u32x4 cuv[3], puv[3];
#pragma unroll
        for (int u = 0; u < 3; ++u) { const int it = it0 + u * stride; cuv[u] = (u32x4){0u, 0u, 0u, 0u}; puv[u] = cuv[u];
            if (it < M * 24) { const int m = it / 24, p = it - m * 24; const int cc = p < 8 ? 8 * p : 128 + 8 * (p - 8);
                cuv[u] = *(const u32x4*)(ZL + (size_t)m * 288 + cc); if ((m & (SEQ - 1)) != 0) puv[u] = *(const u32x4*)(ZL + (size_t)(m - 1) * 288 + cc); } }
#pragma unroll
        for (int u = 0; u < 3; ++u) { const int it = it0 + u * stride; if (it < M * 24) { const int m = it / 24, p = it - m * 24; const int cc = p < 8 ? 8 * p : 128 + 8 * (p - 8);
            const u32x4 cu = cuv[u], pu = puv[u];
            float f[8];
#pragma unroll
            for (int e = 0; e < 4; ++e) { const float c0 = bf2f(cu[e] & 0xffffu), c1 = bf2f(cu[e] >> 16), p0 = bf2f(pu[e] & 0xffffu), p1 = bf2f(pu[e] >> 16);
                f[2 * e] = c0 + (p0 - c0) * mu[1536 + cc + 2 * e]; f[2 * e + 1] = c1 + (p1 - c1) * mu[1536 + cc + 2 * e + 1]; }
            if (p < 8) {
#pragma unroll
                for (int e = 0; e < 8; ++e) f[e] = 1.f - 2.f * __builtin_amdgcn_rcpf(1.f + __expf(2.f * f[e])); }
            else {
#pragma unroll
                for (int e = 0; e < 8; ++e) f[e] = __builtin_amdgcn_rcpf(1.f + __expf(-f[e])); }
            *(u32x4*)(ZT + (size_t)m * 224 + 8 * p) = (u32x4){cvtpk(f[0], f[1]), cvtpk(f[2], f[3]), cvtpk(f[4], f[5]), cvtpk(f[6], f[7])}; } }
    }
    }
}
template <int PASS>
__device__ __forceinline__ void item(Frame& F, unsigned char* ws, const RwkvP& P, int b, int h, int g) {
    LAS unsigned char* L = F.lds;
    const int tid = F.tid, lane = F.lane, wave = F.wave, fr = lane & 15, fq = lane >> 4;
    LAS float* VEC = (LAS float*)(L + O_VEC);
    const bf16* ZR = (const bf16*)(ws + Z_R); const bf16* ZK = (const bf16*)(ws + Z_K); const bf16* ZV = (const bf16*)(ws + Z_V); const bf16* ZL = (const bf16*)(ws + Z_L);
    float* SEGPQ = (float*)(ws + WS_RKPQ);
    const int itm = (b * 8 + h) * NSEG + g;
    {
        const int j = tid & 63, cg = tid >> 6;
        { float v[8];
#pragma unroll
          for (int e = 0; e < 8; ++e) v[e] = P.w_up[(cg * 8 + e) * 512 + h * 64 + j];
          *(LAS u32x4*)(L + O_WUPT + (j * 72 + cg * 8) * 2) = (u32x4){cvtpk(v[0], v[1]), cvtpk(v[2], v[3]), cvtpk(v[4], v[5]), cvtpk(v[6], v[7])};
#pragma unroll
          for (int e = 0; e < 8; ++e) v[e] = P.a_up[(cg * 8 + e) * 512 + h * 64 + j];
          *(LAS u32x4*)(L + O_AUPT + (j * 72 + cg * 8) * 2) = (u32x4){cvtpk(v[0], v[1]), cvtpk(v[2], v[3]), cvtpk(v[4], v[5]), cvtpk(v[6], v[7])}; }
#pragma unroll 1
        for (int c8 = cg; c8 < 20; c8 += 8) { float v[8];
#pragma unroll
          for (int e = 0; e < 8; ++e) v[e] = P.g_up[(c8 * 8 + e) * 512 + h * 64 + j];
          *(LAS u32x4*)(L + O_GUPT + (j * 168 + c8 * 8) * 2) = (u32x4){cvtpk(v[0], v[1]), cvtpk(v[2], v[3]), cvtpk(v[4], v[5]), cvtpk(v[6], v[7])}; }
        if (tid < 64) { const int c = h * 64 + tid; VEC[V_W0 + tid] = P.w0[c]; VEC[V_A0 + tid] = P.a0[c]; VEC[V_KK + tid] = P.k_k[c]; VEC[V_KA + tid] = P.k_a[c]; VEC[V_RK + tid] = P.r_k[c];
            VEC[V_LNG + tid] = P.ln_g[c]; VEC[V_LNB + tid] = P.ln_b[c]; VEC[V_MUR + tid] = P.mu[c]; VEC[V_MUR + 64 + tid] = P.mu[512 + c]; VEC[V_MUR + 128 + tid] = P.mu[1024 + c]; }
        if (tid < 288) VEC[V_MUL + tid] = P.mu[1536 + tid];
    }
    f32x4 Sreg[4];
    const int i0 = 16 * (wave & 3);
#pragma unroll
    for (int jt = 0; jt < 4; ++jt) Sreg[jt] = (f32x4){0.f, 0.f, 0.f, 0.f};
    if (PASS == 0) { if (wave >= 4) {
#pragma unroll
        for (int jt = 0; jt < 4; ++jt)
#pragma unroll
            for (int r = 0; r < 4; ++r) Sreg[jt][r] = (16 * jt + 4 * fq + r == i0 + fr) ? 1.f : 0.f; } }
    else if (wave < 4 && g > 0) {
        const float* Pb = SEGPQ + (size_t)((b * 8 + h) * NSEG) * 8192;
        f32x4 praw[4][2][2]; f32x4 qraw[4];
#define FOLD_LOAD_JT(GP, jt) do { const float* Pm_ = Pb + (size_t)(GP) * 8192; const float* Qm_ = Pm_ + 4096; \
            _Pragma("unroll") for (int r = 0; r < 4; ++r) qraw[jt][r] = Qm_[(16 * (jt) + 4 * fq + r) * 64 + i0 + fr]; \
            _Pragma("unroll") for (int s = 0; s < 2; ++s) { praw[jt][s][0] = *(const f32x4*)(Pm_ + (16 * (jt) + fr) * 64 + 32 * s + 4 * fq); praw[jt][s][1] = *(const f32x4*)(Pm_ + (16 * (jt) + fr) * 64 + 32 * s + 16 + 4 * fq); } } while (0)
#pragma unroll
        for (int jt = 0; jt < 4; ++jt) FOLD_LOAD_JT(0, jt);
#pragma unroll 1
        for (int gp = 0; gp < g; ++gp) {
            bf16x8 Sh[2], Sl[2];
#pragma unroll
            for (int s = 0; s < 2; ++s) { unsigned hi[4], lo[4];
#pragma unroll
                for (int e = 0; e < 4; ++e) { const float x0 = Sreg[2 * s + (e >> 1)][2 * (e & 1)], x1 = Sreg[2 * s + (e >> 1)][2 * (e & 1) + 1];
                    hi[e] = cvtpk(x0, x1); lo[e] = cvtpk(x0 - bf2f(hi[e] & 0xffffu), x1 - bf2f(hi[e] >> 16)); }
                Sh[s] = __builtin_bit_cast(bf16x8, (u32x4){hi[0], hi[1], hi[2], hi[3]}); Sl[s] = __builtin_bit_cast(bf16x8, (u32x4){lo[0], lo[1], lo[2], lo[3]}); }
            f32x4 Sn[4];
#pragma unroll
            for (int jt = 0; jt < 4; ++jt) {
                bf16x8 Ph[2], Pl[2]; Sn[jt] = qraw[jt];
#pragma unroll
                for (int s = 0; s < 2; ++s) { const f32x4 p0 = praw[jt][s][0], p1 = praw[jt][s][1]; unsigned hi[4], lo[4];
                    hi[0] = cvtpk(p0[0], p0[1]); hi[1] = cvtpk(p0[2], p0[3]); hi[2] = cvtpk(p1[0], p1[1]); hi[3] = cvtpk(p1[2], p1[3]);
                    lo[0] = cvtpk(p0[0] - bf2f(hi[0] & 0xffffu), p0[1] - bf2f(hi[0] >> 16)); lo[1] = cvtpk(p0[2] - bf2f(hi[1] & 0xffffu), p0[3] - bf2f(hi[1] >> 16));
                    lo[2] = cvtpk(p1[0] - bf2f(hi[2] & 0xffffu), p1[1] - bf2f(hi[2] >> 16)); lo[3] = cvtpk(p1[2] - bf2f(hi[3] & 0xffffu), p1[3] - bf2f(hi[3] >> 16));
                    Ph[s] = __builtin_bit_cast(bf16x8, (u32x4){hi[0], hi[1], hi[2], hi[3]}); Pl[s] = __builtin_bit_cast(bf16x8, (u32x4){lo[0], lo[1], lo[2], lo[3]}); }
                if (gp + 1 < g) FOLD_LOAD_JT(gp + 1, jt);
#pragma unroll
                for (int s = 0; s < 2; ++s) { Sn[jt] = RK_MFMA(Ph[s], Sh[s], Sn[jt]); Sn[jt] = RK_MFMA(Ph[s], Sl[s], Sn[jt]); Sn[jt] = RK_MFMA(Pl[s], Sh[s], Sn[jt]); }
            }
#pragma unroll
            for (int jt = 0; jt < 4; ++jt) Sreg[jt] = Sn[jt];
        }
#undef FOLD_LOAD_JT
    }
    __syncthreads();
    const int tseg0 = g * SEGLEN;
    u32x4 pre[5];
    {
        int ln0; asm volatile("v_mbcnt_lo_u32_b32 %0, -1, 0\n\tv_mbcnt_hi_u32_b32 %0, -1, %0" : "=v"(ln0));
        const int t0 = wave * 64 + ln0, cp = t0 % 60, rg = t0 / 60;
        const bf16* ZT = (const bf16*)(ws + WS_ZT);
        const bf16* src = cp < 8 ? ZR : (cp < 16 ? ZK : (cp < 24 ? ZV : (cp < 32 ? ZL : ZT))); const int ld = cp < 24 ? 512 : (cp < 32 ? 288 : 224), col = cp < 24 ? h * 64 + 8 * (cp & 7) : (cp < 32 ? 64 + 8 * (cp - 24) : 8 * (cp - 32));
#pragma unroll
        for (int e = 0; e < 5; ++e) { const int tt = tseg0 + 4 * rg - 1 + e; pre[e] = (u32x4){0u, 0u, 0u, 0u};
            if (t0 < 480 && tt >= 0 && (PASS == 1 || cp < 40)) pre[e] = *(const u32x4*)(src + ((size_t)b * SEQ + tt) * ld + col); }
    }
#pragma unroll 1
    for (int ch = 0; ch < SEGLEN / T; ++ch) {
        int lane_c; asm volatile("v_mbcnt_lo_u32_b32 %0, -1, 0\n\tv_mbcnt_hi_u32_b32 %0, -1, %0" : "=v"(lane_c));
        const int lane = lane_c, tid = wave * 64 + lane, fr = lane & 15, fq = lane >> 4;
        const int tc0 = tseg0 + ch * T;
        const size_t m0 = (size_t)b * SEQ + tc0;
        if (PASS == 1 && ch > 0) {
            const int t = tid >> 4, iq = tid & 15;
            const f32x4 y = *(const LAS f32x4*)(L + O_YB + (t * 64 + 4 * iq) * 4);
            float s1 = (y[0] + y[1]) + (y[2] + y[3]);
#pragma unroll
            for (int o = 1; o < 16; o <<= 1) s1 += shx(s1, o, lane);
            const float mean = s1 * (1.f / 64.f); const f32x4 dy = y - mean;
            float s2 = (dy[0] * dy[0] + dy[1] * dy[1]) + (dy[2] * dy[2] + dy[3] * dy[3]);
#pragma unroll
            for (int o = 1; o < 16; o <<= 1) s2 += shx(s2, o, lane);
            const float rstd = __builtin_amdgcn_rsqf(s2 * (1.f / 64.f) + GN_EPS), bo = ((LAS float*)(L + O_SC))[32 + t];
            const f32x4 gg = *(const LAS f32x4*)(L + O_GG + (t * 64 + 4 * iq) * 4);
            float o4[4];
#pragma unroll
            for (int e = 0; e < 4; ++e) { const int i = 4 * iq + e; const float vv = bf2f(((const LAS bf16*)(L + O_VT))[i * TS + t]); o4[e] = (dy[e] * rstd * VEC[V_LNG + i] + VEC[V_LNB + i] + bo * vv) * gg[e]; }
            *(u32x2*)((bf16*)(ws + WS_OA) + (m0 - T + t) * 512 + h * 64 + 4 * iq) = (u32x2){cvtpk(o4[0], o4[1]), cvtpk(o4[2], o4[3])};
        }
        for (int rp_ = 0; rp_ < ((RK_REP == 1) ? 3 : 1); ++rp_) {
        if (tid < 480 && (PASS == 1 || (tid % 60) < 40)) {
            const int cp = tid % 60, rg = tid / 60;
            if (cp < 32) {
                const int which = cp >> 3, p = cp & 7;
                const LAS float* muv = which < 3 ? VEC + V_MUR + which * 64 + 8 * p : VEC + V_MUL + 64 + 8 * p;
                float mu[8];
#pragma unroll
                for (int e = 0; e < 8; ++e) mu[e] = muv[e];
#pragma unroll
                for (int rr = 0; rr < 4; ++rr) { const int t = 4 * rg + rr; const u32x4 cu = pre[rr + 1], pu = pre[rr];
                    float f[8];
#pragma unroll
                    for (int e = 0; e < 4; ++e) { const float c0 = bf2f(cu[e] & 0xffffu), c1 = bf2f(cu[e] >> 16), p0 = bf2f(pu[e] & 0xffffu), p1 = bf2f(pu[e] >> 16);
                        f[2 * e] = c0 + (p0 - c0) * mu[2 * e]; f[2 * e + 1] = c1 + (p1 - c1) * mu[2 * e + 1]; }
                    if (which < 3) { LAS float* dst = (LAS float*)(L + (which == 0 ? O_XR : (which == 1 ? O_XK : O_XV))) + t * 64 + 8 * p;
                        *(LAS f32x4*)dst = (f32x4){f[0], f[1], f[2], f[3]}; *(LAS f32x4*)(dst + 4) = (f32x4){f[4], f[5], f[6], f[7]}; }
                    else *(LAS u32x4*)(L + O_XA + (t * 72 + 8 * p) * 2) = (u32x4){cvtpk(f[0], f[1]), cvtpk(f[2], f[3]), cvtpk(f[4], f[5]), cvtpk(f[6], f[7])};
                }
            } else {
#pragma unroll
                for (int rr = 0; rr < 4; ++rr) { const int t = 4 * rg + rr;
                    if (cp < 40) *(LAS u32x4*)(L + O_TXW + (t * 72 + 8 * (cp - 32)) * 2) = pre[rr + 1];
                    else *(LAS u32x4*)(L + O_SG + (t * 168 + 8 * (cp - 40)) * 2) = pre[rr + 1]; }
            }
            if (ch + 1 < SEGLEN / T && (RK_REP != 1 || rp_ == 2)) {
                const bf16* ZT = (const bf16*)(ws + WS_ZT);
                const bf16* src = cp < 8 ? ZR : (cp < 16 ? ZK : (cp < 24 ? ZV : (cp < 32 ? ZL : ZT))); const int ld = cp < 24 ? 512 : (cp < 32 ? 288 : 224), col = cp < 24 ? h * 64 + 8 * (cp & 7) : (cp < 32 ? 64 + 8 * (cp - 24) : 8 * (cp - 32));
#pragma unroll
                for (int e = 0; e < 5; ++e) pre[e] = *(const u32x4*)(src + (m0 + T + 4 * rg - 1 + e) * ld + col);
            }
        }
        __syncthreads();
        }
        for (int rp_ = 0; rp_ < ((RK_REP == 2) ? 3 : 1); ++rp_) {
        {
            const int nt = wave & 3, jn = 16 * nt + fr;
            if (wave < 4) {
                f32x4 aw[2];
#pragma unroll
                for (int mt = 0; mt < 2; ++mt) aw[mt] = (f32x4){0.f, 0.f, 0.f, 0.f};
#pragma unroll
                for (int s = 0; s < 2; ++s) {
                    const bf16x8 bw = *(const LAS bf16x8*)(L + O_WUPT + (jn * 72 + 32 * s + 8 * fq) * 2);
#pragma unroll
                    for (int mt = 0; mt < 2; ++mt) { const bf16x8 xw = *(const LAS bf16x8*)(L + O_TXW + ((16 * mt + fr) * 72 + 32 * s + 8 * fq) * 2); aw[mt] = RK_MFMA(xw, bw, aw[mt]); }
                }
                const float w0 = VEC[V_W0 + jn];
#pragma unroll
                for (int mt = 0; mt < 2; ++mt) {
                    float ldv[4];
#pragma unroll
                    for (int r = 0; r < 4; ++r) {
                        const float xq = -(aw[mt][r] + w0);
                        const float sp = fmaxf(xq, 0.f) + __logf(1.f + __expf(-fabsf(xq)));
                        ldv[r] = -__expf(-sp - 0.5f); }
                    ldv[1] += ldv[0]; ldv[2] += ldv[1]; ldv[3] += ldv[2];
                    const float tot = ldv[3];
                    const float s1 = shx(tot, 16, lane);
                    const float pair = tot + s1;
                    const float s2 = shx(pair, 32, lane);
                    const float excl = ((fq & 1) ? s1 : 0.f) + ((fq & 2) ? s2 : 0.f);
#pragma unroll
                    for (int r = 0; r < 4; ++r) ((LAS float*)(L + O_DEC))[(16 * mt + 4 * fq + r) * 64 + jn] = ldv[r] + excl;
                }
            } else {
                f32x4 ai[2], ag[2];
#pragma unroll
                for (int mt = 0; mt < 2; ++mt) { ai[mt] = (f32x4){0.f, 0.f, 0.f, 0.f}; ag[mt] = ai[mt]; }
#pragma unroll
                for (int s = 0; s < 2; ++s) {
                    const bf16x8 ba = *(const LAS bf16x8*)(L + O_AUPT + (jn * 72 + 32 * s + 8 * fq) * 2);
#pragma unroll
                    for (int mt = 0; mt < 2; ++mt) { const bf16x8 xa = *(const LAS bf16x8*)(L + O_XA + ((16 * mt + fr) * 72 + 32 * s + 8 * fq) * 2); ai[mt] = RK_MFMA(xa, ba, ai[mt]); }
                }
                if (PASS == 1) {
#pragma unroll
                    for (int s = 0; s < 5; ++s) {
                        const bf16x8 bg = *(const LAS bf16x8*)(L + O_GUPT + (jn * 168 + 32 * s + 8 * fq) * 2);
#pragma unroll
                        for (int mt = 0; mt < 2; ++mt) { const bf16x8 xg = *(const LAS bf16x8*)(L + O_SG + ((16 * mt + fr) * 168 + 32 * s + 8 * fq) * 2); ag[mt] = RK_MFMA(xg, bg, ag[mt]); }
                    }
                }
                const float a0 = VEC[V_A0 + jn];
#pragma unroll
                for (int mt = 0; mt < 2; ++mt)
#pragma unroll
                    for (int r = 0; r < 4; ++r) { const int t = 16 * mt + 4 * fq + r;
                        ((LAS float*)(L + O_AA))[t * 64 + jn] = __builtin_amdgcn_rcpf(1.f + __expf(-(ai[mt][r] + a0)));
                        if (PASS == 1) ((LAS float*)(L + O_GG))[t * 64 + jn] = ag[mt][r]; }
            }
        }
        __syncthreads();
        }
        for (int rp_ = 0; rp_ < ((RK_REP == 3) ? 3 : 1); ++rp_) {
        {
            const int t = tid >> 4, jq = tid & 15, q = t >> 4;
            const f32x4 xk = *(const LAS f32x4*)(L + O_XK + (t * 64 + 4 * jq) * 4), xr = *(const LAS f32x4*)(L + O_XR + (t * 64 + 4 * jq) * 4), aa = *(const LAS f32x4*)(L + O_AA + (t * 64 + 4 * jq) * 4);
            const f32x4 xv = *(const LAS f32x4*)(L + O_XV + (t * 64 + 4 * jq) * 4);
            const f32x4 kkc = *(const LAS f32x4*)(VEC + V_KK + 4 * jq), kac = *(const LAS f32x4*)(VEC + V_KA + 4 * jq), rkc = *(const LAS f32x4*)(VEC + V_RK + 4 * jq);
            f32x4 kkv, kmod; float n2 = 0.f, bo = 0.f;
#pragma unroll
            for (int e = 0; e < 4; ++e) { kkv[e] = xk[e] * kkc[e]; n2 += kkv[e] * kkv[e]; kmod[e] = xk[e] * (1.f + (aa[e] - 1.f) * kac[e]); bo += xr[e] * kmod[e] * rkc[e]; }
#pragma unroll
            for (int o = 1; o < 16; o <<= 1) { n2 += shx(n2, o, lane); bo += shx(bo, o, lane); }
            const float invn = 1.f / fmaxf(sqrtf(n2), 1e-12f);
            if (jq == 0) ((LAS float*)(L + O_SC))[32 + t] = bo;
            const f32x4 cum = *(const LAS f32x4*)(L + O_DEC + (t * 64 + 4 * jq) * 4);
            f32x4 cm1 = (f32x4){0.f, 0.f, 0.f, 0.f}; if (t & 15) cm1 = *(const LAS f32x4*)(L + O_DEC + ((t - 1) * 64 + 4 * jq) * 4);
            float a_t[4], r_t[4], b_t[4], k_t[4], Wv[4];
#pragma unroll
            for (int e = 0; e < 4; ++e) { const float W = __expf(cum[e]), Wm1 = __expf(cm1[e]), iW = __expf(-cum[e]); const float kk = kkv[e] * invn;
                a_t[e] = -kk * Wm1; r_t[e] = xr[e] * W; b_t[e] = kk * aa[e] * iW; k_t[e] = kmod[e] * iW; Wv[e] = W; }
            *(LAS f32x4*)(L + O_ATF + (t * 64 + 4 * jq) * 4) = (f32x4){a_t[0], a_t[1], a_t[2], a_t[3]};
            *(LAS u32x2*)(L + O_AT + (t * 72 + 4 * jq) * 2) = (u32x2){cvtpk(a_t[0], a_t[1]), cvtpk(a_t[2], a_t[3])};
            *(LAS u32x2*)(L + O_RT + (t * 72 + 4 * jq) * 2) = (u32x2){cvtpk(r_t[0], r_t[1]), cvtpk(r_t[2], r_t[3])};
            const unsigned b01 = cvtpk(b_t[0], b_t[1]), b23 = cvtpk(b_t[2], b_t[3]), k01 = cvtpk(k_t[0], k_t[1]), k23 = cvtpk(k_t[2], k_t[3]), v01 = cvtpk(xv[0], xv[1]), v23 = cvtpk(xv[2], xv[3]);
            *(LAS u32x2*)(L + O_BT + (t * 72 + 4 * jq) * 2) = (u32x2){b01, b23};
            *(LAS u32x2*)(L + O_KT + (t * 72 + 4 * jq) * 2) = (u32x2){k01, k23};
            LAS bf16* btt = (LAS bf16*)(L + O_BTT) + (4 * jq) * TS + t; LAS bf16* ktt = (LAS bf16*)(L + O_KTT) + (4 * jq) * TS + t; LAS bf16* vt = (LAS bf16*)(L + O_VT) + (4 * jq) * TS + t;
            btt[0] = (bf16)(b01 & 0xffffu); btt[TS] = (bf16)(b01 >> 16); btt[2 * TS] = (bf16)(b23 & 0xffffu); btt[3 * TS] = (bf16)(b23 >> 16);
            ktt[0] = (bf16)(k01 & 0xffffu); ktt[TS] = (bf16)(k01 >> 16); ktt[2 * TS] = (bf16)(k23 & 0xffffu); ktt[3 * TS] = (bf16)(k23 >> 16);
            vt[0] = (bf16)(v01 & 0xffffu); vt[TS] = (bf16)(v01 >> 16); vt[2 * TS] = (bf16)(v23 & 0xffffu); vt[3 * TS] = (bf16)(v23 >> 16);
            if ((t & 15) == 15) *(LAS f32x4*)(L + O_WL + (q * 64 + 4 * jq) * 4) = (f32x4){Wv[0], Wv[1], Wv[2], Wv[3]};
        }
        __syncthreads();
        }
        for (int rp_ = 0; rp_ < ((RK_REP == 4) ? 3 : 1); ++rp_) {
        {
            const int q = wave >> 2, tile = wave & 3;
            const int ao = (tile & 2) ? O_RT : O_AT, bo = (tile & 1) ? O_KT : O_BT;
            f32x4 acc = (f32x4){0.f, 0.f, 0.f, 0.f};
            if (PASS == 1 || tile < 2)
#pragma unroll
            for (int s = 0; s < 2; ++s) { const bf16x8 av = *(const LAS bf16x8*)(L + ao + ((16 * q + fr) * 72 + 32 * s + 8 * fq) * 2), bv = *(const LAS bf16x8*)(L + bo + ((16 * q + fr) * 72 + 32 * s + 8 * fq) * 2);
                acc = RK_MFMA(av, bv, acc); }
#pragma unroll
            for (int r = 0; r < 4; ++r) { const int t = 4 * fq + r; const bool keep = (tile & 2) ? (fr <= t) : (fr < t); const float v = keep ? acc[r] : 0.f;
                if (tile == 0) ((LAS float*)(L + O_NM))[q * 256 + fr * 16 + t] = v;
                else if (tile == 1) ((LAS float*)(L + O_AAK))[q * 256 + t * 16 + fr] = v;
                else if (tile == 2) ((LAS bf16*)(L + O_ARB))[q * 256 + t * 16 + fr] = (bf16)f2bf(v);
                else ((LAS bf16*)(L + O_ARK))[q * 256 + t * 16 + fr] = (bf16)f2bf(v); }
        }
        __syncthreads();
        }
        for (int rp_ = 0; rp_ < ((RK_REP == 5) ? 3 : 1); ++rp_) {
        if (wave < 2) {
            const int q = wave, j = lane; const LAS float* NT = (const LAS float*)(L + O_NM) + q * 256;
            float X[16];
#pragma unroll
            for (int t = 0; t < 16; ++t) X[t] = ((const LAS float*)(L + O_ATF))[(16 * q + t) * 64 + j];
#pragma unroll
            for (int s = 0; s < 15; ++s) {
#pragma unroll
                for (int t4 = (s + 1) / 4; t4 < 4; ++t4) { const f32x4 n4 = *(const LAS f32x4*)(NT + s * 16 + 4 * t4);
#pragma unroll
                    for (int e = 0; e < 4; ++e) if (4 * t4 + e > s) X[4 * t4 + e] += n4[e] * X[s]; }
            }
#pragma unroll
            for (int t = 0; t < 16; ++t) ((LAS bf16*)(L + O_AH))[(16 * q + t) * 72 + j] = (bf16)f2bf(X[t]);
        } else if (wave == 2) {
            const int q = (lane >> 4) & 1, sc = lane & 15; const LAS float* NT = (const LAS float*)(L + O_NM) + q * 256; const LAS float* Ak = (const LAS float*)(L + O_AAK) + q * 256;
            float X[16];
#pragma unroll
            for (int t = 0; t < 16; ++t) X[t] = Ak[t * 16 + sc];
#pragma unroll
            for (int s = 0; s < 15; ++s) {
#pragma unroll
                for (int t4 = (s + 1) / 4; t4 < 4; ++t4) { const f32x4 n4 = *(const LAS f32x4*)(NT + s * 16 + 4 * t4);
#pragma unroll
                    for (int e = 0; e < 4; ++e) if (4 * t4 + e > s) X[4 * t4 + e] += n4[e] * X[s]; }
            }
            if (lane < 32) {
#pragma unroll
                for (int t = 0; t < 16; ++t) ((LAS bf16*)(L + O_AKH))[q * 256 + t * 16 + sc] = (bf16)f2bf(X[t]); }
        }
        __syncthreads();
        }
        f32x4 Ssave[4];
#pragma unroll
        for (int jt = 0; jt < 4; ++jt) Ssave[jt] = Sreg[jt];
        for (int rp6_ = 0; rp6_ < ((RK_REP == 6) ? 3 : 1); ++rp6_) {
        if (RK_REP == 6) {
#pragma unroll
            for (int jt = 0; jt < 4; ++jt) Sreg[jt] = Ssave[jt]; }
        if (wave < 4 || PASS == 0) {
            const bool qpart = wave < 4;
#pragma unroll
            for (int q = 0; q < 2; ++q) {
                bf16x8 Sf[2];
#pragma unroll
                for (int s = 0; s < 2; ++s) Sf[s] = __builtin_bit_cast(bf16x8, (u32x4){cvtpk(Sreg[2 * s][0], Sreg[2 * s][1]), cvtpk(Sreg[2 * s][2], Sreg[2 * s][3]), cvtpk(Sreg[2 * s + 1][0], Sreg[2 * s + 1][1]), cvtpk(Sreg[2 * s + 1][2], Sreg[2 * s + 1][3])});
                const int rowA = (16 * q + fr) * 72;
                f32x4 U = (f32x4){0.f, 0.f, 0.f, 0.f};
#pragma unroll
                for (int s = 0; s < 2; ++s) { const bf16x8 af = mk8(*(const LAS u32x2*)(L + O_AH + (rowA + 32 * s + 4 * fq) * 2), *(const LAS u32x2*)(L + O_AH + (rowA + 32 * s + 16 + 4 * fq) * 2)); U = RK_MFMA(af, Sf[s], U); }
                u32x2 vv = {0u, 0u};
                if (qpart) { vv = *(const LAS u32x2*)(L + O_VT + ((i0 + fr) * TS + 16 * q + 4 * fq) * 2);
                    const bf16x8 akf = mk8(*(const LAS u32x2*)(L + O_AKH + (q * 256 + fr * 16 + 4 * fq) * 2), (u32x2){0u, 0u}); U = RK_MFMA(akf, mk8(vv, (u32x2){0u, 0u}), U); }
                const bf16x8 UV = mk8((u32x2){cvtpk(U[0], U[1]), cvtpk(U[2], U[3])}, vv);
                if (PASS == 1) {
                    f32x4 Y = (f32x4){0.f, 0.f, 0.f, 0.f};
#pragma unroll
                    for (int s = 0; s < 2; ++s) { const bf16x8 rf = mk8(*(const LAS u32x2*)(L + O_RT + (rowA + 32 * s + 4 * fq) * 2), *(const LAS u32x2*)(L + O_RT + (rowA + 32 * s + 16 + 4 * fq) * 2)); Y = RK_MFMA(rf, Sf[s], Y); }
                    const bf16x8 abf = mk8(*(const LAS u32x2*)(L + O_ARB + (q * 256 + fr * 16 + 4 * fq) * 2), *(const LAS u32x2*)(L + O_ARK + (q * 256 + fr * 16 + 4 * fq) * 2)); Y = RK_MFMA(abf, UV, Y);
#pragma unroll
                    for (int r = 0; r < 4; ++r) ((LAS float*)(L + O_YB))[(16 * q + 4 * fq + r) * 64 + i0 + fr] = Y[r];
                }
#pragma unroll
                for (int jt = 0; jt < 4; ++jt) {
                    const bf16x8 bkf = mk8(*(const LAS u32x2*)(L + O_BTT + ((16 * jt + fr) * TS + 16 * q + 4 * fq) * 2), *(const LAS u32x2*)(L + O_KTT + ((16 * jt + fr) * TS + 16 * q + 4 * fq) * 2));
                    Sreg[jt] = RK_MFMA(bkf, UV, Sreg[jt]);
                    const f32x4 wl = *(const LAS f32x4*)(L + O_WL + (q * 64 + 16 * jt + 4 * fq) * 4);
                    Sreg[jt] = Sreg[jt] * wl;
                }
            }
        }
        __syncthreads();
        }
    }
    if (PASS == 1) {
        int lane_c; asm volatile("v_mbcnt_lo_u32_b32 %0, -1, 0\n\tv_mbcnt_hi_u32_b32 %0, -1, %0" : "=v"(lane_c));
        const int lane = lane_c, tid = wave * 64 + lane;
        const size_t m0 = (size_t)b * SEQ + tseg0 + SEGLEN;
        const int t = tid >> 4, iq = tid & 15;
        const f32x4 y = *(const LAS f32x4*)(L + O_YB + (t * 64 + 4 * iq) * 4);
        float s1 = (y[0] + y[1]) + (y[2] + y[3]);
#pragma unroll
        for (int o = 1; o < 16; o <<= 1) s1 += shx(s1, o, lane);
        const float mean = s1 * (1.f / 64.f); const f32x4 dy = y - mean;
        float s2 = (dy[0] * dy[0] + dy[1] * dy[1]) + (dy[2] * dy[2] + dy[3] * dy[3]);
#pragma unroll
        for (int o = 1; o < 16; o <<= 1) s2 += shx(s2, o, lane);
        const float rstd = __builtin_amdgcn_rsqf(s2 * (1.f / 64.f) + GN_EPS), bo = ((LAS float*)(L + O_SC))[32 + t];
        const f32x4 gg = *(const LAS f32x4*)(L + O_GG + (t * 64 + 4 * iq) * 4);
        float o4[4];
#pragma unroll
        for (int e = 0; e < 4; ++e) { const int i = 4 * iq + e; const float vv = bf2f(((const LAS bf16*)(L + O_VT))[i * TS + t]); o4[e] = (dy[e] * rstd * VEC[V_LNG + i] + VEC[V_LNB + i] + bo * vv) * gg[e]; }
        *(u32x2*)((bf16*)(ws + WS_OA) + (m0 - T + t) * 512 + h * 64 + 4 * iq) = (u32x2){cvtpk(o4[0], o4[1]), cvtpk(o4[2], o4[3])};
    }
    if (PASS == 0) {
        float* dst = SEGPQ + (size_t)itm * 8192 + (wave < 4 ? 4096 : 0);
#pragma unroll
        for (int jt = 0; jt < 4; ++jt)
#pragma unroll
            for (int r = 0; r < 4; ++r) dst[(16 * jt + 4 * fq + r) * 64 + i0 + fr] = Sreg[jt][r];
    }
    __syncthreads();
}
#undef RK_MFMA
}

namespace rk2 {
using rk::bf16x8; using rk::f32x4; using rk::u32x4; using rk::u32x2; using rk::cvtpk; using rk::mk8; using rk::shx;
using rk::V_W0; using rk::V_A0; using rk::V_KK; using rk::V_KA; using rk::V_RK; using rk::V_LNG; using rk::V_LNB; using rk::V_MUR; using rk::V_MUL;
constexpr int T = 32, SEGLEN = 512, NSEG = SEQ / SEGLEN, TS = 36;
constexpr int O_VEC = 0, O_XR = 3712, O_XK = O_XR + 8192, O_XV = O_XK + 8192;
constexpr int O_TXW = O_XV + 8192, O_XA = O_TXW + 4608, O_SG = O_XA + 4608;
constexpr int O_DEC = O_SG + 10752, O_AA = O_DEC + 8192, O_GG = O_AA + 8192  , O_SC = O_GG + 24576  ;
constexpr int O_AT = O_SC + 256, O_RT = O_AT + 4608, O_BT = O_RT + 4608, O_KT = O_BT + 4608;
constexpr int O_VB = O_KT + 4608  , O_WL = O_VB + 9216;
constexpr int O_NM = O_WL + 512, O_AAK = O_NM + 2048, O_ARB = O_AAK + 2048, O_ARK = O_ARB + 1024, O_AH = O_ARK + 1024, O_AKH = O_AH + 4608, O_ATF = O_AKH + 1024, O_YB = O_ATF + 8192  , O_END = O_YB + 16384;
static_assert(O_END <= 163840 - 512, "rk2 LDS map");
#define RK_MFMA(a, b, c) __builtin_amdgcn_mfma_f32_16x16x32_bf16((a), (b), (c), 0, 0, 0)
#define RK2_LANE() int lane_c_; asm volatile("v_mbcnt_lo_u32_b32 %0, -1, 0\n\tv_mbcnt_hi_u32_b32 %0, -1, %0" : "=v"(lane_c_)); const int lane = lane_c_, tid = wave * 64 + lane, fr = lane & 15, fq = lane >> 4; (void)tid; (void)fr; (void)fq;

typedef short v4i16_t __attribute__((ext_vector_type(4)));
__device__ __forceinline__ u32x2 tr4(LAS unsigned char* img, int tok0, int c0, int fr, int fq) {
    const v4i16_t v = __builtin_amdgcn_ds_read_tr16_b64_v4i16((LAS v4i16_t*)(img + ((tok0 + 4 * fq + (fr >> 2)) * 72 + c0 + 4 * (fr & 3)) * 2));
    return __builtin_bit_cast(u32x2, v); }
template <int PASS>
__device__ __forceinline__ void item(Frame& F, unsigned char* ws, const RwkvP& P, int b, int h, int g) {
    LAS unsigned char* L = F.lds;
    const int wave = F.wave;
    LAS float* VEC = (LAS float*)(L + O_VEC);
    const bf16* ZR = (const bf16*)(ws + Z_R); const bf16* ZK = (const bf16*)(ws + Z_K); const bf16* ZV = (const bf16*)(ws + Z_V); const bf16* ZL = (const bf16*)(ws + Z_L); const bf16* ZT = (const bf16*)(ws + WS_ZT);
    float* SEGPQ = (float*)(ws + WS_RKPQ);
    const int itm = (b * 8 + h) * NSEG + g;
    const int tseg0 = g * SEGLEN;
    u32x4 pre[1][5];
#define RK2_TASK(k, id, cp, rg) const int id = tid; int cp, rg; bool on_##k; \
    if (id < 64) { cp = 32 + (id & 7); rg = id >> 3; on_##k = true; } \
    else if (id < 192) { const int k_ = id - 64; cp = 40 + (k_ & 15); rg = k_ >> 4; on_##k = (PASS == 1); } \
    else if (id < 256) { const int k_ = id - 192; cp = 24 + (k_ & 7); rg = k_ >> 3; on_##k = true; } \
    else { const int k_ = id - 256; if (k_ < 192) { cp = k_ % 24; rg = k_ / 24; on_##k = true; } else { const int m_ = k_ - 192; cp = 56 + (m_ & 3); rg = (m_ >> 2) & 7; on_##k = (PASS == 1) && m_ < 32; } }
#define RK2_SRC(cp) const bf16* src = cp < 8 ? ZR : (cp < 16 ? ZK : (cp < 24 ? ZV : (cp < 32 ? ZL : ZT))); const int ld = cp < 24 ? 512 : (cp < 32 ? 288 : 224), col = cp < 24 ? h * 64 + 8 * (cp & 7) : (cp < 32 ? 64 + 8 * (cp - 24) : 8 * (cp - 32));
#define RK2_PREFETCH(k, tc0n) do { RK2_TASK(k, id_, cp_, rg_) if (on_##k) { RK2_SRC(cp_) _Pragma("unroll") for (int e = 0; e < 5; ++e) { const int tt = (tc0n) + 4 * rg_ - 1 + e; pre[k][e] = (u32x4){0u, 0u, 0u, 0u}; \
            if (tt >= 0) pre[k][e] = *(const u32x4*)(src + ((size_t)b * SEQ + tt) * ld + col); } } } while (0)
    { RK2_LANE(); RK2_PREFETCH(0, tseg0); }
    bf16x8 bw[2], ba[2], bg[5];
    f32x4 Sreg[4];
    const int i0 = 16 * (wave & 3);
    {
        RK2_LANE();
        if (tid < 64) { const int c = h * 64 + tid; VEC[V_W0 + tid] = P.w0[c]; VEC[V_A0 + tid] = P.a0[c]; VEC[V_KK + tid] = P.k_k[c]; VEC[V_KA + tid] = P.k_a[c]; VEC[V_RK + tid] = P.r_k[c];
            VEC[V_LNG + tid] = P.ln_g[c]; VEC[V_LNB + tid] = P.ln_b[c]; VEC[V_MUR + tid] = P.mu[c]; VEC[V_MUR + 64 + tid] = P.mu[512 + c]; VEC[V_MUR + 128 + tid] = P.mu[1024 + c]; }
        if (tid < 288) VEC[V_MUL + tid] = P.mu[1536 + tid];
#pragma unroll
        for (int jt = 0; jt < 4; ++jt) Sreg[jt] = (f32x4){0.f, 0.f, 0.f, 0.f};
        if (PASS == 0) { if (wave >= 4) {
#pragma unroll
            for (int jt = 0; jt < 4; ++jt)
#pragma unroll
                for (int r = 0; r < 4; ++r) Sreg[jt][r] = (16 * jt + 4 * fq + r == i0 + fr) ? 1.f : 0.f; } }
        else if (g > 0) {
            const unsigned char* Mb = (const unsigned char*)(SEGPQ + (size_t)((b * 8 + h) * NSEG) * 8192);
            constexpr int RING = 16384;
#define FOLD_ISSUE(GP) do { const unsigned char* m_ = Mb + (size_t)(GP) * 32768 + wave * 4096 + lane * 16; LAS unsigned char* d_ = L + RING + ((GP) & 3) * 32768 + wave * 4096; \
            _Pragma("unroll") for (int c_ = 0; c_ < 4; ++c_) __builtin_amdgcn_global_load_lds((const unsigned*)(m_ + c_ * 1024), (LAS unsigned*)(d_ + c_ * 1024), 16, 0, 0); } while (0)
            FOLD_ISSUE(0); if (g > 1) FOLD_ISSUE(1); if (g > 2) FOLD_ISSUE(2);
#pragma unroll 1
            for (int gp = 0; gp < g; ++gp) {
                const int later = (g < gp + 3 ? g : gp + 3) - gp - 1;
                if (later == 2) asm volatile("s_waitcnt vmcnt(8)" ::: "memory"); else if (later == 1) asm volatile("s_waitcnt vmcnt(4)" ::: "memory"); else asm volatile("s_waitcnt vmcnt(0)" ::: "memory");
                __builtin_amdgcn_s_barrier(); asm volatile("" ::: "memory");
                if (gp + 3 < g) FOLD_ISSUE(gp + 3);
                if (wave < 4) {
                    const LAS unsigned char* sl = L + RING + (gp & 3) * 32768;
                    bf16x8 Sh[2], Sl[2];
#pragma unroll
                    for (int s = 0; s < 2; ++s) { unsigned hi[4], lo[4];
#pragma unroll
                        for (int e = 0; e < 4; ++e) { const float x0 = Sreg[2 * s + (e >> 1)][2 * (e & 1)], x1 = Sreg[2 * s + (e >> 1)][2 * (e & 1) + 1];
                            hi[e] = cvtpk(x0, x1); lo[e] = cvtpk(x0 - bf2f(hi[e] & 0xffffu), x1 - bf2f(hi[e] >> 16)); }
                        Sh[s] = __builtin_bit_cast(bf16x8, (u32x4){hi[0], hi[1], hi[2], hi[3]}); Sl[s] = __builtin_bit_cast(bf16x8, (u32x4){lo[0], lo[1], lo[2], lo[3]}); }
#pragma unroll
                    for (int jt = 0; jt < 4; ++jt) {
                        f32x4 acc = *(const LAS f32x4*)(sl + ((wave * 4 + jt) * 64 + lane) * 16);
#pragma unroll
                        for (int s = 0; s < 2; ++s) { const bf16x8 ph = *(const LAS bf16x8*)(sl + 16384 + ((jt * 2 + s) * 64 + lane) * 16), pl = *(const LAS bf16x8*)(sl + 24576 + ((jt * 2 + s) * 64 + lane) * 16);
                            acc = RK_MFMA(ph, Sh[s], acc); acc = RK_MFMA(ph, Sl[s], acc); acc = RK_MFMA(pl, Sh[s], acc); }
                        Sreg[jt] = acc;
                    }
                }
            }
#undef FOLD_ISSUE
        }
    }
    {
        RK2_LANE();
        const int jn = h * 64 + 16 * (wave & 3) + fr;
#pragma unroll
        for (int s = 0; s < 2; ++s) { bw[s] = (bf16x8){0, 0, 0, 0, 0, 0, 0, 0}; ba[s] = bw[s]; }
#pragma unroll
        for (int s = 0; s < 5; ++s) bg[s] = (bf16x8){0, 0, 0, 0, 0, 0, 0, 0};
        if (wave >= 4) {
            float vw[2][8], va[2][8], vg[5][8];
#pragma unroll
            for (int s = 0; s < 2; ++s)
#pragma unroll
                for (int e = 0; e < 8; ++e) { vw[s][e] = P.w_up[(32 * s + 8 * fq + e) * 512 + jn]; va[s][e] = P.a_up[(32 * s + 8 * fq + e) * 512 + jn]; }
            if (PASS == 1) {
#pragma unroll
                for (int s = 0; s < 5; ++s)
#pragma unroll
                    for (int e = 0; e < 8; ++e) vg[s][e] = P.g_up[(32 * s + 8 * fq + e) * 512 + jn]; }
#pragma unroll
            for (int s = 0; s < 2; ++s) {
                bw[s] = __builtin_bit_cast(bf16x8, (u32x4){cvtpk(vw[s][0], vw[s][1]), cvtpk(vw[s][2], vw[s][3]), cvtpk(vw[s][4], vw[s][5]), cvtpk(vw[s][6], vw[s][7])});
                ba[s] = __builtin_bit_cast(bf16x8, (u32x4){cvtpk(va[s][0], va[s][1]), cvtpk(va[s][2], va[s][3]), cvtpk(va[s][4], va[s][5]), cvtpk(va[s][6], va[s][7])}); }
            if (PASS == 1) {
#pragma unroll
                for (int s = 0; s < 5; ++s) bg[s] = __builtin_bit_cast(bf16x8, (u32x4){cvtpk(vg[s][0], vg[s][1]), cvtpk(vg[s][2], vg[s][3]), cvtpk(vg[s][4], vg[s][5]), cvtpk(vg[s][6], vg[s][7])}); }
        }
    }
#define RK2_S1(k) do { RK2_TASK(k, id_, cp, rg) if (on_##k) { \
        if (cp < 32) { const int which = cp >> 3, p = cp & 7; const LAS float* muv = which < 3 ? VEC + V_MUR + which * 64 + 8 * p : VEC + V_MUL + 64 + 8 * p; float mu[8]; \
            _Pragma("unroll") for (int e = 0; e < 8; ++e) mu[e] = muv[e]; \
            _Pragma("unroll") for (int rr = 0; rr < 4; ++rr) { const int t = 4 * rg + rr; const u32x4 cu = pre[k][rr + 1], pu = pre[k][rr]; float f[8]; \
                _Pragma("unroll") for (int e = 0; e < 4; ++e) { const float c0 = bf2f(cu[e] & 0xffffu), c1 = bf2f(cu[e] >> 16), p0 = bf2f(pu[e] & 0xffffu), p1 = bf2f(pu[e] >> 16); \
                    f[2 * e] = c0 + (p0 - c0) * mu[2 * e]; f[2 * e + 1] = c1 + (p1 - c1) * mu[2 * e + 1]; } \
                if (which < 3) { LAS float* dst = (LAS float*)(L + (which == 0 ? O_XR : (which == 1 ? O_XK : O_XV))) + t * 64 + 8 * p; \
                    *(LAS f32x4*)dst = (f32x4){f[0], f[1], f[2], f[3]}; *(LAS f32x4*)(dst + 4) = (f32x4){f[4], f[5], f[6], f[7]}; } \
                else *(LAS u32x4*)(L + O_XA + (t * 72 + 8 * p) * 2) = (u32x4){cvtpk(f[0], f[1]), cvtpk(f[2], f[3]), cvtpk(f[4], f[5]), cvtpk(f[6], f[7])}; } } \
        else { _Pragma("unroll") for (int rr = 0; rr < 4; ++rr) { const int t = 4 * rg + rr; \
                if (cp < 40) *(LAS u32x4*)(L + O_TXW + (t * 72 + 8 * (cp - 32)) * 2) = pre[k][rr + 1]; else *(LAS u32x4*)(L + O_SG + (t * 168 + 8 * (cp - 40)) * 2) = pre[k][rr + 1]; } } } } while (0)
#define RK2_S2W(cn) do { const int jn = 16 * (wave & 3) + fr; f32x4 aw[2]; \
        _Pragma("unroll") for (int mt = 0; mt < 2; ++mt) aw[mt] = (f32x4){0.f, 0.f, 0.f, 0.f}; \
        _Pragma("unroll") for (int s = 0; s < 2; ++s) _Pragma("unroll") for (int mt = 0; mt < 2; ++mt) { \
            const bf16x8 xw = *(const LAS bf16x8*)(L + O_TXW + ((16 * mt + fr) * 72 + 32 * s + 8 * fq) * 2); aw[mt] = RK_MFMA(xw, bw[s], aw[mt]); } \
        const float w0 = VEC[V_W0 + jn]; \
        _Pragma("unroll") for (int mt = 0; mt < 2; ++mt) { float ldv[4]; \
            _Pragma("unroll") for (int r = 0; r < 4; ++r) ldv[r] = -0.8750387749145276f * __builtin_amdgcn_rcpf(1.f + __expf(-(aw[mt][r] + w0)));     \
            ldv[1] += ldv[0]; ldv[2] += ldv[1]; ldv[3] += ldv[2]; const float tot = ldv[3]; const float s1 = shx(tot, 16, lane); const float pair = tot + s1; const float s2 = shx(pair, 32, lane); \
            const float excl = ((fq & 1) ? s1 : 0.f) + ((fq & 2) ? s2 : 0.f); \
            _Pragma("unroll") for (int r = 0; r < 4; ++r) ((LAS float*)(L + O_DEC))[(16 * mt + 4 * fq + r) * 64 + jn] = ldv[r] + excl; } } while (0)
#define RK2_S2A(cn) do { const int jn = 16 * (wave & 3) + fr; f32x4 ai[2]; \
        _Pragma("unroll") for (int mt = 0; mt < 2; ++mt) ai[mt] = (f32x4){0.f, 0.f, 0.f, 0.f}; \
        _Pragma("unroll") for (int s = 0; s < 2; ++s) _Pragma("unroll") for (int mt = 0; mt < 2; ++mt) { \
            const bf16x8 xa = *(const LAS bf16x8*)(L + O_XA + ((16 * mt + fr) * 72 + 32 * s + 8 * fq) * 2); ai[mt] = RK_MFMA(xa, ba[s], ai[mt]); } \
        const float a0 = VEC[V_A0 + jn]; \
        _Pragma("unroll") for (int mt = 0; mt < 2; ++mt) _Pragma("unroll") for (int r = 0; r < 4; ++r) ((LAS float*)(L + O_AA))[(16 * mt + 4 * fq + r) * 64 + jn] = __builtin_amdgcn_rcpf(1.f + __expf(-(ai[mt][r] + a0))); } while (0)
#define RK2_S2G(cn) do { const int jn = 16 * (wave & 3) + fr; f32x4 ag[2]; \
        _Pragma("unroll") for (int mt = 0; mt < 2; ++mt) ag[mt] = (f32x4){0.f, 0.f, 0.f, 0.f}; \
        _Pragma("unroll") for (int s = 0; s < 5; ++s) _Pragma("unroll") for (int mt = 0; mt < 2; ++mt) { \
            const bf16x8 xg = *(const LAS bf16x8*)(L + O_SG + ((16 * mt + fr) * 168 + 32 * s + 8 * fq) * 2); ag[mt] = RK_MFMA(xg, bg[s], ag[mt]); } \
        _Pragma("unroll") for (int mt = 0; mt < 2; ++mt) _Pragma("unroll") for (int r = 0; r < 4; ++r) ((LAS float*)(L + O_GG + ((cn) % 3) * 8192))[(16 * mt + 4 * fq + r) * 64 + jn] = ag[mt][r]; } while (0)
#define RK2_S7(cp_, t, iq) do { const int bufp = (cp_) & 1; \
        const f32x4 y = *(const LAS f32x4*)(L + O_YB + bufp * 8192 + ((t) * 64 + 4 * (iq)) * 4); float s1 = rk::row_sum16((y[0] + y[1]) + (y[2] + y[3])); \
        const float mean = s1 * (1.f / 64.f); const f32x4 dy = y - mean; const float s2 = rk::row_sum16((dy[0] * dy[0] + dy[1] * dy[1]) + (dy[2] * dy[2] + dy[3] * dy[3])); \
        const float rstd = __builtin_amdgcn_rsqf(s2 * (1.f / 64.f) + GN_EPS), bo = ((LAS float*)(L + O_SC))[bufp * 32 + (t)]; \
        const f32x4 gg = *(const LAS f32x4*)(L + O_GG + ((cp_) % 3) * 8192 + ((t) * 64 + 4 * (iq)) * 4); float o4[4]; \
        const u32x2 vb = *(const LAS u32x2*)(L + O_VB + bufp * 4608 + ((t) * 72 + 4 * (iq)) * 2); const float vf[4] = {bf2f(vb.x & 0xffffu), bf2f(vb.x >> 16), bf2f(vb.y & 0xffffu), bf2f(vb.y >> 16)}; \
        _Pragma("unroll") for (int e = 0; e < 4; ++e) { const int i = 4 * (iq) + e; o4[e] = (dy[e] * rstd * VEC[V_LNG + i] + VEC[V_LNB + i] + bo * vf[e]) * gg[e]; } \
        *(u32x2*)((bf16*)(ws + WS_OA) + ((size_t)b * SEQ + tseg0 + (cp_) * T + (t)) * 512 + h * 64 + 4 * (iq)) = (u32x2){cvtpk(o4[0], o4[1]), cvtpk(o4[2], o4[3])}; } while (0)

    lds_barrier();
    {
        RK2_LANE();
        RK2_S1(0); RK2_PREFETCH(0, tseg0 + T);
        lds_barrier();
        if (wave >= 4) { RK2_S2W(0); RK2_S2A(0); if (PASS == 1) RK2_S2G(0); }
        lds_barrier();
    }
#pragma unroll 1
    for (int ch = 0; ch < SEGLEN / T; ++ch) {
        RK2_LANE();
        const int buf = ch & 1;
        for (int rp1 = 0; rp1 < (RK2_REP == 1 ? 3 : 1); ++rp1) {
        {
            const int t = tid >> 4, jq = tid & 15, q = t >> 4;
            const f32x4 xk = *(const LAS f32x4*)(L + O_XK + (t * 64 + 4 * jq) * 4), xr = *(const LAS f32x4*)(L + O_XR + (t * 64 + 4 * jq) * 4), aa = *(const LAS f32x4*)(L + O_AA + (t * 64 + 4 * jq) * 4);
            const f32x4 xv = *(const LAS f32x4*)(L + O_XV + (t * 64 + 4 * jq) * 4);
            const f32x4 kkc = *(const LAS f32x4*)(VEC + V_KK + 4 * jq), kac = *(const LAS f32x4*)(VEC + V_KA + 4 * jq), rkc = *(const LAS f32x4*)(VEC + V_RK + 4 * jq);
            f32x4 kkv, kmod; float n2 = 0.f, bo = 0.f;
#pragma unroll
            for (int e = 0; e < 4; ++e) { kkv[e] = xk[e] * kkc[e]; n2 += kkv[e] * kkv[e]; kmod[e] = xk[e] * (1.f + (aa[e] - 1.f) * kac[e]); bo += xr[e] * kmod[e] * rkc[e]; }
            n2 = rk::row_sum16(n2); bo = rk::row_sum16(bo);
            const float invn = __builtin_amdgcn_rsqf(fmaxf(n2, 1e-24f));
            if (jq == 0) ((LAS float*)(L + O_SC))[buf * 32 + t] = bo;
            const f32x4 cum = *(const LAS f32x4*)(L + O_DEC + (t * 64 + 4 * jq) * 4);
            f32x4 cm1 = (f32x4){0.f, 0.f, 0.f, 0.f}; if (t & 15) cm1 = *(const LAS f32x4*)(L + O_DEC + ((t - 1) * 64 + 4 * jq) * 4);
            float a_t[4], r_t[4], b_t[4], k_t[4], Wv[4];
#pragma unroll
            for (int e = 0; e < 4; ++e) { const float W = __builtin_amdgcn_exp2f(cum[e]), Wm1 = __builtin_amdgcn_exp2f(cm1[e]), iW = __builtin_amdgcn_exp2f(-cum[e]); const float kk = kkv[e] * invn;
                a_t[e] = -kk * Wm1; r_t[e] = xr[e] * W; b_t[e] = kk * aa[e] * iW; k_t[e] = kmod[e] * iW; Wv[e] = W; }
            *(LAS f32x4*)(L + O_ATF + (t * 64 + 4 * jq) * 4) = (f32x4){a_t[0], a_t[1], a_t[2], a_t[3]};
            *(LAS u32x2*)(L + O_AT + (t * 72 + 4 * jq) * 2) = (u32x2){cvtpk(a_t[0], a_t[1]), cvtpk(a_t[2], a_t[3])};
            *(LAS u32x2*)(L + O_RT + (t * 72 + 4 * jq) * 2) = (u32x2){cvtpk(r_t[0], r_t[1]), cvtpk(r_t[2], r_t[3])};
            const unsigned b01 = cvtpk(b_t[0], b_t[1]), b23 = cvtpk(b_t[2], b_t[3]), k01 = cvtpk(k_t[0], k_t[1]), k23 = cvtpk(k_t[2], k_t[3]), v01 = cvtpk(xv[0], xv[1]), v23 = cvtpk(xv[2], xv[3]);
            *(LAS u32x2*)(L + O_BT + (t * 72 + 4 * jq) * 2) = (u32x2){b01, b23};
            *(LAS u32x2*)(L + O_KT + (t * 72 + 4 * jq) * 2) = (u32x2){k01, k23};
            *(LAS u32x2*)(L + O_VB + buf * 4608 + (t * 72 + 4 * jq) * 2) = (u32x2){v01, v23};
            if ((t & 15) == 15) *(LAS f32x4*)(L + O_WL + (q * 64 + 4 * jq) * 4) = (f32x4){Wv[0], Wv[1], Wv[2], Wv[3]};
        }
        lds_barrier();
        }
        for (int rp2 = 0; rp2 < (RK2_REP == 2 ? 3 : 1); ++rp2) {
        {
            const int q = wave >> 2, tile = wave & 3;
            const int ao = (tile & 2) ? O_RT : O_AT, bo = (tile & 1) ? O_KT : O_BT;
            f32x4 acc = (f32x4){0.f, 0.f, 0.f, 0.f};
            if (PASS == 1 || tile < 2)
#pragma unroll
            for (int s = 0; s < 2; ++s) { const bf16x8 av = *(const LAS bf16x8*)(L + ao + ((16 * q + fr) * 72 + 32 * s + 8 * fq) * 2), bv = *(const LAS bf16x8*)(L + bo + ((16 * q + fr) * 72 + 32 * s + 8 * fq) * 2);
                acc = RK_MFMA(av, bv, acc); }
#pragma unroll
            for (int r = 0; r < 4; ++r) { const int t = 4 * fq + r; const bool keep = (tile & 2) ? (fr <= t) : (fr < t); const float v = keep ? acc[r] : 0.f;
                if (tile == 0) ((LAS float*)(L + O_NM))[q * 256 + fr * 16 + t] = v;
                else if (tile == 1) ((LAS float*)(L + O_AAK))[q * 256 + t * 16 + fr] = v;
                else if (tile == 2) ((LAS bf16*)(L + O_ARB))[q * 256 + t * 16 + fr] = (bf16)f2bf(v);
                else ((LAS bf16*)(L + O_ARK))[q * 256 + t * 16 + fr] = (bf16)f2bf(v); }
        }
        if (wave < 3 && ch + 1 < SEGLEN / T) { RK2_S1(0); if (ch + 2 < SEGLEN / T && (RK2_REP != 2 || rp2 == 2)) RK2_PREFETCH(0, tseg0 + (ch + 2) * T); }
        lds_barrier();
        }
        for (int rp3 = 0; rp3 < (RK2_REP == 3 ? 3 : 1); ++rp3) {
        if (wave < 2) {
            const int q = wave, j = lane; const LAS float* NT = (const LAS float*)(L + O_NM) + q * 256;
            float X[16];
#pragma unroll
            for (int t = 0; t < 16; ++t) X[t] = ((const LAS float*)(L + O_ATF))[(16 * q + t) * 64 + j];
#pragma unroll
            for (int s = 0; s < 15; ++s) {
#pragma unroll
                for (int t4 = (s + 1) / 4; t4 < 4; ++t4) { const f32x4 n4 = *(const LAS f32x4*)(NT + s * 16 + 4 * t4);
#pragma unroll
                    for (int e = 0; e < 4; ++e) if (4 * t4 + e > s) X[4 * t4 + e] += n4[e] * X[s]; }
            }
#pragma unroll
            for (int t = 0; t < 16; ++t) ((LAS bf16*)(L + O_AH))[(16 * q + t) * 72 + j] = (bf16)f2bf(X[t]);
        } else if (wave == 2) {
            const int q = (lane >> 4) & 1, sc = lane & 15; const LAS float* NT = (const LAS float*)(L + O_NM) + q * 256; const LAS float* Ak = (const LAS float*)(L + O_AAK) + q * 256;
            float X[16];
#pragma unroll
            for (int t = 0; t < 16; ++t) X[t] = Ak[t * 16 + sc];
#pragma unroll
            for (int s = 0; s < 15; ++s) {
#pragma unroll
                for (int t4 = (s + 1) / 4; t4 < 4; ++t4) { const f32x4 n4 = *(const LAS f32x4*)(NT + s * 16 + 4 * t4);
#pragma unroll
                    for (int e = 0; e < 4; ++e) if (4 * t4 + e > s) X[4 * t4 + e] += n4[e] * X[s]; }
            }
            if (lane < 32) {
#pragma unroll
                for (int t = 0; t < 16; ++t) ((LAS bf16*)(L + O_AKH))[q * 256 + t * 16 + sc] = (bf16)f2bf(X[t]); }
        } else if (wave >= 4 && ch + 1 < SEGLEN / T) {
            RK2_S2W(ch + 1);
        }
        if (wave >= 3 && ch + 1 < SEGLEN / T) { RK2_S1(0); if (ch + 2 < SEGLEN / T && (RK2_REP != 3 || rp3 == 2)) RK2_PREFETCH(0, tseg0 + (ch + 2) * T); }
        lds_barrier();
        }
        if (wave >= 4) {
            if (PASS == 1 && ch > 0) { const int t2 = tid - 256; RK2_S7(ch - 1, t2 >> 4, t2 & 15); RK2_S7(ch - 1, 16 + (t2 >> 4), t2 & 15); }
            if (ch + 1 < SEGLEN / T) { RK2_S2A(ch + 1); if (PASS == 1) RK2_S2G(ch + 1); }
        }
        if (wave < 4 || PASS == 0) {
            const bool qpart = wave < 4;
#pragma unroll
            for (int q = 0; q < 2; ++q) {
                bf16x8 Sf[2];
#pragma unroll
                for (int s = 0; s < 2; ++s) Sf[s] = __builtin_bit_cast(bf16x8, (u32x4){cvtpk(Sreg[2 * s][0], Sreg[2 * s][1]), cvtpk(Sreg[2 * s][2], Sreg[2 * s][3]), cvtpk(Sreg[2 * s + 1][0], Sreg[2 * s + 1][1]), cvtpk(Sreg[2 * s + 1][2], Sreg[2 * s + 1][3])});
                const int rowA = (16 * q + fr) * 72;
                f32x4 U = (f32x4){0.f, 0.f, 0.f, 0.f};
#pragma unroll
                for (int s = 0; s < 2; ++s) { const bf16x8 af = mk8(*(const LAS u32x2*)(L + O_AH + (rowA + 32 * s + 4 * fq) * 2), *(const LAS u32x2*)(L + O_AH + (rowA + 32 * s + 16 + 4 * fq) * 2)); U = RK_MFMA(af, Sf[s], U); }
                u32x2 vv = {0u, 0u};
                if (qpart) { vv = tr4(L + O_VB + buf * 4608, 16 * q, i0, fr, fq);
                    const bf16x8 akf = mk8(*(const LAS u32x2*)(L + O_AKH + (q * 256 + fr * 16 + 4 * fq) * 2), (u32x2){0u, 0u}); U = RK_MFMA(akf, mk8(vv, (u32x2){0u, 0u}), U); }
                const bf16x8 UV = mk8((u32x2){cvtpk(U[0], U[1]), cvtpk(U[2], U[3])}, vv);
                if (PASS == 1) {
                    f32x4 Y = (f32x4){0.f, 0.f, 0.f, 0.f};
#pragma unroll
                    for (int s = 0; s < 2; ++s) { const bf16x8 rf = mk8(*(const LAS u32x2*)(L + O_RT + (rowA + 32 * s + 4 * fq) * 2), *(const LAS u32x2*)(L + O_RT + (rowA + 32 * s + 16 + 4 * fq) * 2)); Y = RK_MFMA(rf, Sf[s], Y); }
                    const bf16x8 abf = mk8(*(const LAS u32x2*)(L + O_ARB + (q * 256 + fr * 16 + 4 * fq) * 2), *(const LAS u32x2*)(L + O_ARK + (q * 256 + fr * 16 + 4 * fq) * 2)); Y = RK_MFMA(abf, UV, Y);
#pragma unroll
                    for (int r = 0; r < 4; ++r) ((LAS float*)(L + O_YB + buf * 8192))[(16 * q + 4 * fq + r) * 64 + i0 + fr] = Y[r];
                }
#pragma unroll
                for (int jt = 0; jt < 4; ++jt) {
                    const bf16x8 bkf = mk8(tr4(L + O_BT, 16 * q, 16 * jt, fr, fq), tr4(L + O_KT, 16 * q, 16 * jt, fr, fq));
                    Sreg[jt] = RK_MFMA(bkf, UV, Sreg[jt]);
                    const f32x4 wl = *(const LAS f32x4*)(L + O_WL + (q * 64 + 16 * jt + 4 * fq) * 4);
                    Sreg[jt] = Sreg[jt] * wl;
                }
            }
        }
        lds_barrier();
    }
    if (PASS == 1) { RK2_LANE(); RK2_S7(SEGLEN / T - 1, tid >> 4, tid & 15); }
    if (PASS == 0) {
        RK2_LANE();
        unsigned char* mp = (unsigned char*)(SEGPQ + (size_t)itm * 8192);
        LAS float* Pt = (LAS float*)L;
        if (wave < 4) {
#pragma unroll
            for (int jt = 0; jt < 4; ++jt) *(f32x4*)(mp + ((wave * 4 + jt) * 64 + lane) * 16) = Sreg[jt];
        } else {
#pragma unroll
            for (int jt = 0; jt < 4; ++jt)
#pragma unroll
                for (int r = 0; r < 4; ++r) Pt[(16 * jt + 4 * fq + r) * 65 + i0 + fr] = Sreg[jt][r];
        }
        lds_barrier();
        {
            const int jt = wave >> 1, s = wave & 1; const LAS float* pr = Pt + (16 * jt + fr) * 65 + 32 * s + 4 * fq;
            float p[8];
#pragma unroll
            for (int e = 0; e < 4; ++e) { p[e] = pr[e]; p[4 + e] = pr[16 + e]; }
            unsigned hi[4], lo[4];
#pragma unroll
            for (int e = 0; e < 4; ++e) { hi[e] = cvtpk(p[2 * e], p[2 * e + 1]); lo[e] = cvtpk(p[2 * e] - bf2f(hi[e] & 0xffffu), p[2 * e + 1] - bf2f(hi[e] >> 16)); }
            *(u32x4*)(mp + 16384 + ((jt * 2 + s) * 64 + lane) * 16) = (u32x4){hi[0], hi[1], hi[2], hi[3]};
            *(u32x4*)(mp + 24576 + ((jt * 2 + s) * 64 + lane) * 16) = (u32x4){lo[0], lo[1], lo[2], lo[3]};
        }
    }
    lds_barrier();
#undef RK2_TASK
#undef RK2_SRC
#undef RK2_PREFETCH
#undef RK2_S1
#undef RK2_S2W
#undef RK2_S2A
#undef RK2_S2G
#undef RK2_S7
}
#undef RK_MFMA
#undef RK2_LANE
}

struct LruP { const float *cw, *cb, *wa, *ba, *wx, *bx, *lam; };
__device__ __forceinline__ float gelu_tanh_(float x) { const float u = 0.7978845608028654f * (x + 0.044715f * x * x * x); return 0.5f * x * (1.f + tanhf(u)); }
__device__ __forceinline__ void lru_naive_item(Frame& F, unsigned char* ws, const LruP& P, int b, int blk) {
    LAS float* L = (LAS float*)F.lds;
    LAS float* Lxc = L;
    LAS float* Lwa = L + 4096;
    LAS float* Lwx = L + 8192;
    LAS float* Laa = L + 12288;
    LAS float* Lbb = L + 16384;
    const bf16* ZBX = (const bf16*)(ws + Z_BX); bf16* ZBY = (bf16*)(ws + Z_BY);
    const int tid = F.tid;
    for (int idx = tid; idx < 4096; idx += NTHR) { Lwa[idx] = P.wa[blk * 4096 + idx]; Lwx[idx] = P.wx[blk * 4096 + idx]; }
    float hcar = 0.f;
    for (int tile = 0; tile < SEQ / 64; ++tile) {
        const int t0 = tile * 64;
        __syncthreads();
        for (int idx = tid; idx < 4096; idx += NTHR) {
            const int tt = idx >> 6, c = idx & 63, ch = blk * 64 + c, t = t0 + tt;
            float s = P.cb[ch];
#pragma unroll
            for (int i = 0; i < 4; ++i) { const int ts = t - 3 + i; if (ts >= 0) s += P.cw[i * 512 + ch] * bf2f(ZBX[((size_t)b * SEQ + ts) * 512 + ch]); }
            Lxc[idx] = s;
        }
        __syncthreads();
        for (int idx = tid; idx < 4096; idx += NTHR) {
            const int tt = idx >> 6, j = idx & 63, ch = blk * 64 + j;
            float sa = P.ba[ch], sx = P.bx[ch];
            for (int i = 0; i < 64; ++i) { const float xv = Lxc[tt * 64 + i]; sa += xv * Lwa[i * 64 + j]; sx += xv * Lwx[i * 64 + j]; }
            const float ga = sigmoidf_(sa), gx = sigmoidf_(sx);
            const float log_a = -8.0f * ga * softplusf_(-P.lam[ch]);
            const float a = expf(log_a); float mult = sqrtf(fmaxf(-expm1f(2.f * log_a), 0.f));
            if (t0 + tt == 0) mult = 1.f;
            Laa[idx] = a; Lbb[idx] = Lxc[idx] * gx * mult;
        }
        __syncthreads();
        if (tid < 64) {
            const int ch = blk * 64 + tid;
            for (int tt = 0; tt < 64; ++tt) {
                hcar = Laa[tt * 64 + tid] * hcar + Lbb[tt * 64 + tid];
                const size_t off = ((size_t)b * SEQ + t0 + tt) * 512 + ch;
                ZBY[off] = (bf16)f2bf(hcar * gelu_tanh_(bf2f(ZBY[off])));
            }
        }
    }
    __syncthreads();
}

__device__ __forceinline__ int t5_bucket(int d) {
    if (d < 16) return d;
    int v = 16 + (int)(logf((float)d / 16.f) / logf(128.f) * 16.f);
    return v > 31 ? 31 : v;
}
__device__ __forceinline__ void attn_naive(Frame& F, unsigned char* ws, const float* relb, const float* qg, const float* kg, int worker, int nworkers) {
    LAS float* Lbias = (LAS float*)F.lds;
    for (int idx = F.tid; idx < 12 * 129; idx += NTHR) { const int hd = idx / 129, rel = idx % 129, g = hd >> 2; const int dil = g == 0 ? 1 : (g == 1 ? 4 : 16);
        Lbias[idx] = relb[t5_bucket(rel * dil) * 12 + hd]; }
    __syncthreads();
    bf16* AQ = (bf16*)(ws + A_Q); const bf16* AK = (const bf16*)(ws + A_K); const bf16* AV = (const bf16*)(ws + A_V); float* LSE = (float*)(ws + WS_LSE);
    for (long it2 = (long)worker * NTHR + F.tid; it2 < (long)M * 24; it2 += (long)nworkers * NTHR) {
        const long it = it2 >> 1; const int half = (int)(it2 & 1);
        const int m = (int)(it / 12), hd = (int)(it % 12), g = hd >> 2; const int dil = g == 0 ? 1 : (g == 1 ? 4 : 16);
        const int t = m % SEQ;
        float q[32]; float s2 = 0.f;
        const unsigned* qp = (const unsigned*)(AQ + (size_t)m * 768 + hd * 64 + half * 32);
#pragma unroll
        for (int j = 0; j < 16; ++j) { const unsigned u = qp[j]; q[2 * j] = bf2f(u & 0xffffu); q[2 * j + 1] = bf2f(u >> 16); s2 += q[2 * j] * q[2 * j] + q[2 * j + 1] * q[2 * j + 1]; }
        s2 += shfl_xor_l(s2, 1, F.lane);
        const float qs = (1.f / sqrtf(s2 * (1.f / 64.f) + RMS_EPS)) * 0.125f;
#pragma unroll
        for (int j = 0; j < 32; ++j) q[j] = q[j] * qs * qg[half * 32 + j] * kg[half * 32 + j];
        float o[32];
#pragma unroll
        for (int j = 0; j < 32; ++j) o[j] = 0.f;
        float mx = -1e30f, l = 0.f;
        for (int rel = 0; rel <= 128; ++rel) {
            const int tk = t - rel * dil; if (tk < 0) break;
            const size_t mk = (size_t)(m - rel * dil);
            const unsigned* kp = (const unsigned*)(AK + mk * 768 + hd * 64 + half * 32);
            float dot = 0.f, k2 = 0.f;
#pragma unroll
            for (int j = 0; j < 16; ++j) { const unsigned u = kp[j]; const float k0 = bf2f(u & 0xffffu), k1 = bf2f(u >> 16); dot += q[2 * j] * k0 + q[2 * j + 1] * k1; k2 += k0 * k0 + k1 * k1; }
            dot += shfl_xor_l(dot, 1, F.lane); k2 += shfl_xor_l(k2, 1, F.lane);
            const float logit = dot * (1.f / sqrtf(k2 * (1.f / 64.f) + RMS_EPS)) + Lbias[hd * 129 + rel];
            const float mn = fmaxf(mx, logit); const float sc = __expf(mx - mn), p = __expf(logit - mn);
            l = l * sc + p; mx = mn;
            const unsigned* vp = (const unsigned*)(AV + mk * 768 + hd * 64 + half * 32);
#pragma unroll
            for (int j = 0; j < 16; ++j) { const unsigned u = vp[j]; o[2 * j] = o[2 * j] * sc + p * bf2f(u & 0xffffu); o[2 * j + 1] = o[2 * j + 1] * sc + p * bf2f(u >> 16); }
        }
        const float il = 1.f / l;
        unsigned* op = (unsigned*)(AQ + (size_t)m * 768 + hd * 64 + half * 32);
#pragma unroll
        for (int j = 0; j < 16; ++j) op[j] = f2bf(o[2 * j] * il) | (f2bf(o[2 * j + 1] * il) << 16);
        if (half == 0) LSE[(size_t)m * 12 + hd] = mx + logf(l);
    }
}
namespace at {
typedef short bf16x8 __attribute__((ext_vector_type(8)));
typedef float f32x4 __attribute__((ext_vector_type(4)));
typedef unsigned u32x4 __attribute__((ext_vector_type(4)));
typedef unsigned u32x2 __attribute__((ext_vector_type(2)));
constexpr int O_KL = 0, O_VT = 36864, O_LB = O_VT + 33792, O_QKG = O_LB + 9216, O_END = O_QKG + 256;
#define AT_MFMA(a, b, c) __builtin_amdgcn_mfma_f32_16x16x32_bf16((a), (b), (c), 0, 0, 0)
__device__ __forceinline__ unsigned cvtpk(float lo, float hi) { return pg8::cvt_pk_bf16(lo, hi); }
__device__ __forceinline__ bf16x8 mk8(u32x2 lo, u32x2 hi) { u32x4 v = {lo.x, lo.y, hi.x, hi.y}; return __builtin_bit_cast(bf16x8, v); }
__device__ __forceinline__ float shx(float v, int o, int lane) { return __builtin_bit_cast(float, __builtin_amdgcn_ds_bpermute((lane ^ o) << 2, __builtin_bit_cast(int, v))); }

__device__ __forceinline__ void bias_table(Frame& F, const float* relb, const float* qg, const float* kg) {
    LAS float* Lb = (LAS float*)(F.lds + O_LB);
    if (F.tid < 64) ((LAS float*)(F.lds + O_QKG))[F.tid] = qg[F.tid] * kg[F.tid] * (0.125f * 1.4426950408889634f);
    for (int idx = F.tid; idx < 12 * 192; idx += NTHR) { const int hd = idx / 192, rel = idx - hd * 192 - 32, g = hd >> 2; const int dil = g == 0 ? 1 : (g == 1 ? 4 : 16);
        Lb[idx] = (rel >= 0 && rel <= 128) ? relb[t5_bucket(rel * dil) * 12 + hd] * 1.4426950408889634f : -1e30f; }
    lds_barrier();
}
struct Raw { u32x4 kv[4], v0[2], v1[2], q0, q1; };
struct Idx { int b, hd, dil, r, n; };
__device__ __forceinline__ Idx decode(int it) { Idx x; const int g = it >> 9, rem = it & 511; x.b = rem >> 8; const int hh = (rem >> 6) & 3, rn = rem & 63;
    x.dil = g == 0 ? 1 : (g == 1 ? 4 : 16); const int nb = 64 / x.dil; x.r = rn / nb; x.n = rn - x.r * nb; x.hd = g * 4 + hh; return x; }
__device__ __forceinline__ void load_raw(Raw& R, const unsigned char* ws, const Idx& x, int tid, int wave, int fr, int fq) {
    const bf16* AQ = (const bf16*)(ws + A_Q); const bf16* AK = (const bf16*)(ws + A_K); const bf16* AV = (const bf16*)(ws + A_V);
    const size_t mb = (size_t)x.b * SEQ;
    { const int key = tid >> 1, half = tid & 1; const int u = (x.n - 1) * 128 + key;
#pragma unroll
      for (int e = 0; e < 4; ++e) R.kv[e] = (u32x4){0u, 0u, 0u, 0u};
      if (u >= 0) { const u32x4* kp = (const u32x4*)(AK + (mb + (size_t)u * x.dil + x.r) * 768 + x.hd * 64 + half * 32);
#pragma unroll
        for (int e = 0; e < 4; ++e) R.kv[e] = kp[e]; } }
    { const int kp = tid >> 2, dq = tid & 3; const int u0 = (x.n - 1) * 128 + 2 * kp;
      R.v0[0] = R.v0[1] = R.v1[0] = R.v1[1] = (u32x4){0u, 0u, 0u, 0u};
      if (u0 >= 0) { const u32x4* p0 = (const u32x4*)(AV + (mb + (size_t)u0 * x.dil + x.r) * 768 + x.hd * 64 + dq * 16); const u32x4* p1 = (const u32x4*)(AV + (mb + (size_t)(u0 + 1) * x.dil + x.r) * 768 + x.hd * 64 + dq * 16);
        R.v0[0] = p0[0]; R.v0[1] = p0[1]; R.v1[0] = p1[0]; R.v1[1] = p1[1]; } }
    { const int qi = 16 * wave + fr; const size_t mq = mb + (size_t)(x.n * 128 + qi) * x.dil + x.r;
      R.q0 = *(const u32x4*)(AQ + mq * 768 + x.hd * 64 + 8 * fq); R.q1 = *(const u32x4*)(AQ + mq * 768 + x.hd * 64 + 32 + 8 * fq); }
}
__device__ __forceinline__ void run(Frame& F0, unsigned char* ws, const float* qg, const float* kg, int first, int stride, int nitems) {
    LAS unsigned char* L = F0.lds; const int wave = F0.wave;
    bf16* AQ = (bf16*)(ws + A_Q); float* LSE = (float*)(ws + WS_LSE);
    Raw R;
    { int ln; asm volatile("v_mbcnt_lo_u32_b32 %0, -1, 0\n\tv_mbcnt_hi_u32_b32 %0, -1, %0" : "=v"(ln));
      if (first < nitems) { const Idx x0 = decode(first); load_raw(R, ws, x0, wave * 64 + ln, wave, ln & 15, ln >> 4); } }
#pragma unroll 1
    for (int it = first; it < nitems; it += stride) {
        int lane_c; asm volatile("v_mbcnt_lo_u32_b32 %0, -1, 0\n\tv_mbcnt_hi_u32_b32 %0, -1, %0" : "=v"(lane_c));
        const int lane = lane_c, tid = wave * 64 + lane, fr = lane & 15, fq = lane >> 4;
        const Idx x = decode(it); const int n = x.n, hd = x.hd;
        const size_t mb = (size_t)x.b * SEQ;
        {
            const int key = tid >> 1, half = tid & 1;
            float s2 = 0.f;
#pragma unroll
            for (int e = 0; e < 4; ++e)
#pragma unroll
                for (int c = 0; c < 4; ++c) { const float a0 = bf2f(R.kv[e][c] & 0xffffu), a1 = bf2f(R.kv[e][c] >> 16); s2 += a0 * a0 + a1 * a1; }
            s2 += shx(s2, 1, lane);
            const float rs = __builtin_amdgcn_rsqf(s2 * (1.f / 64.f) + RMS_EPS);
#pragma unroll
            for (int e = 0; e < 4; ++e) { u32x4 o;
#pragma unroll
                for (int c = 0; c < 4; ++c) o[c] = cvtpk(bf2f(R.kv[e][c] & 0xffffu) * rs, bf2f(R.kv[e][c] >> 16) * rs);
                *(LAS u32x4*)(L + O_KL + (key * 72 + half * 32 + e * 8) * 2) = o; }
        }
        {
            const int kp = tid >> 2, dq = tid & 3;
#pragma unroll
            for (int e = 0; e < 2; ++e)
#pragma unroll
                for (int c = 0; c < 4; ++c) { const int d = dq * 16 + e * 8 + c * 2; const unsigned a = R.v0[e][c], bq = R.v1[e][c];
                    *(LAS unsigned*)(L + O_VT + (d * 264 + 2 * kp) * 2) = (a & 0xffffu) | (bq << 16);
                    *(LAS unsigned*)(L + O_VT + ((d + 1) * 264 + 2 * kp) * 2) = (a >> 16) | (bq & 0xffff0000u); }
        }
        const int qi = 16 * wave + fr; const size_t mq = mb + (size_t)(n * 128 + qi) * x.dil + x.r;
        bf16x8 qf[2];
        {
            const u32x4 q0 = R.q0, q1 = R.q1;
            float s2 = 0.f;
#pragma unroll
            for (int c = 0; c < 4; ++c) { const float a0 = bf2f(q0[c] & 0xffffu), a1 = bf2f(q0[c] >> 16), b0 = bf2f(q1[c] & 0xffffu), b1 = bf2f(q1[c] >> 16); s2 += (a0 * a0 + a1 * a1) + (b0 * b0 + b1 * b1); }
            s2 += shx(s2, 16, lane); s2 += shx(s2, 32, lane);
            const float rs = __builtin_amdgcn_rsqf(s2 * (1.f / 64.f) + RMS_EPS);
            const LAS float* qk = (const LAS float*)(L + O_QKG) + 8 * fq;
            const f32x4 g0 = *(const LAS f32x4*)qk, g1 = *(const LAS f32x4*)(qk + 4), g2 = *(const LAS f32x4*)(qk + 32), g3 = *(const LAS f32x4*)(qk + 36);
            u32x4 o0, o1;
#pragma unroll
            for (int c = 0; c < 4; ++c) { const float ga = c < 2 ? g0[2 * c] : g1[2 * c - 4], gb = c < 2 ? g0[2 * c + 1] : g1[2 * c - 3], gc = c < 2 ? g2[2 * c] : g3[2 * c - 4], gd = c < 2 ? g2[2 * c + 1] : g3[2 * c - 3];
                o0[c] = cvtpk(bf2f(q0[c] & 0xffffu) * rs * ga, bf2f(q0[c] >> 16) * rs * gb);
                o1[c] = cvtpk(bf2f(q1[c] & 0xffffu) * rs * gc, bf2f(q1[c] >> 16) * rs * gd); }
            qf[0] = __builtin_bit_cast(bf16x8, o0); qf[1] = __builtin_bit_cast(bf16x8, o1);
        }
        lds_barrier();
        if (it + stride < nitems) { const Idx xn = decode(it + stride); load_raw(R, ws, xn, tid, wave, fr, fq); }
        const int kt0 = wave & ~1;
        f32x4 sc[10];
#pragma unroll
        for (int j = 0; j < 10; ++j) { sc[j] = (f32x4){0.f, 0.f, 0.f, 0.f};
#pragma unroll
            for (int s = 0; s < 2; ++s) { const bf16x8 kf = *(const LAS bf16x8*)(L + O_KL + (((kt0 + j) * 16 + fr) * 72 + 32 * s + 8 * fq) * 2); sc[j] = AT_MFMA(kf, qf[s], sc[j]); } }
        const LAS float* Lb = (const LAS float*)(L + O_LB) + hd * 192 + (qi + 160 - kt0 * 16 - 4 * fq);
        float mx = -1e30f;
#pragma unroll
        for (int j = 0; j < 10; ++j)
#pragma unroll
            for (int rr = 0; rr < 4; ++rr) sc[j][rr] += Lb[-(16 * j + rr)];
        if (n == 0) {
#pragma unroll
            for (int j = 0; j < 10; ++j)
#pragma unroll
                for (int rr = 0; rr < 4; ++rr) if ((kt0 + j) * 16 + 4 * fq + rr < 128) sc[j][rr] = -1e30f; }
#pragma unroll
        for (int j = 0; j < 10; ++j)
#pragma unroll
            for (int rr = 0; rr < 4; ++rr) mx = fmaxf(mx, sc[j][rr]);
        mx = fmaxf(mx, shx(mx, 16, lane)); mx = fmaxf(mx, shx(mx, 32, lane));
        float l = 0.f;
#pragma unroll
        for (int j = 0; j < 10; ++j)
#pragma unroll
            for (int rr = 0; rr < 4; ++rr) { const float p = __builtin_amdgcn_exp2f(sc[j][rr] - mx); sc[j][rr] = p; l += p; }
        l += shx(l, 16, lane); l += shx(l, 32, lane);
        f32x4 oc[4];
#pragma unroll
        for (int dt = 0; dt < 4; ++dt) oc[dt] = (f32x4){0.f, 0.f, 0.f, 0.f};
#pragma unroll
        for (int s = 0; s < 5; ++s) {
            const bf16x8 pf = mk8((u32x2){cvtpk(sc[2 * s][0], sc[2 * s][1]), cvtpk(sc[2 * s][2], sc[2 * s][3])}, (u32x2){cvtpk(sc[2 * s + 1][0], sc[2 * s + 1][1]), cvtpk(sc[2 * s + 1][2], sc[2 * s + 1][3])});
            const int key0 = (kt0 + 2 * s) * 16 + 4 * fq;
#pragma unroll
            for (int dt = 0; dt < 4; ++dt) { const bf16x8 vf = mk8(*(const LAS u32x2*)(L + O_VT + ((16 * dt + fr) * 264 + key0) * 2), *(const LAS u32x2*)(L + O_VT + ((16 * dt + fr) * 264 + key0 + 16) * 2)); oc[dt] = AT_MFMA(vf, pf, oc[dt]); }
        }
        const float il = __builtin_amdgcn_rcpf(l);
#pragma unroll
        for (int dt = 0; dt < 4; ++dt) *(u32x2*)(AQ + mq * 768 + hd * 64 + 16 * dt + 4 * fq) = (u32x2){cvtpk(oc[dt][0] * il, oc[dt][1] * il), cvtpk(oc[dt][2] * il, oc[dt][3] * il)};
        if (fq == 0) LSE[mq * 12 + hd] = (mx + __builtin_amdgcn_logf(l)) * 0.6931471805599453f;
        lds_barrier();
    }
}
#undef AT_MFMA
}

namespace lr {
typedef short bf16x8 __attribute__((ext_vector_type(8)));
typedef float f32x4 __attribute__((ext_vector_type(4)));
typedef float f32x2 __attribute__((ext_vector_type(2)));
typedef unsigned u32x4 __attribute__((ext_vector_type(4)));
constexpr int O_WAT = 0, O_WXT = 9216, O_XCF = 18432, O_XCB = O_XCF + 16384, O_AF = O_XCB + 9216, O_BF = O_AF + 16384, O_VEC = O_BF + 16384, O_FOLD = O_VEC + 2048, O_HC = O_FOLD + 4096, O_END = O_HC + 256;
constexpr int V_CW = 0, V_CB = 256, V_BA = 320, V_BX = 384, V_SPL = 448;
__device__ __forceinline__ float gelu_fast(float x) { const float u = 0.7978845608028654f * (x + 0.044715f * x * x * x); return x * (1.f - __builtin_amdgcn_rcpf(1.f + __expf(2.f * u))); }
#define LR_MFMA(a, b, c) __builtin_amdgcn_mfma_f32_16x16x32_bf16((a), (b), (c), 0, 0, 0)
template <int PASS>
__device__ __forceinline__ void item(Frame& F, unsigned char* ws, const LruP& P, int b, int blk, int tg) {
    LAS unsigned char* L = F.lds;
    const int wave = F.wave;
    LAS float* VEC = (LAS float*)(L + O_VEC);
    const bf16* ZBX = (const bf16*)(ws + Z_BX); bf16* ZBY = (bf16*)(ws + Z_BY);
    f32x2* AGG = (f32x2*)(ws + WS_LRUAGG);
    {
        const int tid = F.tid, j = tid & 63, ig = tid >> 6;
        float va[8], vx[8];
#pragma unroll
        for (int e = 0; e < 8; ++e) { va[e] = P.wa[blk * 4096 + (ig * 8 + e) * 64 + j]; vx[e] = P.wx[blk * 4096 + (ig * 8 + e) * 64 + j]; }
        *(LAS u32x4*)(L + O_WAT + (j * 72 + ig * 8) * 2) = (u32x4){pg8::cvt_pk_bf16(va[0], va[1]), pg8::cvt_pk_bf16(va[2], va[3]), pg8::cvt_pk_bf16(va[4], va[5]), pg8::cvt_pk_bf16(va[6], va[7])};
        *(LAS u32x4*)(L + O_WXT + (j * 72 + ig * 8) * 2) = (u32x4){pg8::cvt_pk_bf16(vx[0], vx[1]), pg8::cvt_pk_bf16(vx[2], vx[3]), pg8::cvt_pk_bf16(vx[4], vx[5]), pg8::cvt_pk_bf16(vx[6], vx[7])};
        if (tid < 64) { const int ch = blk * 64 + tid;
#pragma unroll
            for (int i = 0; i < 4; ++i) VEC[V_CW + i * 64 + tid] = P.cw[i * 512 + ch];
            VEC[V_CB + tid] = P.cb[ch]; VEC[V_BA + tid] = P.ba[ch]; VEC[V_BX + tid] = P.bx[ch]; VEC[V_SPL + tid] = softplusf_(-P.lam[ch]); }
    }
    float hcar = 0.f;
    if (PASS == 1) {
        const int c = F.lane; float A = 1.f, B = 0.f;
        f32x2 abv[15];
#pragma unroll
        for (int k = 0; k < 15; ++k) { abv[k] = (f32x2){1.f, 0.f}; if (k < tg) abv[k] = AGG[((size_t)b * 128 + wave * tg + k) * 512 + blk * 64 + c]; }
#pragma unroll
        for (int k = 0; k < 15; ++k) { B = abv[k].x * B + abv[k].y; A = abv[k].x * A; }
        ((LAS f32x2*)(L + O_FOLD))[wave * 64 + c] = (f32x2){A, B};
        lds_barrier();
        if (wave == 0) {
#pragma unroll
            for (int w = 0; w < 8; ++w) { const f32x2 ab = ((LAS f32x2*)(L + O_FOLD))[w * 64 + c]; hcar = ab.x * hcar + ab.y; } }
    }
    if (wave == 0) ((LAS float*)(L + O_HC))[F.lane] = hcar;
    u32x4 xq[4], yq = {0u, 0u, 0u, 0u};
#define LR_LOAD(TILE, TID) do { const int tt_ = (TID) >> 3, c8_ = ((TID) & 7) * 8, t0_ = (TILE) * 64; \
        _Pragma("unroll") for (int i = 0; i < 4; ++i) { const int ts = t0_ + tt_ - 3 + i; xq[i] = (u32x4){0u, 0u, 0u, 0u}; if (ts >= 0) xq[i] = *(const u32x4*)(ZBX + ((size_t)b * SEQ + ts) * 512 + blk * 64 + c8_); } \
        if (PASS == 1) yq = *(const u32x4*)(ZBY + ((size_t)b * SEQ + t0_ + tt_) * 512 + blk * 64 + c8_); } while (0)
    { int ln; asm volatile("v_mbcnt_lo_u32_b32 %0, -1, 0\n\tv_mbcnt_hi_u32_b32 %0, -1, %0" : "=v"(ln)); LR_LOAD(tg * 8, wave * 64 + ln); }
    lds_barrier();
#pragma unroll 1
    for (int tl = 0; tl < 8; ++tl) {
        int lane_c; asm volatile("v_mbcnt_lo_u32_b32 %0, -1, 0\n\tv_mbcnt_hi_u32_b32 %0, -1, %0" : "=v"(lane_c));
        const int lane = lane_c, tid = wave * 64 + lane, fr = lane & 15, fq = lane >> 4;
        const int tile = tg * 8 + tl, t0 = tile * 64; const size_t m0 = (size_t)b * SEQ + t0;
        const u32x4 yv = yq;
        {
            const int tt = tid >> 3, c8 = (tid & 7) * 8; float acc[8];
#pragma unroll
            for (int e = 0; e < 8; ++e) acc[e] = VEC[V_CB + c8 + e];
#pragma unroll
            for (int i = 0; i < 4; ++i) { const u32x4 xv = xq[i];
#pragma unroll
                    for (int c = 0; c < 4; ++c) { acc[2 * c] += VEC[V_CW + i * 64 + c8 + 2 * c] * bf2f(xv[c] & 0xffffu); acc[2 * c + 1] += VEC[V_CW + i * 64 + c8 + 2 * c + 1] * bf2f(xv[c] >> 16); } }
            if (tl + 1 < 8) LR_LOAD(tile + 1, tid);
            *(LAS f32x4*)(L + O_XCF + (tt * 64 + c8) * 4) = (f32x4){acc[0], acc[1], acc[2], acc[3]}; *(LAS f32x4*)(L + O_XCF + (tt * 64 + c8 + 4) * 4) = (f32x4){acc[4], acc[5], acc[6], acc[7]};
            *(LAS u32x4*)(L + O_XCB + (tt * 72 + c8) * 2) = (u32x4){pg8::cvt_pk_bf16(acc[0], acc[1]), pg8::cvt_pk_bf16(acc[2], acc[3]), pg8::cvt_pk_bf16(acc[4], acc[5]), pg8::cvt_pk_bf16(acc[6], acc[7])};
        }
        lds_barrier();
        {
            const int nt = wave & 3, mh = wave >> 2, jn = 16 * nt + fr;
            f32x4 ga[2], gx[2];
#pragma unroll
            for (int mm = 0; mm < 2; ++mm) { ga[mm] = (f32x4){0.f, 0.f, 0.f, 0.f}; gx[mm] = ga[mm]; }
#pragma unroll
            for (int s = 0; s < 2; ++s) { const bf16x8 wa = *(const LAS bf16x8*)(L + O_WAT + (jn * 72 + 32 * s + 8 * fq) * 2), wx = *(const LAS bf16x8*)(L + O_WXT + (jn * 72 + 32 * s + 8 * fq) * 2);
#pragma unroll
                for (int mm = 0; mm < 2; ++mm) { const bf16x8 xa = *(const LAS bf16x8*)(L + O_XCB + ((16 * (2 * mh + mm) + fr) * 72 + 32 * s + 8 * fq) * 2); ga[mm] = LR_MFMA(xa, wa, ga[mm]); gx[mm] = LR_MFMA(xa, wx, gx[mm]); } }
            const float ba = VEC[V_BA + jn], bx = VEC[V_BX + jn], spl = VEC[V_SPL + jn];
#pragma unroll
            for (int mm = 0; mm < 2; ++mm)
#pragma unroll
                for (int r = 0; r < 4; ++r) { const int tt = 16 * (2 * mh + mm) + 4 * fq + r;
                    const float xc = ((LAS float*)(L + O_XCF))[tt * 64 + jn];
                    const float g_a = __builtin_amdgcn_rcpf(1.f + __expf(-(ga[mm][r] + ba))), g_x = __builtin_amdgcn_rcpf(1.f + __expf(-(gx[mm][r] + bx)));
                    const float log_a = -8.0f * g_a * spl; const float a = __expf(log_a); float mult = __builtin_amdgcn_sqrtf(fmaxf(1.f - a * a, 0.f));
                    if (t0 + tt == 0) mult = 1.f;
                    ((LAS float*)(L + O_AF))[tt * 64 + jn] = a; ((LAS float*)(L + O_BF))[tt * 64 + jn] = xc * g_x * mult; }
        }
        lds_barrier();
        {
            float al[8], hl[8]; float A = 1.f, B = 0.f;
#pragma unroll
            for (int k = 0; k < 8; ++k) { const int tt = 8 * wave + k; const float a = ((LAS float*)(L + O_AF))[tt * 64 + lane]; B = a * B + ((LAS float*)(L + O_BF))[tt * 64 + lane]; A *= a; al[k] = A; hl[k] = B; }
            ((LAS f32x2*)(L + O_FOLD))[wave * 64 + lane] = (f32x2){A, B};
            lds_barrier();
            float hin = ((LAS float*)(L + O_HC))[lane];
            float At = 1.f;
#pragma unroll
            for (int w = 0; w < 8; ++w) { const f32x2 ab = ((LAS f32x2*)(L + O_FOLD))[w * 64 + lane]; if (w < wave) hin = ab.x * hin + ab.y; At *= ab.x; }
            if (PASS == 0) {
                if (wave == 7) { const float Bt = al[7] * hin + hl[7];
                    AGG[((size_t)b * 128 + tile) * 512 + blk * 64 + lane] = (f32x2){At, Bt}; }
            } else {
#pragma unroll
                for (int k = 0; k < 8; ++k) ((LAS float*)(L + O_BF))[(8 * wave + k) * 64 + lane] = al[k] * hin + hl[k];
                if (wave == 7) hcar = al[7] * hin + hl[7];
            }
        }
        lds_barrier();
        if (PASS == 1 && wave == 7) ((LAS float*)(L + O_HC))[lane] = hcar;
        if (PASS == 1) {
            const int tt = tid >> 3, c8 = (tid & 7) * 8; bf16* yp = ZBY + (m0 + tt) * 512 + blk * 64 + c8;
            const f32x4 h0 = *(const LAS f32x4*)(L + O_BF + (tt * 64 + c8) * 4), h1 = *(const LAS f32x4*)(L + O_BF + (tt * 64 + c8 + 4) * 4);
            u32x4 o;
#pragma unroll
            for (int c = 0; c < 4; ++c) { const float hA = c < 2 ? h0[2 * c] : h1[2 * c - 4], hB = c < 2 ? h0[2 * c + 1] : h1[2 * c - 3];
                o[c] = pg8::cvt_pk_bf16(hA * gelu_fast(bf2f(yv[c] & 0xffffu)), hB * gelu_fast(bf2f(yv[c] >> 16))); }
            *(u32x4*)yp = o;
            lds_barrier();
        }
    }
}
#undef LR_MFMA
#undef LR_LOAD
}

__device__ __forceinline__ void phase_combine(Frame& F, unsigned char* ws) {
    typedef unsigned u32x4c __attribute__((ext_vector_type(4)));
    const bf16* AQ = (const bf16*)(ws + A_Q); const float* LSE = (const float*)(ws + WS_LSE); bf16* OC = (bf16*)(ws + WS_OC);
    const int stride = F.G * NTHR;
    for (int it0 = F.vcu * NTHR + F.tid; it0 < M * 32; it0 += 4 * stride) {
        float l0[4], l1[4], l2[4]; u32x4c a0[4], a1[4], a2[4];
#pragma unroll
        for (int u = 0; u < 4; ++u) { const int it = it0 + u * stride; if (it < M * 32) { const int m = it >> 5, c8 = (it & 31) * 8, hh = c8 >> 6;
            l0[u] = LSE[(size_t)m * 12 + hh]; l1[u] = LSE[(size_t)m * 12 + 4 + hh]; l2[u] = LSE[(size_t)m * 12 + 8 + hh];
            a0[u] = *(const u32x4c*)(AQ + (size_t)m * 768 + c8); a1[u] = *(const u32x4c*)(AQ + (size_t)m * 768 + 256 + c8); a2[u] = *(const u32x4c*)(AQ + (size_t)m * 768 + 512 + c8); } }
#pragma unroll
        for (int u = 0; u < 4; ++u) { const int it = it0 + u * stride; if (it < M * 32) { const int m = it >> 5, c8 = (it & 31) * 8;
            const float mx = fmaxf(l0[u], fmaxf(l1[u], l2[u])); float e0 = __expf(l0[u] - mx), e1 = __expf(l1[u] - mx), e2 = __expf(l2[u] - mx); const float inv = 1.f / (e0 + e1 + e2);
            e0 *= inv; e1 *= inv; e2 *= inv;
            u32x4c o;
#pragma unroll
            for (int c = 0; c < 4; ++c) o[c] = pg8::cvt_pk_bf16(e0 * bf2f(a0[u][c] & 0xffffu) + e1 * bf2f(a1[u][c] & 0xffffu) + e2 * bf2f(a2[u][c] & 0xffffu), e0 * bf2f(a0[u][c] >> 16) + e1 * bf2f(a1[u][c] >> 16) + e2 * bf2f(a2[u][c] >> 16));
            *(u32x4c*)(OC + (size_t)m * 256 + c8) = o; } }
    }
}

constexpr int LDS_BYTES = 163840, LDSCTL_OFF = LDS_BYTES - 512, MISC_OFF = LDSCTL_OFF + 64;
constexpr int PH_PER_LAYER = 10, NPHASES = DEPTH * PH_PER_LAYER;

template <int PH>
__global__ void __launch_bounds__(NTHR, 2) fwd_kernel(Args args) {
    extern __shared__ __attribute__((aligned(16))) unsigned char lds[];
    Frame F0;
    F0.lds = (LAS unsigned char*)lds;
    F0.tid = 0; F0.lane = 0; F0.wave = __builtin_amdgcn_readfirstlane((int)threadIdx.x >> 6);
    F0.bid = blockIdx.x; F0.G = gridDim.x; { const int bx = blockIdx.x; F0.vcu = (F0.G % 8 == 0) ? (bx % 8) * (F0.G / 8) + bx / 8 : bx; }
    unsigned char* ws = args.ws;
    volatile LAS unsigned* MISC = (volatile LAS unsigned*)(F0.lds + MISC_OFF);
    for (int u = threadIdx.x; u < (LDS_BYTES - LDSCTL_OFF) / 4; u += NTHR) ((LAS unsigned*)(F0.lds + LDSCTL_OFF))[u] = 0u;
    __syncthreads();
    XcdBarrier bar; bar.bar = (unsigned*)(ws + WS_CTL) + CW_BAR; bar.x = 0; bar.st = nullptr;
    if (MK_ONE_LAUNCH) bar = xcd_barrier_post((unsigned*)(ws + WS_CTL) + CW_BAR, MISC + 8);
    const int lo = args.ph_lo, hi = args.ph_hi;
#define IN(k) ((PH < 0 || PH == ((k) % PH_PER_LAYER)) && lo <= (k) && (k) < hi)
#define SEAM(k) do { if (MK_ONE_LAUNCH && IN(k) && IN((k) + 1)) { for (int rb_ = 0; rb_ < REP_BAR; ++rb_) xcd_barrier(bar); } } while (0)

#define PHASE(k) if constexpr (PH < 0 || PH == (k)) if (IN(pb + (k)))
#define PHASE_BEGIN Frame F = phase_frame(F0); unsigned char* ws = launder(args.ws); float* outp = launder(args.out); (void)outp; float* ssb = (float*)(ws + WS_CTL + WS_SS); (void)ssb;
#pragma unroll 1
    for (int l = 0; l < DEPTH; ++l) {
        const int pb = l * PH_PER_LAYER;
        const float* xin = (l == 0) ? args.in[I_X] : args.out;
        if (l == 0) { PHASE(0) { PHASE_BEGIN phase_x2bf(F, launder(args.in[I_X]), (bf16*)(ws + WS_XB), ssb); for (int i = F.vcu * NTHR + F.tid; i < 3 * M; i += F.G * NTHR) ssb[M + i] = 0.f;     convert_wb1(F, args, 0, ws); } SEAM(pb + 0); }
        PHASE(1) { { PHASE_BEGIN rk::lora_inputs<0>(F, ws, launder(args.in[I_MU] + l * 1824), launder((const float*)ssb + (size_t)(2 * l) * M)); __syncthreads(); }
          PHASE_BEGIN pg8::Gemm g{(const bf16*)(ws + WS_XB), (const bf16*)(ws + WS_WMIX), M, 5120, D}; pg8::EpiMixMF E{ws, (const LAS float*)(F.lds + 131072)};
            for (int rep = 0; rep < REP_MIX; ++rep) { Frame Fr = phase_frame(F0); pg8::RstdOrder S; S.init(M, 5120, Fr.G, Fr.bid); S.ss = ssb + (size_t)(2 * l) * M; S.tab = (LAS float*)(Fr.lds + 131072); S.tid = Fr.tid;
                pg8::gemm_phase<pg8::EpiMixMF, pg8::RstdOrder, true, true, true>(Fr.lds, g, S, E, Fr.tid); } } SEAM(pb + 1);
        PHASE(2) { PHASE_BEGIN
            RwkvP P{args.in[I_MU] + l * 1824, args.in[I_W0] + l * 512, args.in[I_WUP] + l * 64 * 512, args.in[I_A0] + l * 512, args.in[I_AUP] + l * 64 * 512, args.in[I_GUP] + l * 160 * 512,
                    args.in[I_KK] + l * 512, args.in[I_KA] + l * 512, args.in[I_RK] + l * 512, args.in[I_LNG] + l * 512, args.in[I_LNB] + l * 512};
            LruP PL{args.in[I_CW] + l * 4 * 512, args.in[I_CB] + l * 512, args.in[I_LWA] + l * 8 * 4096, args.in[I_LBA] + l * 512, args.in[I_LWX] + l * 8 * 4096, args.in[I_LBX] + l * 512, args.in[I_LAM] + l * 512};
            { Frame Fi = phase_frame(F); rk::lora_inputs<1>(Fi, launder(ws), launder(P.mu), launder((const float*)ssb + (size_t)(2 * l) * M)); }
            xcd_barrier(bar);
            for (int rep = 0; rep < REP_RWKV; ++rep) for (int it = F.vcu; it < 256; it += F.G) { Frame Fi = phase_frame(F); rk2::item<0>(Fi, launder(ws), P, it >> 7, (it >> 4) & 7, it & 15); }
            for (int rep = 0; rep < REP_LRUA; ++rep) for (int it = F.vcu; it < 256; it += F.G) { Frame Fi = phase_frame(F); lr::item<0>(Fi, launder(ws), PL, it >> 7, (it >> 4) & 7, it & 15); }
            { Frame Fi = phase_frame(F); at::bias_table(Fi, launder(args.in[I_RELB]), launder(args.in[I_QG] + l * 64), launder(args.in[I_KG] + l * 64)); }
            { Frame Fi = phase_frame(F); at::run(Fi, launder(ws), launder(args.in[I_QG] + l * 64), launder(args.in[I_KG] + l * 64), Fi.vcu, Fi.G, 1536); }
        } SEAM(pb + 2);
        PHASE(3) { PHASE_BEGIN
            { RwkvP P{args.in[I_MU] + l * 1824, args.in[I_W0] + l * 512, args.in[I_WUP] + l * 64 * 512, args.in[I_A0] + l * 512, args.in[I_AUP] + l * 64 * 512, args.in[I_GUP] + l * 160 * 512,
                    args.in[I_KK] + l * 512, args.in[I_KA] + l * 512, args.in[I_RK] + l * 512, args.in[I_LNG] + l * 512, args.in[I_LNB] + l * 512};
              for (int rep = 0; rep < REP_RWKV; ++rep) for (int it = F.vcu; it < 256; it += F.G) { Frame Fi = phase_frame(F); rk2::item<1>(Fi, launder(ws), P, it >> 7, (it >> 4) & 7, it & 15); } }
            { LruP PL{args.in[I_CW] + l * 4 * 512, args.in[I_CB] + l * 512, args.in[I_LWA] + l * 8 * 4096, args.in[I_LBA] + l * 512, args.in[I_LWX] + l * 8 * 4096, args.in[I_LBX] + l * 512, args.in[I_LAM] + l * 512};
              for (int it = F.vcu; it < 256; it += F.G) { Frame Fi = phase_frame(F); lr::item<1>(Fi, launder(ws), PL, it >> 7, (it >> 4) & 7, it & 15); } }
            phase_combine(F, ws); } SEAM(pb + 3);
        PHASE(5) { for (int rep = 0; rep < (REP_PH == 5 ? 2 : 1); ++rep) {
            Frame Fa = phase_frame(F0); unsigned char* wsa = launder(args.ws); pg8::StaticOrder S; S.init(M, D, Fa.G, Fa.bid); pg8::Unit u;
            if (S.next(0, u)) {
                pg8::MergeDisp Dp{(const char*)(wsa + WS_XB), (const char*)(wsa + WS_WG), (const char*)wsa, (const char*)(wsa + WS_PA),
                                  (bf16*)(wsa + WS_GSCR), (bf16*)(wsa + WS_MERGED), (const float*)(wsa + WS_CTL + WS_SS) + (size_t)(2 * l) * M, (LAS float*)(Fa.lds + 131072), Fa.tid};
                pg8::gemm_seq<pg8::MergeDisp>(Fa.lds, Dp, 6, u.pm, u.pn, Fa.tid); }
        } } SEAM(pb + 5);
        PHASE(6) { { PHASE_BEGIN convert_wb2(F, args, l, ws); __syncthreads(); }
            { PHASE_BEGIN pg8::Gemm g{(const bf16*)(ws + WS_MERGED), (const bf16*)(ws + WS_WOUT), M, D, D}; pg8::StaticOrder S; S.init(M, D, F.G, F.bid); pg8::EpiResH E{nullptr, (const bf16*)(ws + WS_XB), (bf16*)(ws + WS_XB), nullptr, ssb + (size_t)(2 * l + 1) * M};
              if (REP_PH == 6) { pg8::EpiResH Ed = E; Ed.dry = true; Frame Fr = phase_frame(F0); pg8::gemm_phase<pg8::EpiResH, pg8::StaticOrder, true, true>(Fr.lds, g, S, Ed, Fr.tid); }
              { Frame Fr = phase_frame(F0); pg8::gemm_phase<pg8::EpiResH, pg8::StaticOrder, true, true>(Fr.lds, g, S, E, Fr.tid); } } } SEAM(pb + 6);
        PHASE(8) { if (l + 1 < DEPTH) { PHASE_BEGIN convert_wb1(F, args, l + 1, ws); __syncthreads(); }
            { PHASE_BEGIN pg8::Gemm g{(const bf16*)(ws + WS_XB), (const bf16*)(ws + WS_WUP), M, FF, D}; pg8::EpiActMF<2> E{(bf16*)(ws + WS_HID), FF, (const LAS float*)(F.lds + 131072)};
              for (int rep = 0; rep < (REP_PH == 8 ? 2 : 1); ++rep) { Frame Fr = phase_frame(F0); pg8::RstdOrder S; S.init(M, FF, Fr.G, Fr.bid); S.ss = ssb + (size_t)(2 * l + 1) * M; S.tab = (LAS float*)(Fr.lds + 131072); S.tid = Fr.tid;
                pg8::gemm_phase<pg8::EpiActMF<2>, pg8::RstdOrder, true, true, true>(Fr.lds, g, S, E, Fr.tid); } } } SEAM(pb + 8);
        PHASE(9) { PHASE_BEGIN pg8::Gemm g{(const bf16*)(ws + WS_HID), (const bf16*)(ws + WS_WDOWN), M, D, FF}; pg8::StaticOrder S; S.init(M, D, F.G, F.bid);
            pg8::EpiResH E{nullptr, (const bf16*)(ws + WS_XB), (l + 1 < DEPTH) ? (bf16*)(ws + WS_XB) : nullptr, (l + 1 < DEPTH) ? nullptr : outp, (l + 1 < DEPTH) ? ssb + (size_t)(2 * l + 2) * M : nullptr};
            if (REP_PH == 9) { pg8::EpiResH Ed = E; Ed.dry = true; Frame Fr = phase_frame(F0); pg8::gemm_phase<pg8::EpiResH, pg8::StaticOrder, true, true>(Fr.lds, g, S, Ed, Fr.tid); }
            { Frame Fr = phase_frame(F0); pg8::gemm_phase<pg8::EpiResH, pg8::StaticOrder, true, true>(Fr.lds, g, S, E, Fr.tid); } }
        if (l + 1 < DEPTH) SEAM(pb + 9);
    }
#undef PHASE
#undef PHASE_BEGIN
#undef IN
#undef SEAM
}

extern "C" void kernel_launch(void* const* d_in, const int* in_sizes, int n_in, void* d_out, int out_size, void* d_ws, size_t ws_size, hipStream_t stream) {
    static int grid = 0;
    if (grid == 0) {
        if (n_in != 31 || in_sizes[0] != M * D || out_size != M * D || ws_size < WS_END) { fprintf(stderr, "kernel_launch: unexpected shapes (n_in %d, in0 %d, out %d, ws %zu); nothing launched\n", n_in, n_in > 0 ? in_sizes[0] : -1, out_size, ws_size); grid = -1; return; }
        int dev = 0, cus = 0;
        if (hipGetDevice(&dev) != hipSuccess || hipDeviceGetAttribute(&cus, hipDeviceAttributeMultiprocessorCount, dev) != hipSuccess) { grid = -1; return; }
        bool okattr = true;
#define SETATTR(P) okattr = okattr && (hipFuncSetAttribute((const void*)fwd_kernel<P>, hipFuncAttributeMaxDynamicSharedMemorySize, LDS_BYTES) == hipSuccess)
#if MK_ONE_LAUNCH
        SETATTR(-1);
#else
        SETATTR(0); SETATTR(1); SETATTR(2); SETATTR(3); SETATTR(4); SETATTR(5); SETATTR(6); SETATTR(7); SETATTR(8); SETATTR(9);
#endif
        if (!okattr) { fprintf(stderr, "kernel_launch: hipFuncSetAttribute failed\n"); grid = -1; return; }
        (void)hipGetLastError();
        grid = cus;
    }
    if (grid < 0) return;
    if (hipMemsetAsync((char*)d_ws + WS_CTL, 0, CTL_ZERO_BYTES, stream) != hipSuccess) return;
    Args a{};
    for (int i = 0; i < 31; ++i) a.in[i] = (const float*)d_in[i];
    a.out = (float*)d_out; a.ws = (unsigned char*)d_ws;
#if MK_ONE_LAUNCH
    {
        a.ph_lo = 0; a.ph_hi = NPHASES;
        hipLaunchKernelGGL(fwd_kernel<-1>, dim3(grid), dim3(NTHR), LDS_BYTES, stream, a);
    }
#else
    {
#define LAUNCH(P) case P: hipLaunchKernelGGL(fwd_kernel<P>, dim3(grid), dim3(NTHR), LDS_BYTES, stream, a); break;
        for (int p = 0; p < NPHASES; ++p) { a.ph_lo = p; a.ph_hi = p + 1;
            switch (p % PH_PER_LAYER) { LAUNCH(0) LAUNCH(1) LAUNCH(2) LAUNCH(3) LAUNCH(4) LAUNCH(5) LAUNCH(6) LAUNCH(7) LAUNCH(8) LAUNCH(9) } }
    }
#endif
}
```

```cpp
#include <hip/hip_runtime.h>
#include <cstdio>
#include <cstdint>

#ifndef USE_MFMA
#define USE_MFMA 0x372
#endif
#define MF(k) ((USE_MFMA >> (k)) & 1)
#ifndef FAST_RWKV
#define FAST_RWKV 1
#endif
#ifndef FAST_ATTN
#define FAST_ATTN 1
#endif
#ifndef FAST_LRU
#define FAST_LRU 1
#endif
#ifndef RK_REP
#define RK_REP 0
#endif
#ifndef RK2_REP
#define RK2_REP 0
#endif
#ifndef REP_RWKV
#define REP_RWKV 1
#endif
#ifndef REP_LRUA
#define REP_LRUA 1
#endif
#ifndef REP_ATTN
#define REP_ATTN 1
#endif
#ifndef REP_BAR
#define REP_BAR 1
#endif
#ifndef REP_PH
#define REP_PH -1
#endif
#ifndef REP_MIX
#define REP_MIX 1
#endif
#ifndef REP_RMS
#define REP_RMS 1
#endif
#ifndef MK_ONE_LAUNCH
#define MK_ONE_LAUNCH 1
#endif

constexpr int BATCH = 2, SEQ = 8192, D = 1024, M = BATCH * SEQ, DEPTH = 2;
constexpr int DIN = 8224, FF = 4096;
constexpr int NMIX = 5152;
constexpr int NGATE = 3072;
constexpr float RMS_EPS = 1e-6f, GN_EPS = 64e-5f;
constexpr int NWAVES = 8, NTHR = 512;

constexpr size_t MiB = 1u << 20;
constexpr size_t WS_CTL = 0, CTL_ZERO_BYTES = 64 * 1024;
constexpr size_t WS_SS = 256 * 1024;
constexpr size_t WS_XB = 1 * MiB;
constexpr size_t WS_Z = 33 * MiB;
constexpr size_t Z_R = WS_Z + 0 * MiB, Z_K = WS_Z + 16 * MiB, Z_V = WS_Z + 32 * MiB, Z_L = WS_Z + 48 * MiB  , Z_BX = WS_Z + 57 * MiB;
constexpr size_t A_K = WS_Z + 73 * MiB, A_V = WS_Z + 97 * MiB, Z_BY = WS_Z + 121 * MiB, A_Q = WS_Z + 137 * MiB;
constexpr size_t WS_GATES = WS_Z;
constexpr size_t WS_MERGED = WS_Z;
constexpr size_t WS_GSCR = WS_Z + 32 * MiB;
constexpr size_t WS_H2 = WS_Z;
constexpr size_t WS_HID = WS_Z + 32 * MiB;
constexpr size_t WS_OA = 194 * MiB;
constexpr size_t WS_OC = 210 * MiB;
constexpr size_t WS_WMIX = 218 * MiB;
constexpr size_t WS_WTAIL = WS_WMIX + 5120 * 2048;
constexpr size_t WS_WG = WS_WMIX + 5376 * 2048;
constexpr size_t WS_PA = WS_WG + 6 * MiB, WS_PB = WS_PA + 1 * MiB, WS_PC = WS_PB + 1 * MiB, WS_WOUT = WS_PC + MiB / 2;
constexpr size_t WS_WUP = WS_OA, WS_WDOWN = WS_OA + 8 * MiB;
constexpr size_t WS_LSE = 239 * MiB;
constexpr size_t WS_RKPQ = 240 * MiB;
constexpr size_t WS_LRUAGG = 248 * MiB;
constexpr size_t WS_ZT = 249 * MiB;
constexpr size_t WS_END = 256 * MiB;
static_assert(WS_PB == WS_PA + MiB && WS_PC == WS_PB + MiB && WS_OA == 194 * MiB && Z_BY == 154 * MiB && WS_OC == 210 * MiB, "merge phase operand arithmetic");
static_assert(WS_WOUT + 2 * MiB <= WS_LSE && WS_WDOWN + 8 * MiB <= WS_OC, "ws map (weights)");
static_assert(WS_HID + (size_t)M * FF * 2 <= WS_OA && A_Q + (size_t)M * 768 * 2 <= WS_OA && WS_GATES + (size_t)M * NGATE * 2 <= Z_BY, "ws map");

#define GAS __attribute__((address_space(1)))
#define LAS __attribute__((address_space(3)))
typedef unsigned short bf16;
typedef GAS unsigned gu32;
#define RLX_AGENT __ATOMIC_RELAXED, __HIP_MEMORY_SCOPE_AGENT
__device__ __forceinline__ unsigned f2bf(float f) { unsigned u = __builtin_bit_cast(unsigned, f); return (u + 0x7fffu + ((u >> 16) & 1u)) >> 16; }
__device__ __forceinline__ float bf2f(unsigned h) { return __builtin_bit_cast(float, h << 16); }
__device__ __forceinline__ float shfl_xor_l(float v, int o, int lane) { return __builtin_bit_cast(float, __builtin_amdgcn_ds_bpermute((lane ^ o) << 2, __builtin_bit_cast(int, v))); }
__device__ __forceinline__ float wave_sum(float v, int lane) {
#pragma unroll
    for (int o = 1; o < 64; o <<= 1) v += shfl_xor_l(v, o, lane);
    return v;
}
template <class T> __device__ __forceinline__ T* launder(T* p) { GAS T* g = (GAS T*)p; asm volatile("" : "+s"(g)); return (T*)g; }
__device__ __forceinline__ float sigmoidf_(float x) { return 1.f / (1.f + __expf(-x)); }
__device__ __forceinline__ float softplusf_(float x) { return x > 20.f ? x : log1pf(expf(x)); }

#define XB_TMO      128
#define XB_XCNT(j)  (256  + 64 * (j))
#define XB_XSUB(j)  (1280 + 64 * (j))
#define XB_XGEN(j)  (2304 + 64 * (j))
#define XB_TOP      3328
#define XB_TOPGEN   (3392 + 8192)
#define XCD_BAR_WORDS 3456
#define XB_SPIN_CAP (1u << 22)
constexpr int CW_BAR = 4096;
__device__ __forceinline__ unsigned xb_ld(unsigned* p)              { return __hip_atomic_load(p, __ATOMIC_RELAXED, __HIP_MEMORY_SCOPE_AGENT); }
__device__ __forceinline__ unsigned xb_add(unsigned* p, unsigned v) { return __hip_atomic_fetch_add(p, v, __ATOMIC_RELAXED, __HIP_MEMORY_SCOPE_AGENT); }
__device__ __forceinline__ unsigned xb_xcc_id() { return (unsigned)__builtin_amdgcn_s_getreg((3 << 11) | 20) & 0xFu; }
#define XB_SPIN(cond, bar) do { unsigned _sp = 0; while (cond) { \
    if ((++_sp & 255u) == 0u) { if (xb_ld(&(bar)[XB_TMO])) break; if (_sp > XB_SPIN_CAP) { atomicAdd(&(bar)[XB_TMO], 1u); break; } } } } while (0)
struct XcdBarrier { unsigned* bar; unsigned x; volatile LAS unsigned* st; };
__device__ __forceinline__ XcdBarrier xcd_barrier_post(unsigned* bar, volatile LAS unsigned* st) {
    XcdBarrier b; b.bar = bar; b.x = xb_xcc_id(); b.st = st;
    if (threadIdx.x == 0) (void)xb_add(&bar[XB_XCNT(b.x)], 1u);
    return b;
}
__device__ __forceinline__ void xcd_barrier_complete(unsigned* bar, unsigned x, unsigned& nloc, unsigned& nx) {
    const unsigned G = gridDim.x * gridDim.y * gridDim.z;
    unsigned sum, cnt, mine, sp = 0u;
    for (;;) {
        sum = 0u; cnt = 0u; mine = 0u;
        unsigned cj[16];
        { const unsigned* cb_ = &bar[XB_XCNT(0)]; const unsigned zo_ = 0u;
          static_assert(XB_XCNT(1) - XB_XCNT(0) == 64, "counter spacing");
          asm volatile(
                     "s_nop 7\n\t"
                     "global_load_dword %0, %16, %17 sc1\n\t"
                     "global_load_dword %1, %16, %17 offset:256 sc1\n\t"
                     "global_load_dword %2, %16, %17 offset:512 sc1\n\t"
                     "global_load_dword %3, %16, %17 offset:768 sc1\n\t"
                     "global_load_dword %4, %16, %17 offset:1024 sc1\n\t"
                     "global_load_dword %5, %16, %17 offset:1280 sc1\n\t"
                     "global_load_dword %6, %16, %17 offset:1536 sc1\n\t"
                     "global_load_dword %7, %16, %17 offset:1792 sc1\n\t"
                     "global_load_dword %8, %16, %17 offset:2048 sc1\n\t"
                     "global_load_dword %9, %16, %17 offset:2304 sc1\n\t"
                     "global_load_dword %10, %16, %17 offset:2560 sc1\n\t"
                     "global_load_dword %11, %16, %17 offset:2816 sc1\n\t"
                     "global_load_dword %12, %16, %17 offset:3072 sc1\n\t"
                     "global_load_dword %13, %16, %17 offset:3328 sc1\n\t"
                     "global_load_dword %14, %16, %17 offset:3584 sc1\n\t"
                     "global_load_dword %15, %16, %17 offset:3840 sc1\n\t"
                     "s_waitcnt vmcnt(0)"
                     : "=&v"(cj[0]), "=&v"(cj[1]), "=&v"(cj[2]), "=&v"(cj[3]), "=&v"(cj[4]), "=&v"(cj[5]), "=&v"(cj[6]), "=&v"(cj[7]), "=&v"(cj[8]), "=&v"(cj[9]), "=&v"(cj[10]), "=&v"(cj[11]), "=&v"(cj[12]), "=&v"(cj[13]), "=&v"(cj[14]), "=&v"(cj[15]) : "v"(zo_), "s"(cb_) : "memory"); }
#pragma unroll
        for (unsigned j = 0; j < 16; ++j) { const unsigned c = cj[j]; sum += c; cnt += (c > 0u) ? 1u : 0u; mine = (j == x) ? c : mine; }
        if (sum == G) break;
        __builtin_amdgcn_s_sleep(1);
        if ((++sp & 255u) == 0u) { if (xb_ld(&bar[XB_TMO])) break; if (sp > XB_SPIN_CAP) { atomicAdd(&bar[XB_TMO], 1u); break; } }
    }
    nloc = mine > 0u ? mine : 1u; nx = cnt > 0u ? cnt : 1u;
}
__device__ __forceinline__ void xcd_barrier(const XcdBarrier& b) {
    asm volatile("s_waitcnt vmcnt(0)" ::: "memory");
    __syncthreads();
    if (threadIdx.x == 0) {
        unsigned* bar = b.bar;
        __builtin_amdgcn_s_waitcnt(0);
        unsigned nloc = b.st[0], nx = b.st[1];
        if (nloc == 0u) { xcd_barrier_complete(bar, b.x, nloc, nx); b.st[0] = nloc; b.st[1] = nx; }
        const unsigned old = xb_add(&bar[XB_XSUB(b.x)], 1u);
        const unsigned gen = old / nloc;
        if (old + 1u == (gen + 1u) * nloc) {
            __builtin_amdgcn_fence(__ATOMIC_RELEASE, "agent");
            asm volatile("s_waitcnt vmcnt(0)" ::: "memory");
            const unsigned og = xb_add(&bar[XB_TOP], 1u);
            const unsigned tg = og / nx;
            if (og + 1u == (tg + 1u) * nx) xb_add(&bar[XB_TOPGEN], 1u);
            else XB_SPIN(xb_ld(&bar[XB_TOPGEN]) == tg, bar);
            __builtin_amdgcn_fence(__ATOMIC_ACQUIRE, "agent");
        } else {
            XB_SPIN(xb_ld(&bar[XB_TOPGEN]) == gen, bar);
            __builtin_amdgcn_fence(__ATOMIC_ACQUIRE, "agent");
            asm volatile("s_waitcnt vmcnt(0)" ::: "memory");
        }
    }
    __syncthreads();
}

namespace pg8 {
#define PG8_LAS __attribute__((address_space(3)))
typedef unsigned short bf16_t;
typedef short bf16x8 __attribute__((ext_vector_type(8)));
typedef float f32x4 __attribute__((ext_vector_type(4)));
typedef unsigned u32x4 __attribute__((ext_vector_type(4)));
constexpr int BM = 256, BK = 64, HALF = 128, HTB = HALF * BK * 2  , STAGE_BYTES = 8 * HTB, NXCD = 8, WGM = 8;

__host__ __device__ __forceinline__ int lds_byte(int r, int c) { const int st = (r >> 4) * 2 + (c >> 5), rr = r & 15, cc = c & 31, ob = rr * 64 + cc * 2; return st * 1024 + (ob ^ (((ob >> 9) & 1) << 5)); }
__host__ __device__ __forceinline__ void stage_rc(int b, int& R, int& C) { const int st = b / 1024, sb = b % 1024, swz = sb ^ (((sb >> 9) & 1) << 5); R = (st >> 1) * 16 + swz / 64; C = (st & 1) * 32 + (swz % 64) / 2; }
__host__ __device__ __forceinline__ int perm32(int rho) { const int n = rho >> 4, i = rho & 15; return 8 * (i >> 2) + 4 * n + (i & 3); }

struct Unit { int pm, pn, par; };
struct Gemm { const bf16_t* A; const bf16_t* Bt; int M, N, K; };

struct StaticOrder {
    int nM, nN, nwg, G, c;
    __host__ __device__ __forceinline__ void init(int M, int N, int G_, int c_) { nM = M / BM; nN = N / BM; nwg = nM * nN; G = G_; c = c_; }
    __host__ __device__ __forceinline__ bool next(int i, Unit& u) const {
        const long L = (long)i * G + c; if (L >= nwg) return false;
        int wgid = (int)L; { const int q = nwg / NXCD, r = nwg % NXCD, xcd = wgid % NXCD, off = wgid / NXCD; wgid = (xcd < r ? xcd * (q + 1) : r * (q + 1) + (xcd - r) * q) + off; }
        const int nig = WGM * nN, gid = wgid / nig, fm = gid * WGM, gsz = (nM - fm) < WGM ? (nM - fm) : WGM;
        u.pm = fm + ((wgid % nig) % gsz); u.pn = (wgid % nig) / gsz; u.par = i & 1; return true;
    }
    __device__ __forceinline__ void a_ready(const Unit&) const {}
    __device__ __forceinline__ void done(const Unit&) const {}
};
struct RstdOrder : StaticOrder {
    const float* ss; PG8_LAS float* tab; int tid;
    __device__ __forceinline__ void a_ready(const Unit& u) const { if (tid < 256) tab[u.par * 256 + tid] = __builtin_amdgcn_rsqf(ss[u.pm * BM + tid] * (1.f / 1024.f) + 1e-6f); }
};

typedef float f32x2_c __attribute__((ext_vector_type(2))); typedef __bf16 bf16x2_c __attribute__((ext_vector_type(2)));
__device__ __forceinline__ unsigned cvt_pk_bf16(float lo, float hi) { f32x2_c v = {lo, hi}; bf16x2_c b = __builtin_convertvector(v, bf16x2_c); return __builtin_bit_cast(unsigned, b); }

typedef _Float16 f16x2_c __attribute__((ext_vector_type(2))); typedef _Float16 f16x8 __attribute__((ext_vector_type(8)));
__device__ __forceinline__ unsigned cvt_pk_f16(float lo, float hi) { f32x2_c v = {lo, hi}; f16x2_c h = __builtin_convertvector(v, f16x2_c); return __builtin_bit_cast(unsigned, h); }
__device__ __forceinline__ float hfl(unsigned u) { return (float)__builtin_bit_cast(f16x2_c, u)[0]; }
__device__ __forceinline__ float hfh(unsigned u) { return (float)__builtin_bit_cast(f16x2_c, u)[1]; }
__device__ __forceinline__ u32x4 pack8h(const f32x4& v0, const f32x4& v1) { u32x4 w; w.x = cvt_pk_f16(v0[0], v0[1]); w.y = cvt_pk_f16(v0[2], v0[3]); w.z = cvt_pk_f16(v1[0], v1[1]); w.w = cvt_pk_f16(v1[2], v1[3]); return w; }
__device__ __forceinline__ f32x4 mfma16(bool f16, bf16x8 a, bf16x8 b, f32x4 c) {
    return f16 ? __builtin_amdgcn_mfma_f32_16x16x32_f16(__builtin_bit_cast(f16x8, a), __builtin_bit_cast(f16x8, b), c, 0, 0, 0) : __builtin_amdgcn_mfma_f32_16x16x32_bf16(a, b, c, 0, 0, 0); }
__device__ __forceinline__ u32x4 pack8(const f32x4& v0, const f32x4& v1) { u32x4 w; w.x = cvt_pk_bf16(v0[0], v0[1]); w.y = cvt_pk_bf16(v0[2], v0[3]); w.z = cvt_pk_bf16(v1[0], v1[1]); w.w = cvt_pk_bf16(v1[2], v1[3]); return w; }
__device__ __forceinline__ float bfl(unsigned u) { return __builtin_bit_cast(float, u << 16); }
__device__ __forceinline__ float bfh(unsigned u) { return __builtin_bit_cast(float, u & 0xffff0000u); }
__device__ __forceinline__ void st16_wt(void* base, unsigned byte_off, u32x4 v) {
    const __amdgpu_buffer_rsrc_t rsrc = __builtin_amdgcn_make_buffer_rsrc(base, (short)0, 0x7fffffff, 0x00020000);
    __builtin_amdgcn_raw_buffer_store_b128(v, rsrc, (int)byte_off, 0, 16);
}
__device__ __forceinline__ float fsig(float x) { return __builtin_amdgcn_rcpf(1.f + __builtin_amdgcn_exp2f(-1.4426950408889634f * x)); }
__device__ __forceinline__ float row_rstd(const float* ss, int row) { return __builtin_amdgcn_rsqf(ss[row] * (1.f / 1024.f) + RMS_EPS); }
struct EpiMixMF {
    static constexpr bool PERM = true, AFTER_DRAIN = false;
    unsigned char* ws; const PG8_LAS float* rt;
    __device__ __forceinline__ void operator()(const f32x4 (&acc)[2][2][4][2], const Unit& u, int wr, int wc, int fr, int fq) const {
        const int pn = u.pn; size_t boff; int ld, colt, lim;
        if (pn < 2)       { boff = Z_R;  ld = 512; colt = pn * 256;        lim = 512; }
        else if (pn < 4)  { boff = Z_K;  ld = 512; colt = (pn - 2) * 256;  lim = 512; }
        else if (pn < 6)  { boff = Z_V;  ld = 512; colt = (pn - 4) * 256;  lim = 512; }
        else if (pn < 7)  { boff = Z_L;  ld = 288; colt = 0;               lim = 256; }
        else if (pn < 9)  { boff = Z_BX; ld = 512; colt = (pn - 7) * 256;  lim = 512; }
        else if (pn < 11) { boff = Z_BY; ld = 512; colt = (pn - 9) * 256;  lim = 512; }
        else if (pn < 14) { boff = A_Q;  ld = 768; colt = (pn - 11) * 256; lim = 768; }
        else if (pn < 17) { boff = A_K;  ld = 768; colt = (pn - 14) * 256; lim = 768; }
        else              { boff = A_V;  ld = 768; colt = (pn - 17) * 256; lim = 768; }
        bf16_t* base = (bf16_t*)(ws + boff);
        const int row0 = u.pm * BM + wr * 64 + fr, col0 = colt + wc * 32 + 8 * fq;
        float rsv[2][4];
#pragma unroll
        for (int ai = 0; ai < 2; ++ai)
#pragma unroll
            for (int m = 0; m < 4; ++m) rsv[ai][m] = rt[u.par * 256 + wr * 64 + fr + ai * HALF + m * 16];
        __builtin_amdgcn_sched_barrier(0);
#pragma unroll
        for (int ai = 0; ai < 2; ++ai)
#pragma unroll
            for (int m = 0; m < 4; ++m) { const unsigned roff = (unsigned)(((row0 + ai * HALF + m * 16) * ld + col0) * 2); const float rs = rsv[ai][m];
#pragma unroll
                for (int bj = 0; bj < 2; ++bj) if (col0 + bj * HALF < lim) st16_wt(base, roff + bj * HALF * 2, pack8(acc[ai][bj][m][0] * rs, acc[ai][bj][m][1] * rs)); }
    }
};
template <int ACT  > struct EpiActMF {
    static constexpr bool PERM = true, AFTER_DRAIN = false;
    bf16_t* O; int ldc; const PG8_LAS float* rt;
    __device__ __forceinline__ void operator()(const f32x4 (&acc)[2][2][4][2], const Unit& u, int wr, int wc, int fr, int fq) const {
        const int row0 = u.pm * BM + wr * 64 + fr, col0 = u.pn * BM + wc * 32 + 8 * fq;
        float rsv[2][4];
#pragma unroll
        for (int ai = 0; ai < 2; ++ai)
#pragma unroll
            for (int m = 0; m < 4; ++m) rsv[ai][m] = rt[u.par * 256 + wr * 64 + fr + ai * HALF + m * 16];
        __builtin_amdgcn_sched_barrier(0);
#pragma unroll
        for (int ai = 0; ai < 2; ++ai)
#pragma unroll
            for (int m = 0; m < 4; ++m) { bf16_t* rowp = O + (size_t)(row0 + ai * HALF + m * 16) * ldc + col0; const float rs = rsv[ai][m] * (ACT == 1 ? -1.4426950408889634f : 1.f);
#pragma unroll
                for (int bj = 0; bj < 2; ++bj) { f32x4 v0 = acc[ai][bj][m][0] * rs, v1 = acc[ai][bj][m][1] * rs;
#pragma unroll
                    for (int e = 0; e < 4; ++e) {
                        if (ACT == 1) { v0[e] = __builtin_amdgcn_rcpf(1.f + __builtin_amdgcn_exp2f(v0[e])); v1[e] = __builtin_amdgcn_rcpf(1.f + __builtin_amdgcn_exp2f(v1[e])); }
                        if (ACT == 2) { const float a = fmaxf(v0[e], 0.f), b = fmaxf(v1[e], 0.f); v0[e] = a * a; v1[e] = b * b; } }
                    if (ACT == 2) st16_wt(O, (unsigned)(((size_t)(row0 + ai * HALF + m * 16) * ldc + col0 + bj * HALF) * 2), pack8(v0, v1)); else *(u32x4*)(rowp + bj * HALF) = pack8(v0, v1); } }
    }
};
template <int BR> struct EpiMergeMF {
    static constexpr bool PERM = true, AFTER_DRAIN = false;
    const bf16_t* gates; bf16_t* O; int gld, goff;
    __device__ __forceinline__ void operator()(const f32x4 (&acc)[2][2][4][2], const Unit& u, int wr, int wc, int fr, int fq) const {
        const int row0 = u.pm * BM + wr * 64 + fr, col0 = u.pn * BM + wc * 32 + 8 * fq;
#pragma unroll
        for (int ai = 0; ai < 2; ++ai) {
            u32x4 gv[4][2], pv[4][2];
#pragma unroll
            for (int m = 0; m < 4; ++m)
#pragma unroll
                for (int bj = 0; bj < 2; ++bj) { const size_t r = (size_t)(row0 + ai * HALF + m * 16);
                    gv[m][bj] = *(const u32x4*)(gates + r * gld + goff + col0 + bj * HALF);
                    if (BR > 0) pv[m][bj] = *(const u32x4*)(O + r * 1024 + col0 + bj * HALF); }
            __builtin_amdgcn_sched_barrier(0);
#pragma unroll
            for (int m = 0; m < 4; ++m)
#pragma unroll
                for (int bj = 0; bj < 2; ++bj) { const size_t r = (size_t)(row0 + ai * HALF + m * 16); const u32x4 g = gv[m][bj];
                    f32x4 v0 = acc[ai][bj][m][0], v1 = acc[ai][bj][m][1];
                    v0[0] *= bfl(g.x); v0[1] *= bfh(g.x); v0[2] *= bfl(g.y); v0[3] *= bfh(g.y); v1[0] *= bfl(g.z); v1[1] *= bfh(g.z); v1[2] *= bfl(g.w); v1[3] *= bfh(g.w);
                    if (BR > 0) { const u32x4 p = pv[m][bj];
                        v0[0] += bfl(p.x); v0[1] += bfh(p.x); v0[2] += bfl(p.y); v0[3] += bfh(p.y); v1[0] += bfl(p.z); v1[1] += bfh(p.z); v1[2] += bfl(p.w); v1[3] += bfh(p.w); }
                    *(u32x4*)(O + r * 1024 + col0 + bj * HALF) = pack8(v0, v1); }
            asm volatile("" ::: "memory");
        }
    }
};
struct EpiResMF {
    static constexpr bool PERM = false, AFTER_DRAIN = false;
    const float* base; float* out; bf16_t* xb; float* ss; bool dry = false;
    __device__ __forceinline__ void operator()(const f32x4 (&acc)[2][2][4][2], const Unit& u, int wr, int wc, int fr, int fq) const {
        if (dry && acc[0][0][0][0][0] != 1.2345e30f) return;
        typedef unsigned u32x2e __attribute__((ext_vector_type(2)));
        const int row0 = u.pm * BM + wr * 64 + fr, col0 = u.pn * BM + wc * 32 + 4 * fq, lane = fq * 16 + fr;
#pragma unroll
        for (int ai = 0; ai < 2; ++ai)
#pragma unroll
            for (int m = 0; m < 4; ++m) { const int row = row0 + ai * HALF + m * 16; const size_t off = (size_t)row * 1024 + col0; float s = 0.f;
#pragma unroll
                for (int bj = 0; bj < 2; ++bj)
#pragma unroll
                    for (int n = 0; n < 2; ++n) { const f32x4 b = *(const f32x4*)(base + off + bj * HALF + n * 16); const f32x4 v = b + acc[ai][bj][m][n]; *(f32x4*)(out + off + bj * HALF + n * 16) = v;
                        if (xb) { *(u32x2e*)(xb + off + bj * HALF + n * 16) = (u32x2e){cvt_pk_bf16(v[0], v[1]), cvt_pk_bf16(v[2], v[3])}; s += (v[0] * v[0] + v[1] * v[1]) + (v[2] * v[2] + v[3] * v[3]); } }
                if (ss) { s += __builtin_bit_cast(float, __builtin_amdgcn_ds_bpermute((lane ^ 16) << 2, __builtin_bit_cast(int, s))); s += __builtin_bit_cast(float, __builtin_amdgcn_ds_bpermute((lane ^ 32) << 2, __builtin_bit_cast(int, s)));
                    if (fq == 0) atomicAdd(ss + row, s); }
                if (m & 1) asm volatile("" ::: "memory"); }
    }
};

struct EpiResH {
    static constexpr bool PERM = true, AFTER_DRAIN = false;
    const float* basef; const bf16_t* xbr; bf16_t* xbw; float* outf; float* ss; bool dry = false;
    __device__ __forceinline__ void operator()(const f32x4 (&acc)[2][2][4][2], const Unit& u, int wr, int wc, int fr, int fq) const {
        if (dry && acc[0][0][0][0][0] != 1.2345e30f) return;
        const int row0 = u.pm * BM + wr * 64 + fr, col0 = u.pn * BM + wc * 32 + 8 * fq, lane = fq * 16 + fr;
#pragma unroll
        for (int ai = 0; ai < 2; ++ai) {
            u32x4 raw[4][2];
#pragma unroll
            for (int m = 0; m < 4; ++m)
#pragma unroll
                for (int bj = 0; bj < 2; ++bj) raw[m][bj] = *(const u32x4*)(xbr + (size_t)(row0 + ai * HALF + m * 16) * 1024 + col0 + bj * HALF);
            __builtin_amdgcn_sched_barrier(0);
#pragma unroll
            for (int m = 0; m < 4; ++m) { const int row = row0 + ai * HALF + m * 16; float s = 0.f;
#pragma unroll
                for (int bj = 0; bj < 2; ++bj) { const size_t off = (size_t)row * 1024 + col0 + bj * HALF; const u32x4 p = raw[m][bj];
                    const f32x4 v0 = (f32x4){hfl(p.x), hfh(p.x), hfl(p.y), hfh(p.y)} + acc[ai][bj][m][0], v1 = (f32x4){hfl(p.z), hfh(p.z), hfl(p.w), hfh(p.w)} + acc[ai][bj][m][1];
                    if (outf) { *(f32x4*)(outf + off) = v0; *(f32x4*)(outf + off + 4) = v1; }
                    if (xbw) { *(u32x4*)(xbw + off) = pack8h(v0, v1); s += ((v0[0] * v0[0] + v0[1] * v0[1]) + (v0[2] * v0[2] + v0[3] * v0[3])) + ((v1[0] * v1[0] + v1[1] * v1[1]) + (v1[2] * v1[2] + v1[3] * v1[3])); } }
                if (ss) { s += __builtin_bit_cast(float, __builtin_amdgcn_ds_bpermute((lane ^ 16) << 2, __builtin_bit_cast(int, s))); s += __builtin_bit_cast(float, __builtin_amdgcn_ds_bpermute((lane ^ 32) << 2, __builtin_bit_cast(int, s)));
                    if (fq == 0) atomicAdd(ss + row, s); } }
            asm volatile("" ::: "memory"); }
    }
};

template <class Epi, class Sched, bool ALIGN_EPI = false, bool SP2 = false, bool F16 = false>
__device__ __forceinline__ void gemm_phase(PG8_LAS unsigned char* lds, const Gemm g, const Sched& S, const Epi& E, const int tid) {
    const int wid = __builtin_amdgcn_readfirstlane(tid >> 6), lane = tid & 63, wr = wid >> 2, wc = wid & 3, fr = lane & 15, fq = lane >> 4;
    const int K = g.K, nt = K / BK;
    unsigned voffA[2], voffB[2];
#pragma unroll
    for (int i = 0; i < 2; ++i) { int R, C; stage_rc(tid * 16 + i * 8192, R, C); const int Rb = Epi::PERM ? ((R & ~31) + perm32(R & 31)) : R;
        voffA[i] = (unsigned)(R * K + C) * 2u; voffB[i] = (unsigned)(Rb * K + C) * 2u; }
    const size_t kstep = (size_t)(BK * 2);
    const size_t hstep = (size_t)HALF * K * 2;
    const size_t tstep = 2 * hstep;
    const unsigned ldsw = (unsigned)wid * 1024u;
    const int aoff = lds_byte(wr * 64 + fr, fq * 8), boff = lds_byte(wc * 32 + fr, fq * 8);
#define PG8_SA(b, h) (((b) * 2 + (h)) * HTB)
#define PG8_SB(b, h) ((4 + (b) * 2 + (h)) * HTB)
#define PG8_STAGE(bufoff, gbase, voff) do { _Pragma("unroll") for (int _i = 0; _i < 2; ++_i) \
        __builtin_amdgcn_global_load_lds((const unsigned*)((const char*)(gbase) + (voff)[_i]), (PG8_LAS unsigned*)(lds + (bufoff) + ldsw + _i * 8192), 16, 0, 0); } while (0)
#define PG8_LDA(dst, b, h) do { _Pragma("unroll") for (int m = 0; m < 4; ++m) _Pragma("unroll") for (int k = 0; k < 2; ++k) dst[m][k] = *(const PG8_LAS bf16x8*)(lds + PG8_SA(b, h) + aoff + m * 2048 + k * 1024); } while (0)
#define PG8_LDB(dst, b, h) do { _Pragma("unroll") for (int n = 0; n < 2; ++n) _Pragma("unroll") for (int k = 0; k < 2; ++k) dst[n][k] = *(const PG8_LAS bf16x8*)(lds + PG8_SB(b, h) + boff + n * 2048 + k * 1024); } while (0)
#define PG8_MMA(ai, bj, At, Bt) do { __builtin_amdgcn_s_setprio(1); _Pragma("unroll") for (int m = 0; m < 4; ++m) _Pragma("unroll") for (int n = 0; n < 2; ++n) _Pragma("unroll") for (int k = 0; k < 2; ++k) \
        acc[ai][bj][m][n] = mfma16(F16, Bt[n][k], At[m][k], acc[ai][bj][m][n]); __builtin_amdgcn_s_setprio(0); } while (0)
#define PG8_WAIT_V(n) asm volatile("s_waitcnt vmcnt(" #n ")" ::: "memory")
#define PG8_WAIT_L(n) asm volatile("s_waitcnt lgkmcnt(" #n ")" ::: "memory")
#define PG8_BAR __builtin_amdgcn_s_barrier()
#define PG8_SCHED __builtin_amdgcn_sched_barrier(0)
    Unit cur, nxt; int ui = 0;
    if (!S.next(0, cur)) return;
    f32x4 acc[2][2][4][2];
#pragma unroll
    for (int a = 0; a < 2; ++a)
#pragma unroll
        for (int b = 0; b < 2; ++b)
#pragma unroll
            for (int m = 0; m < 4; ++m)
#pragma unroll
                for (int n = 0; n < 2; ++n) acc[a][b][m][n] = (f32x4){0.f, 0.f, 0.f, 0.f};
    bf16x8 At[4][2], B0[2][2], B1[2][2];
    const char* cA = (const char*)g.A + (size_t)cur.pm * tstep; const char* cB = (const char*)g.Bt + (size_t)cur.pn * tstep;
    S.a_ready(cur);
    if constexpr (SP2) {
        PG8_STAGE(PG8_SB(0, 0), cB, voffB); PG8_STAGE(PG8_SB(0, 1), cB + hstep, voffB); PG8_STAGE(PG8_SA(0, 0), cA, voffA); PG8_STAGE(PG8_SA(0, 1), cA + hstep, voffA);
        if (wr == 1) PG8_BAR;
        PG8_WAIT_V(2); PG8_BAR;
        PG8_STAGE(PG8_SB(1, 0), cB + kstep, voffB); PG8_STAGE(PG8_SA(1, 0), cA + kstep, voffA); PG8_STAGE(PG8_SB(1, 1), cB + hstep + kstep, voffB);
        PG8_WAIT_V(6); PG8_BAR;
    } else {
        PG8_STAGE(PG8_SB(0, 0), cB, voffB); PG8_STAGE(PG8_SA(0, 0), cA, voffA); PG8_STAGE(PG8_SB(0, 1), cB + hstep, voffB); PG8_STAGE(PG8_SA(0, 1), cA + hstep, voffA);
        if (wr == 1) PG8_BAR;
        PG8_WAIT_V(4); PG8_BAR;
        PG8_STAGE(PG8_SB(1, 0), cB + kstep, voffB); PG8_STAGE(PG8_SA(1, 0), cA + kstep, voffA); PG8_STAGE(PG8_SB(1, 1), cB + hstep + kstep, voffB);
        PG8_WAIT_V(6); PG8_BAR;
    }
    for (;;) {
        const bool has_next = S.next(ui + 1, nxt);
        const char* nA = has_next ? (const char*)g.A + (size_t)nxt.pm * tstep : cA; const char* nB = has_next ? (const char*)g.Bt + (size_t)nxt.pn * tstep : cB;
#pragma unroll 1
        for (int t = 0; t < nt; t += 2) {
            const bool last = (t == nt - 2);
            const char* a1 = cA + (size_t)(t + 1) * kstep;
            const char* a2 = last ? nA : cA + (size_t)(t + 2) * kstep; const char* b2 = last ? nB : cB + (size_t)(t + 2) * kstep;
            const char* a3 = a2 + kstep; const char* b3 = b2 + kstep;
            if (last && has_next) S.a_ready(nxt);
            if constexpr (SP2) {
            PG8_LDB(B0, 0, 0); PG8_LDB(B1, 0, 1); PG8_SCHED; PG8_LDA(At, 0, 0); PG8_STAGE(PG8_SA(1, 1), a1 + hstep, voffA);
            PG8_WAIT_V(8); PG8_WAIT_L(0); PG8_BAR; PG8_MMA(0, 0, At, B0); PG8_MMA(0, 1, At, B1); PG8_BAR; PG8_SCHED;
            PG8_LDA(At, 0, 1); PG8_STAGE(PG8_SB(0, 0), b2, voffB); PG8_STAGE(PG8_SB(0, 1), b2 + hstep, voffB); PG8_STAGE(PG8_SA(0, 0), a2, voffA);
            PG8_WAIT_V(8); PG8_WAIT_L(0); PG8_BAR; PG8_MMA(1, 0, At, B0); PG8_MMA(1, 1, At, B1); PG8_BAR; PG8_SCHED;
            PG8_LDB(B0, 1, 0); PG8_LDB(B1, 1, 1); PG8_SCHED; PG8_LDA(At, 1, 0); PG8_STAGE(PG8_SA(0, 1), a2 + hstep, voffA);
            PG8_WAIT_V(8); PG8_WAIT_L(0); PG8_BAR; PG8_MMA(0, 0, At, B0); PG8_MMA(0, 1, At, B1); PG8_BAR; PG8_SCHED;
            PG8_LDA(At, 1, 1); PG8_STAGE(PG8_SB(1, 0), b3, voffB); PG8_STAGE(PG8_SB(1, 1), b3 + hstep, voffB); PG8_STAGE(PG8_SA(1, 0), a3, voffA);
            PG8_WAIT_V(8); PG8_WAIT_L(0); PG8_BAR; PG8_MMA(1, 0, At, B0); PG8_MMA(1, 1, At, B1); PG8_BAR; PG8_SCHED;
            } else {
            PG8_LDB(B0, 0, 0); PG8_SCHED; PG8_LDA(At, 0, 0); PG8_STAGE(PG8_SA(1, 1), a1 + hstep, voffA);
            PG8_WAIT_L(8); PG8_BAR; PG8_WAIT_L(0); PG8_MMA(0, 0, At, B0); PG8_BAR; PG8_SCHED;
            PG8_LDB(B1, 0, 1); PG8_STAGE(PG8_SB(0, 0), b2, voffB);
            PG8_BAR; PG8_WAIT_L(0); PG8_MMA(0, 1, At, B1); PG8_BAR;
            PG8_LDA(At, 0, 1); PG8_STAGE(PG8_SA(0, 0), a2, voffA);
            PG8_BAR; PG8_WAIT_L(0); PG8_MMA(1, 0, At, B0); PG8_BAR; PG8_SCHED;
            PG8_STAGE(PG8_SB(0, 1), b2 + hstep, voffB);
            PG8_WAIT_V(6); PG8_BAR; PG8_MMA(1, 1, At, B1); PG8_BAR;
            PG8_LDB(B0, 1, 0); PG8_SCHED; PG8_LDA(At, 1, 0); PG8_STAGE(PG8_SA(0, 1), a2 + hstep, voffA);
            PG8_WAIT_L(8); PG8_BAR; PG8_WAIT_L(0); PG8_MMA(0, 0, At, B0); PG8_BAR; PG8_SCHED;
            PG8_LDB(B1, 1, 1); PG8_STAGE(PG8_SB(1, 0), b3, voffB);
            PG8_BAR; PG8_WAIT_L(0); PG8_MMA(0, 1, At, B1); PG8_BAR;
            PG8_LDA(At, 1, 1); PG8_STAGE(PG8_SA(1, 0), a3, voffA);
            PG8_BAR; PG8_WAIT_L(0); PG8_MMA(1, 0, At, B0); PG8_BAR; PG8_SCHED;
            PG8_STAGE(PG8_SB(1, 1), b3 + hstep, voffB);
            PG8_WAIT_V(6); PG8_BAR; PG8_MMA(1, 1, At, B1); PG8_BAR;
            }
        }
        if constexpr (ALIGN_EPI) { if (wr == 0) PG8_BAR; }
        if constexpr (!Epi::AFTER_DRAIN) { int fr_e = fr, fq_e = fq; asm volatile("" : "+v"(fr_e), "+v"(fq_e));
            E(acc, cur, wr, wc, fr_e, fq_e); S.done(cur); }
        if (!has_next) break;
#pragma unroll
        for (int a = 0; a < 2; ++a)
#pragma unroll
            for (int b = 0; b < 2; ++b)
#pragma unroll
                for (int m = 0; m < 4; ++m)
#pragma unroll
                    for (int n = 0; n < 2; ++n) acc[a][b][m][n] = (f32x4){0.f, 0.f, 0.f, 0.f};
        cur = nxt; cA = nA; cB = nB; ++ui;
        if constexpr (ALIGN_EPI) { if (wr == 1) PG8_BAR; }
    }
    PG8_WAIT_V(0);
    if constexpr (!ALIGN_EPI) { if (wr == 0) PG8_BAR; }
    PG8_BAR;
    if constexpr (Epi::AFTER_DRAIN) { E.fused(acc, cur, wr, wc, fr, fq, lds, wid, lane); S.done(cur); }
#undef PG8_SA
#undef PG8_SB
#undef PG8_STAGE
#undef PG8_LDA
#undef PG8_LDB
#undef PG8_MMA
#undef PG8_WAIT_V
#undef PG8_WAIT_L
#undef PG8_BAR
#undef PG8_SCHED
}

struct XOp { const char* A; const char* B; int K; };
template <class Disp>
__device__ __forceinline__ void gemm_seq(PG8_LAS unsigned char* lds, const Disp& Dp, const int nsteps, const int pm, const int pn, const int tid) {
    const int wid = __builtin_amdgcn_readfirstlane(tid >> 6), lane = tid & 63, wr = wid >> 2, wc = wid & 3, fr = lane & 15, fq = lane >> 4;
    int RA[2], RB[2], C2[2];
#pragma unroll
    for (int i = 0; i < 2; ++i) { int R, C; stage_rc(tid * 16 + i * 8192, R, C); const int Rb = (R & ~31) + perm32(R & 31); RA[i] = 2 * R; RB[i] = 2 * Rb; C2[i] = 2 * C; }
    const size_t kstep = (size_t)(BK * 2);
    const unsigned ldsw = (unsigned)wid * 1024u;
    const int aoff = lds_byte(wr * 64 + fr, fq * 8), boff = lds_byte(wc * 32 + fr, fq * 8);
#define PG8_SA(b, h) (((b) * 2 + (h)) * HTB)
#define PG8_SB(b, h) ((4 + (b) * 2 + (h)) * HTB)
#define PG8_STAGEX(bufoff, gbase, Rx, KK) do { _Pragma("unroll") for (int _i = 0; _i < 2; ++_i) \
        __builtin_amdgcn_global_load_lds((const unsigned*)((const char*)(gbase) + (unsigned)((Rx)[_i] * (KK) + C2[_i])), (PG8_LAS unsigned*)(lds + (bufoff) + ldsw + _i * 8192), 16, 0, 0); } while (0)
#define PG8_LDA(dst, b, h) do { _Pragma("unroll") for (int m = 0; m < 4; ++m) _Pragma("unroll") for (int k = 0; k < 2; ++k) dst[m][k] = *(const PG8_LAS bf16x8*)(lds + PG8_SA(b, h) + aoff + m * 2048 + k * 1024); } while (0)
#define PG8_LDB(dst, b, h) do { _Pragma("unroll") for (int n = 0; n < 2; ++n) _Pragma("unroll") for (int k = 0; k < 2; ++k) dst[n][k] = *(const PG8_LAS bf16x8*)(lds + PG8_SB(b, h) + boff + n * 2048 + k * 1024); } while (0)
#define PG8_MMA(ai, bj, At, Bt) do { __builtin_amdgcn_s_setprio(1); if (cf16) { _Pragma("unroll") for (int m = 0; m < 4; ++m) _Pragma("unroll") for (int n = 0; n < 2; ++n) _Pragma("unroll") for (int k = 0; k < 2; ++k) \
        acc[ai][bj][m][n] = mfma16(true, Bt[n][k], At[m][k], acc[ai][bj][m][n]); } else { _Pragma("unroll") for (int m = 0; m < 4; ++m) _Pragma("unroll") for (int n = 0; n < 2; ++n) _Pragma("unroll") for (int k = 0; k < 2; ++k) \
        acc[ai][bj][m][n] = mfma16(false, Bt[n][k], At[m][k], acc[ai][bj][m][n]); } __builtin_amdgcn_s_setprio(0); } while (0)
#define PG8_WAIT_V(n) asm volatile("s_waitcnt vmcnt(" #n ")" ::: "memory")
#define PG8_WAIT_L(n) asm volatile("s_waitcnt lgkmcnt(" #n ")" ::: "memory")
#define PG8_BAR __builtin_amdgcn_s_barrier()
#define PG8_SCHED __builtin_amdgcn_sched_barrier(0)
    f32x4 acc[2][2][4][2];
#pragma unroll
    for (int a = 0; a < 2; ++a)
#pragma unroll
        for (int b = 0; b < 2; ++b)
#pragma unroll
            for (int m = 0; m < 4; ++m)
#pragma unroll
                for (int n = 0; n < 2; ++n) acc[a][b][m][n] = (f32x4){0.f, 0.f, 0.f, 0.f};
    bf16x8 At[4][2], B0[2][2], B1[2][2];
    int ui = 0;
    XOp op = Dp.op(0);
    int cK = op.K; size_t ch = (size_t)HALF * cK * 2;
    const char* cA = op.A + (size_t)pm * 2 * ch; const char* cB = op.B + (size_t)pn * 2 * ch;
    Dp.a_ready(0, pm);
    PG8_STAGEX(PG8_SB(0, 0), cB, RB, cK); PG8_STAGEX(PG8_SB(0, 1), cB + ch, RB, cK); PG8_STAGEX(PG8_SA(0, 0), cA, RA, cK); PG8_STAGEX(PG8_SA(0, 1), cA + ch, RA, cK);
    if (wr == 1) PG8_BAR;
    PG8_WAIT_V(2); PG8_BAR;
    PG8_STAGEX(PG8_SB(1, 0), cB + kstep, RB, cK); PG8_STAGEX(PG8_SA(1, 0), cA + kstep, RA, cK); PG8_STAGEX(PG8_SB(1, 1), cB + ch + kstep, RB, cK);
    PG8_WAIT_V(6); PG8_BAR;
#define PG8_SEQ_STEP(F16C) { \
        const bool has_next = ui + 1 < nsteps; \
        int nK = cK; size_t nh = ch; const char* nA = cA; const char* nB = cB; \
        if (has_next) { const XOp nop = Dp.op(ui + 1); nK = nop.K; nh = (size_t)HALF * nK * 2; nA = nop.A + (size_t)pm * 2 * nh; nB = nop.B + (size_t)pn * 2 * nh; } \
        const int nt = cK / BK; constexpr bool cf16 = (F16C); \
_Pragma("unroll 1") \
        for (int t = 0; t < nt; t += 2) { \
            const bool last = (t == nt - 2); \
            const char* a1 = cA + (size_t)(t + 1) * kstep; \
            const char* a2 = last ? nA : cA + (size_t)(t + 2) * kstep; const char* b2 = last ? nB : cB + (size_t)(t + 2) * kstep; \
            const char* a3 = a2 + kstep; const char* b3 = b2 + kstep; \
            const int xK = last ? nK : cK; const size_t xh = last ? nh : ch; \
            if (last && has_next) Dp.a_ready(ui + 1, pm); \
            PG8_LDB(B0, 0, 0); PG8_LDB(B1, 0, 1); PG8_SCHED; PG8_LDA(At, 0, 0); PG8_STAGEX(PG8_SA(1, 1), a1 + ch, RA, cK); \
            PG8_WAIT_V(8); PG8_WAIT_L(0); PG8_BAR; PG8_MMA(0, 0, At, B0); PG8_MMA(0, 1, At, B1); PG8_BAR; PG8_SCHED; \
            PG8_LDA(At, 0, 1); PG8_STAGEX(PG8_SB(0, 0), b2, RB, xK); PG8_STAGEX(PG8_SB(0, 1), b2 + xh, RB, xK); PG8_STAGEX(PG8_SA(0, 0), a2, RA, xK); \
            PG8_WAIT_V(8); PG8_WAIT_L(0); PG8_BAR; PG8_MMA(1, 0, At, B0); PG8_MMA(1, 1, At, B1); PG8_BAR; PG8_SCHED; \
            PG8_LDB(B0, 1, 0); PG8_LDB(B1, 1, 1); PG8_SCHED; PG8_LDA(At, 1, 0); PG8_STAGEX(PG8_SA(0, 1), a2 + xh, RA, xK); \
            PG8_WAIT_V(8); PG8_WAIT_L(0); PG8_BAR; PG8_MMA(0, 0, At, B0); PG8_MMA(0, 1, At, B1); PG8_BAR; PG8_SCHED; \
            PG8_LDA(At, 1, 1); PG8_STAGEX(PG8_SB(1, 0), b3, RB, xK); PG8_STAGEX(PG8_SB(1, 1), b3 + xh, RB, xK); PG8_STAGEX(PG8_SA(1, 0), a3, RA, xK); \
            PG8_WAIT_V(8); PG8_WAIT_L(0); PG8_BAR; PG8_MMA(1, 0, At, B0); PG8_MMA(1, 1, At, B1); PG8_BAR; PG8_SCHED; \
        } \
        if (wr == 0) PG8_BAR; \
        { int fr_e = fr, fq_e = fq; asm volatile("" : "+v"(fr_e), "+v"(fq_e)); Dp.epi(acc, ui, pm, pn, wr, wc, fr_e, fq_e); } \
        if (!has_next) break; \
_Pragma("unroll") \
        for (int a = 0; a < 2; ++a) \
_Pragma("unroll") \
            for (int b = 0; b < 2; ++b) \
_Pragma("unroll") \
                for (int m = 0; m < 4; ++m) \
_Pragma("unroll") \
                    for (int n = 0; n < 2; ++n) acc[a][b][m][n] = (f32x4){0.f, 0.f, 0.f, 0.f}; \
        cK = nK; ch = nh; cA = nA; cB = nB; ++ui; \
        if (wr == 1) PG8_BAR; \
    }
    for (;;) {
        PG8_SEQ_STEP(true)
        PG8_SEQ_STEP(false)
    }
#undef PG8_SEQ_STEP
    PG8_WAIT_V(0);
    PG8_BAR;
#undef PG8_SA
#undef PG8_SB
#undef PG8_STAGEX
#undef PG8_LDA
#undef PG8_LDB
#undef PG8_MMA
#undef PG8_WAIT_V
#undef PG8_WAIT_L
#undef PG8_BAR
#undef PG8_SCHED
}
struct MergeDisp {
    const char *xb, *wg, *wsb, *pa; bf16_t* gscr; bf16_t* merged; const float* ss; PG8_LAS float* tab; int tid;
    __device__ __forceinline__ XOp op(int k) const {
        XOp o; const int br = k >> 1; const bool gate = (k & 1) == 0;
        const char* ab = wsb + (size_t)(194 - 88 * br + 48 * br * br) * 1048576;
        o.A = gate ? xb : ab;
        o.B = gate ? wg + (size_t)br * (1024 * 1024 * 2) : pa + (size_t)br * (1024 * 512 * 2);
        o.K = gate ? 1024 : (br == 2 ? 256 : 512);
        return o; }
    __device__ __forceinline__ bool f16(int k) const { return (k & 1) == 0; }
    __device__ __forceinline__ void a_ready(int k, int pm) const { if ((k & 1) == 0 && tid < 256) tab[((k >> 1) & 1) * 256 + tid] = __builtin_amdgcn_rsqf(ss[pm * BM + tid] * (1.f / 1024.f) + 1e-6f); }
    __device__ __forceinline__ void epi(const f32x4 (&acc)[2][2][4][2], int k, int pm, int pn, int wr, int wc, int fr, int fq) const {
        Unit u; u.pm = pm; u.pn = pn; u.par = (k >> 1) & 1;
        if ((k & 1) == 0) { EpiActMF<1> E{gscr, 1024, tab}; E(acc, u, wr, wc, fr, fq); }
        else if (k == 1) { EpiMergeMF<0> E{gscr, merged, 1024, 0}; E(acc, u, wr, wc, fr, fq); }
        else if (k == 3) { EpiMergeMF<1> E{gscr, merged, 1024, 0}; E(acc, u, wr, wc, fr, fq); }
        else { EpiMergeMF<2> E{gscr, merged, 1024, 0}; E(acc, u, wr, wc, fr, fq); }
    }
};
}

struct Args { const float* in[31]; float* out; unsigned char* ws; int ph_lo, ph_hi; };
enum { I_X = 0, I_RELB, I_NG1, I_WIN, I_MU, I_W0, I_WUP, I_A0, I_AUP, I_GUP, I_KK, I_KA, I_RK, I_LNG, I_LNB, I_PA, I_CW, I_CB, I_LWA, I_LBA, I_LWX, I_LBX, I_LAM, I_PB,
       I_QG, I_KG, I_PC, I_WOUT, I_NG2, I_UP, I_DOWN };

struct Frame {
    LAS unsigned char* lds;
    int tid, lane, wave, vcu, G, bid;
};

__device__ __forceinline__ Frame phase_frame(const Frame& F0) {
    Frame F = F0; asm volatile("" : "+s"(F.vcu), "+s"(F.wave), "+s"(F.G), "+s"(F.bid));
    int ln; asm volatile("v_mbcnt_lo_u32_b32 %0, -1, 0\n\tv_mbcnt_hi_u32_b32 %0, -1, %0" : "=v"(ln));
    F.lane = ln; F.tid = F.wave * 64 + ln; return F;
}

typedef unsigned v4u __attribute__((ext_vector_type(4)));
__device__ __forceinline__ unsigned pk2(float lo, float hi) { return f2bf(lo) | (f2bf(hi) << 16); }
#define LDS_WAIT() asm volatile("s_waitcnt lgkmcnt(0)" ::: "memory")
template <bool SCALE = false, bool F16 = false>
__device__ __forceinline__ void transpose_item(const float* W, int ldw, int K, int nblk, bf16* WT, LAS float* scr, int item, int lane, const float* gk = nullptr) {
    const int kb = item / nblk, nb = item % nblk, k0 = 64 * kb, n0 = 32 * nb;
#pragma unroll 1
    for (int i0 = 0; i0 < 32; i0 += 8) {
        float wv[8], gv[8];
#pragma unroll
        for (int j = 0; j < 8; ++j) { const int kk = 2 * (i0 + j) + (lane >> 5); wv[j] = W[(size_t)(k0 + kk) * ldw + n0 + (lane & 31)]; gv[j] = SCALE ? gk[k0 + kk] : 1.f; }
        __builtin_amdgcn_sched_barrier(0);
#pragma unroll
        for (int j = 0; j < 8; ++j) { const int kk = 2 * (i0 + j) + (lane >> 5); scr[kk * 33 + (lane & 31)] = SCALE ? wv[j] * gv[j] : wv[j]; }
    }
    LDS_WAIT(); asm volatile("" ::: "memory");
    const int c = lane & 7;
    float tv[4][8];
#pragma unroll
    for (int j = 0; j < 4; ++j) { const int n = (lane >> 3) + 8 * j; const LAS float* s_ = scr + (8 * c) * 33 + n;
#pragma unroll
        for (int e = 0; e < 8; ++e) tv[j][e] = s_[e * 33]; }
    __builtin_amdgcn_sched_barrier(0);
#pragma unroll
    for (int j = 0; j < 4; ++j) { const int n = (lane >> 3) + 8 * j; const float* s = tv[j];
        v4u o; if (F16) { o.x = pg8::cvt_pk_f16(s[0], s[1]); o.y = pg8::cvt_pk_f16(s[2], s[3]); o.z = pg8::cvt_pk_f16(s[4], s[5]); o.w = pg8::cvt_pk_f16(s[6], s[7]); }
        else { o.x = pk2(s[0], s[1]); o.y = pk2(s[2], s[3]); o.z = pk2(s[4], s[5]); o.w = pk2(s[6], s[7]); }
        *(v4u*)(WT + (size_t)(n0 + n) * K + k0 + 8 * c) = o; }
    LDS_WAIT(); asm volatile("" ::: "memory");
}
__device__ __forceinline__ void convert_wb1(Frame& F, const Args& args, int l, unsigned char* ws) {
    LAS float* scr = (LAS float*)(F.lds + F.wave * 16384);
    const int gw = F.vcu * NWAVES + F.wave, NGW = F.G * NWAVES;
    const float* w_in = args.in[I_WIN] + (size_t)l * D * DIN; const float* g1 = args.in[I_NG1] + l * D;
    constexpr int J0 = 16 * 56, J1 = 16 * 104, J2 = 16 * 96, J3 = 8 * 32, J4 = 8 * 32, J5 = 4 * 32, J6 = 16 * 32, JZ = 16;
    constexpr int NIT = J0 + J1 + J2 + J3 + J4 + J5 + J6 + JZ;
    for (int it = gw; it < NIT; it += NGW) {
        int r = it;
        if (r < J0) { transpose_item<true, true>(w_in, DIN, D, 56, (bf16*)(ws + WS_WMIX), scr, r, F.lane, g1); continue; } r -= J0;
        if (r < J1) { transpose_item<true, true>(w_in + 1824, DIN, D, 104, (bf16*)(ws + WS_WMIX) + (size_t)1792 * D, scr, r, F.lane, g1); continue; } r -= J1;
        if (r < J2) { transpose_item<true, true>(w_in + NMIX, DIN, D, 96, (bf16*)(ws + WS_WG), scr, r, F.lane, g1); continue; } r -= J2;
        if (r < J3) { transpose_item(args.in[I_PA] + (size_t)l * 512 * D, D, 512, 32, (bf16*)(ws + WS_PA), scr, r, F.lane); continue; } r -= J3;
        if (r < J4) { transpose_item(args.in[I_PB] + (size_t)l * 512 * D, D, 512, 32, (bf16*)(ws + WS_PB), scr, r, F.lane); continue; } r -= J4;
        if (r < J5) { transpose_item(args.in[I_PC] + (size_t)l * 256 * D, D, 256, 32, (bf16*)(ws + WS_PC), scr, r, F.lane); continue; } r -= J5;
        if (r < J6) { transpose_item(args.in[I_WOUT] + (size_t)l * D * D, D, D, 32, (bf16*)(ws + WS_WOUT), scr, r, F.lane); continue; } r -= J6;
        transpose_item<true, true>(w_in + 1792, DIN, D, 1, (bf16*)(ws + WS_WTAIL), scr, r, F.lane, g1);
    }
}
__device__ __forceinline__ void convert_wb2(Frame& F, const Args& args, int l, unsigned char* ws) {
    LAS float* scr = (LAS float*)(F.lds + F.wave * 16384);
    const int gw = F.vcu * NWAVES + F.wave, NGW = F.G * NWAVES;
    constexpr int J0 = 16 * 128, J1 = 64 * 32;
    for (int it = gw; it < J0 + J1; it += NGW) {
        if (it < J0) transpose_item<true, true>(args.in[I_UP] + (size_t)l * D * FF, FF, D, 128, (bf16*)(ws + WS_WUP), scr, it, F.lane, args.in[I_NG2] + l * D);
        else transpose_item(args.in[I_DOWN] + (size_t)l * FF * D, D, FF, 32, (bf16*)(ws + WS_WDOWN), scr, it - J0, F.lane);
    }
}

__device__ __forceinline__ void phase_rms(Frame& F, const float* x, const float* g, bf16* out) {
    const int gw = F.vcu * NWAVES + F.wave, NGW = F.G * NWAVES;
    typedef float f32x4 __attribute__((ext_vector_type(4)));
    for (int m = gw; m < M; m += NGW) {
        const f32x4* xr = (const f32x4*)(x + (size_t)m * D) + F.lane;
        f32x4 v[4]; float s = 0.f;
#pragma unroll
        for (int j = 0; j < 4; ++j) { v[j] = xr[64 * j]; s += (v[j].x * v[j].x + v[j].y * v[j].y) + (v[j].z * v[j].z + v[j].w * v[j].w); }
        const float rstd = 1.f / sqrtf(wave_sum(s, F.lane) * (1.f / D) + RMS_EPS);
        unsigned long long* o8 = (unsigned long long*)(out + (size_t)m * D) + F.lane;
#pragma unroll
        for (int j = 0; j < 4; ++j) {
            const f32x4 gg = *((const f32x4*)g + F.lane + 64 * j);
            const unsigned lo = f2bf(v[j].x * rstd * gg.x) | (f2bf(v[j].y * rstd * gg.y) << 16), hi = f2bf(v[j].z * rstd * gg.z) | (f2bf(v[j].w * rstd * gg.w) << 16);
            o8[64 * j] = (unsigned long long)lo | ((unsigned long long)hi << 32);
        }
    }
}

__device__ __forceinline__ void phase_x2bf(Frame& F, const float* x, bf16* out, float* ss) {
    const int gw = F.vcu * NWAVES + F.wave, NGW = F.G * NWAVES;
    typedef float f32x4 __attribute__((ext_vector_type(4)));
    for (int m = 2 * gw; m < M; m += 2 * NGW) {
        f32x4 v[2][4]; float s[2] = {0.f, 0.f};
#pragma unroll
        for (int rr = 0; rr < 2; ++rr) { const f32x4* xr = (const f32x4*)(x + (size_t)(m + rr) * D) + F.lane;
#pragma unroll
            for (int j = 0; j < 4; ++j) v[rr][j] = xr[64 * j]; }
#pragma unroll
        for (int rr = 0; rr < 2; ++rr) {
#pragma unroll
            for (int j = 0; j < 4; ++j) s[rr] += (v[rr][j].x * v[rr][j].x + v[rr][j].y * v[rr][j].y) + (v[rr][j].z * v[rr][j].z + v[rr][j].w * v[rr][j].w);
            s[rr] = wave_sum(s[rr], F.lane);
            if (F.lane == 0) ss[m + rr] = s[rr];
            unsigned long long* o8 = (unsigned long long*)(out + (size_t)(m + rr) * D) + F.lane;
#pragma unroll
            for (int j = 0; j < 4; ++j) { const unsigned lo = pg8::cvt_pk_f16(v[rr][j].x, v[rr][j].y), hi = pg8::cvt_pk_f16(v[rr][j].z, v[rr][j].w); o8[64 * j] = (unsigned long long)lo | ((unsigned long long)hi << 32); }
        }
    }
}
__device__ __forceinline__ void gemm_tile_acc(int tid, LAS float* lds, const bf16* A, int lda, const float* W, int ldw, int N, int K, int tm, int tn, float (&acc)[8][4]) {
    const int tx = tid & 31, ty = tid >> 5;
    LAS float* As = lds; LAS float* Bs = lds + 16 * 132;
    const int arow = tid >> 2, akq = (tid & 3) * 4, bk = tid >> 5, bn = (tid & 31) * 4;
    for (int k0 = 0; k0 < K; k0 += 16) {
        const unsigned long long av = *(const unsigned long long*)(A + (size_t)(tm * 128 + arow) * lda + k0 + akq);
#pragma unroll
        for (int e = 0; e < 4; ++e) As[(akq + e) * 132 + arow] = bf2f((unsigned)(av >> (16 * e)) & 0xffffu);
        const int n0 = tn * 128 + bn;
        const float* wp = W + (size_t)(k0 + bk) * ldw + n0;
#pragma unroll
        for (int e = 0; e < 4; ++e) Bs[bk * 132 + bn + e] = (n0 + e < N) ? wp[e] : 0.f;
        __syncthreads();
#pragma unroll 2
        for (int kk = 0; kk < 16; ++kk) {
            float a[8], b[4];
#pragma unroll
            for (int i = 0; i < 8; ++i) a[i] = As[kk * 132 + ty * 8 + i];
#pragma unroll
            for (int j = 0; j < 4; ++j) b[j] = Bs[kk * 132 + tx * 4 + j];
#pragma unroll
            for (int i = 0; i < 8; ++i)
#pragma unroll
                for (int j = 0; j < 4; ++j) acc[i][j] += a[i] * b[j];
        }
        __syncthreads();
    }
}
template <class Epi>
__device__ __forceinline__ void gemm_naive(Frame& F, const bf16* A, int lda, const float* W, int ldw, int N, int K, const Epi& epi) {
    const int tx = F.tid & 31, ty = F.tid >> 5;
    const int ntm = M / 128, ntn = (N + 127) / 128;
    for (int tile = F.vcu; tile < ntm * ntn; tile += F.G) {
        const int tm = tile / ntn, tn = tile % ntn;
        float acc[8][4];
#pragma unroll
        for (int i = 0; i < 8; ++i)
#pragma unroll
            for (int j = 0; j < 4; ++j) acc[i][j] = 0.f;
        gemm_tile_acc(F.tid, (LAS float*)F.lds, A, lda, W, ldw, N, K, tm, tn, acc);
#pragma unroll
        for (int i = 0; i < 8; ++i)
#pragma unroll
            for (int j = 0; j < 4; ++j) { const int m = tm * 128 + ty * 8 + i, n = tn * 128 + tx * 4 + j; if (n < N) epi(m, n, acc[i][j]); }
    }
}

struct EpiMix {
    unsigned char* ws;
    __device__ __forceinline__ void operator()(int m, int n, float v) const {
        bf16* p;
        if (n < 512) p = (bf16*)(ws + Z_R) + (size_t)m * 512 + n;
        else if (n < 1024) p = (bf16*)(ws + Z_K) + (size_t)m * 512 + (n - 512);
        else if (n < 1536) p = (bf16*)(ws + Z_V) + (size_t)m * 512 + (n - 1024);
        else if (n < 1824) p = (bf16*)(ws + Z_L) + (size_t)m * 288 + (n - 1536);
        else if (n < 2336) p = (bf16*)(ws + Z_BX) + (size_t)m * 512 + (n - 1824);
        else if (n < 2848) p = (bf16*)(ws + Z_BY) + (size_t)m * 512 + (n - 2336);
        else if (n < 3616) p = (bf16*)(ws + A_Q) + (size_t)m * 768 + (n - 2848);
        else if (n < 4384) p = (bf16*)(ws + A_K) + (size_t)m * 768 + (n - 3616);
        else p = (bf16*)(ws + A_V) + (size_t)m * 768 + (n - 4384);
        *p = (bf16)f2bf(v);
    }
};
struct EpiGate { bf16* o; __device__ __forceinline__ void operator()(int m, int n, float v) const { o[(size_t)m * NGATE + n] = (bf16)f2bf(sigmoidf_(v)); } };
struct EpiBf { bf16* o; int ld; __device__ __forceinline__ void operator()(int m, int n, float v) const { o[(size_t)m * ld + n] = (bf16)f2bf(v); } };
struct EpiRelu2 { bf16* o; int ld; __device__ __forceinline__ void operator()(int m, int n, float v) const { const float r = v > 0.f ? v : 0.f; o[(size_t)m * ld + n] = (bf16)f2bf(r * r); } };
struct EpiRes { const float* base; float* o; __device__ __forceinline__ void operator()(int m, int n, float v) const { o[(size_t)m * D + n] = base[(size_t)m * D + n] + v; } };

__device__ __forceinline__ void phase_merge_naive(Frame& F, const bf16* OA, const bf16* OB, const bf16* OC, const float* pa, const float* pb, const float* pc, const bf16* gates, bf16* out) {
    const int tx = F.tid & 31, ty = F.tid >> 5;
    const int ntm = M / 128, ntn = D / 128;
    for (int tile = F.vcu; tile < ntm * ntn; tile += F.G) {
        const int tm = tile / ntn, tn = tile % ntn;
        float tot[8][4];
#pragma unroll
        for (int i = 0; i < 8; ++i)
#pragma unroll
            for (int j = 0; j < 4; ++j) tot[i][j] = 0.f;
#pragma unroll 1
        for (int br = 0; br < 3; ++br) {
            float acc[8][4];
#pragma unroll
            for (int i = 0; i < 8; ++i)
#pragma unroll
                for (int j = 0; j < 4; ++j) acc[i][j] = 0.f;
            const bf16* A = br == 0 ? OA : (br == 1 ? OB : OC); const int lda = br == 2 ? 256 : 512; const float* W = br == 0 ? pa : (br == 1 ? pb : pc);
            gemm_tile_acc(F.tid, (LAS float*)F.lds, A, lda, W, D, D, lda, tm, tn, acc);
#pragma unroll
            for (int i = 0; i < 8; ++i)
#pragma unroll
                for (int j = 0; j < 4; ++j) { const int m = tm * 128 + ty * 8 + i, n = tn * 128 + tx * 4 + j; tot[i][j] += bf2f(gates[(size_t)m * NGATE + br * D + n]) * acc[i][j]; }
        }
#pragma unroll
        for (int i = 0; i < 8; ++i)
#pragma unroll
            for (int j = 0; j < 4; ++j) { const int m = tm * 128 + ty * 8 + i, n = tn * 128 + tx * 4 + j; out[(size_t)m * D + n] = (bf16)f2bf(tot[i][j]); }
    }
}

struct RwkvP { const float *mu, *w0, *w_up, *a0, *a_up, *g_up, *k_k, *k_a, *r_k, *ln_g, *ln_b; };
__device__ __forceinline__ void rwkv_naive_item(Frame& F, unsigned char* ws, const RwkvP& P, int b, int h) {
    LAS float* L = (LAS float*)F.lds;
    LAS float* Lr = L;
    LAS float* Lk = L + 1024;
    LAS float* Lv = L + 2048;
    LAS float* Ltw = L + 3072;
    LAS float* Lxa = L + 4096;
    LAS float* Lsg = L + 5120;
    LAS float* Lw = L + 7680;
    LAS float* La = L + 8704;
    LAS float* Lg = L + 9728;
    LAS float* Lan = L + 10752;
    LAS float* Lb = L + 11776;
    LAS float* Lbo = L + 12800;
    const bf16* ZR = (const bf16*)(ws + Z_R); const bf16* ZK = (const bf16*)(ws + Z_K); const bf16* ZV = (const bf16*)(ws + Z_V); const bf16* ZL = (const bf16*)(ws + Z_L);
    bf16* OA = (bf16*)(ws + WS_OA);
    const int tid = F.tid, lane = F.lane, wave = F.wave;
    typedef float f32x4s __attribute__((ext_vector_type(4)));
    LAS f32x4s* Ls = (LAS f32x4s*)(L + 13312);
    if (wave == 0) {
#pragma unroll
        for (int j4 = 0; j4 < 16; ++j4) Ls[j4 * 64 + lane] = (f32x4s){0.f, 0.f, 0.f, 0.f};
    }
#pragma unroll 1
    for (int blk = 0; blk < SEQ / 16; ++blk) {
        const int t0 = blk * 16;
#pragma unroll 1
        for (int idx = tid; idx < 16 * 480; idx += NTHR) {
            const int tt = idx / 480, c = idx % 480; const int t = t0 + tt; const size_t m = (size_t)b * SEQ + t;
            float cur, prev = 0.f, mu;
            if (c < 192) { const int which = c / 64, j = c % 64, col = h * 64 + j; const bf16* Zp = which == 0 ? ZR : (which == 1 ? ZK : ZV);
                cur = bf2f(Zp[m * 512 + col]); if (t > 0) prev = bf2f(Zp[(m - 1) * 512 + col]); mu = P.mu[which * 512 + col];
                const float f = cur + (prev - cur) * mu; (which == 0 ? Lr : (which == 1 ? Lk : Lv))[tt * 64 + j] = f;
            } else { const int cc = c - 192;
                cur = bf2f(ZL[m * 288 + cc]); if (t > 0) prev = bf2f(ZL[(m - 1) * 288 + cc]); mu = P.mu[1536 + cc];
                const float f = cur + (prev - cur) * mu;
                if (cc < 64) Ltw[tt * 64 + cc] = tanhf(f); else if (cc < 128) Lxa[tt * 64 + cc - 64] = f; else Lsg[tt * 160 + cc - 128] = sigmoidf_(f);
            }
        }
        __syncthreads();
#pragma unroll 1
        for (int idx = tid; idx < 1024; idx += NTHR) {
            const int tt = idx >> 6, j = idx & 63, col = h * 64 + j;
            float wl = P.w0[col], al = P.a0[col], gg = 0.f;
#pragma unroll 4
            for (int c = 0; c < 64; ++c) { wl += Ltw[tt * 64 + c] * P.w_up[c * 512 + col]; al += Lxa[tt * 64 + c] * P.a_up[c * 512 + col]; }
#pragma unroll 4
            for (int c = 0; c < 160; ++c) gg += Lsg[tt * 160 + c] * P.g_up[c * 512 + col];
            const float w = -softplusf_(-wl) - 0.5f;
            Lw[idx] = expf(-expf(w)); La[idx] = sigmoidf_(al); Lg[idx] = gg;
        }
        __syncthreads();
#pragma unroll
        for (int q = 0; q < 2; ++q) {
            const int tt = 2 * wave + q, col = h * 64 + lane;
            const float kraw = Lk[tt * 64 + lane], kkv = kraw * P.k_k[col];
            const float n2 = wave_sum(kkv * kkv, lane); const float kkn = kkv / fmaxf(sqrtf(n2), 1e-12f);
            const float a = La[tt * 64 + lane]; const float kmod = kraw * (1.f + (a - 1.f) * P.k_a[col]);
            const float bo = wave_sum(Lr[tt * 64 + lane] * kmod * P.r_k[col], lane);
            Lk[tt * 64 + lane] = kmod; Lan[tt * 64 + lane] = -kkn; Lb[tt * 64 + lane] = kkn * a;
            if (lane == 0) Lbo[tt] = bo;
        }
        __syncthreads();
        if (wave == 0) {
            const int col = h * 64 + lane; const float lng = P.ln_g[col], lnb = P.ln_b[col];
            float S[64];
#pragma unroll
            for (int j4 = 0; j4 < 16; ++j4) { const f32x4s s4 = Ls[j4 * 64 + lane]; S[4 * j4] = s4.x; S[4 * j4 + 1] = s4.y; S[4 * j4 + 2] = s4.z; S[4 * j4 + 3] = s4.w; }
#pragma unroll 1
            for (int tt = 0; tt < 16; ++tt) {
                typedef float f32x4 __attribute__((ext_vector_type(4)));
                float sa = 0.f;
#pragma unroll
                for (int j4 = 0; j4 < 16; ++j4) { const f32x4 an = *(const LAS f32x4*)(Lan + tt * 64 + 4 * j4);
                    sa += S[4 * j4] * an.x + S[4 * j4 + 1] * an.y + S[4 * j4 + 2] * an.z + S[4 * j4 + 3] * an.w; __builtin_amdgcn_sched_barrier(0); }
                const float vi = Lv[tt * 64 + lane]; float y = 0.f;
#pragma unroll
                for (int j4 = 0; j4 < 16; ++j4) {
                    const f32x4 w4 = *(const LAS f32x4*)(Lw + tt * 64 + 4 * j4), b4 = *(const LAS f32x4*)(Lb + tt * 64 + 4 * j4), k4 = *(const LAS f32x4*)(Lk + tt * 64 + 4 * j4), r4 = *(const LAS f32x4*)(Lr + tt * 64 + 4 * j4);
                    S[4 * j4] = S[4 * j4] * w4.x + sa * b4.x + vi * k4.x; S[4 * j4 + 1] = S[4 * j4 + 1] * w4.y + sa * b4.y + vi * k4.y;
                    S[4 * j4 + 2] = S[4 * j4 + 2] * w4.z + sa * b4.z + vi * k4.z; S[4 * j4 + 3] = S[4 * j4 + 3] * w4.w + sa * b4.w + vi * k4.w;
                    y += S[4 * j4] * r4.x + S[4 * j4 + 1] * r4.y + S[4 * j4 + 2] * r4.z + S[4 * j4 + 3] * r4.w; __builtin_amdgcn_sched_barrier(0); }
                const float mean = wave_sum(y, lane) * (1.f / 64.f); const float dy = y - mean; const float var = wave_sum(dy * dy, lane) * (1.f / 64.f);
                const float o = (dy * (1.f / sqrtf(var + GN_EPS)) * lng + lnb + Lbo[tt] * vi) * Lg[tt * 64 + lane];
                OA[((size_t)b * SEQ + t0 + tt) * 512 + col] = (bf16)f2bf(o);
            }
#pragma unroll
            for (int j4 = 0; j4 < 16; ++j4) Ls[j4 * 64 + lane] = (f32x4s){S[4 * j4], S[4 * j4 + 1], S[4 * j4 + 2], S[4 * j4 + 3]};
        }
        __syncthreads();
    }
}

__device__ __forceinline__ void lds_barrier() { asm volatile("s_waitcnt lgkmcnt(0)" ::: "memory"); __builtin_amdgcn_s_barrier(); asm volatile("" ::: "memory"); }
namespace rk {
typedef short bf16x8 __attribute__((ext_vector_type(8)));
typedef float f32x4 __attribute__((ext_vector_type(4)));
typedef unsigned u32x4 __attribute__((ext_vector_type(4)));
typedef unsigned u32x2 __attribute__((ext_vector_type(2)));
constexpr int T = 32, SEGLEN = 512, NSEG = SEQ / SEGLEN, TS = 36;
constexpr int O_WUPT = 0, O_AUPT = O_WUPT + 9216, O_GUPT = O_AUPT + 9216, O_VEC = O_GUPT + 21504;
constexpr int O_XR = O_VEC + 3712, O_XK = O_XR + 8192, O_XV = O_XK + 8192, O_LIN = O_XV + 8192;
constexpr int O_TXW = O_LIN, O_XA = O_LIN + 4608, O_SG = O_LIN + 9216;
constexpr int O_AT = O_LIN, O_RT = O_LIN + 4608, O_BT = O_LIN + 9216, O_KT = O_LIN + 13824;
constexpr int O_DEC = O_LIN + 19968, O_AA = O_DEC + 8192, O_GG = O_AA + 8192, O_SC = O_GG + 8192;
constexpr int O_BTT = O_SC + 256, O_KTT = O_BTT + 4608, O_VT = O_KTT + 4608, O_WL = O_VT + 4608;
constexpr int O_NM = O_WL + 512, O_AAK = O_NM + 2048, O_ARB = O_AAK + 2048, O_ARK = O_ARB + 1024, O_AH = O_ARK + 1024, O_AKH = O_AH + 4608, O_ATF = O_AKH + 1024, O_YB = O_ATF + 8192, O_END = O_YB + 8192;
static_assert(O_END <= 163840 - 512, "rwkv LDS map");
constexpr int V_W0 = 0, V_A0 = 64, V_KK = 128, V_KA = 192, V_RK = 256, V_LNG = 320, V_LNB = 384, V_MUR = 448, V_MUL = 640;

__device__ __forceinline__ unsigned cvtpk(float lo, float hi) { return pg8::cvt_pk_bf16(lo, hi); }
__device__ __forceinline__ bf16x8 mk8(u32x2 lo, u32x2 hi) { u32x4 v = {lo.x, lo.y, hi.x, hi.y}; return __builtin_bit_cast(bf16x8, v); }
__device__ __forceinline__ float shx(float v, int o, int lane) { return __builtin_bit_cast(float, __builtin_amdgcn_ds_bpermute((lane ^ o) << 2, __builtin_bit_cast(int, v))); }
__device__ __forceinline__ float row_sum16(float x) {
    x += __builtin_bit_cast(float, __builtin_amdgcn_update_dpp(0, __builtin_bit_cast(int, x), 0x128, 0xf, 0xf, true));
    x += __builtin_bit_cast(float, __builtin_amdgcn_update_dpp(0, __builtin_bit_cast(int, x), 0x124, 0xf, 0xf, true));
    x += __builtin_bit_cast(float, __builtin_amdgcn_update_dpp(0, __builtin_bit_cast(int, x), 0x122, 0xf, 0xf, true));
    x += __builtin_bit_cast(float, __builtin_amdgcn_update_dpp(0, __builtin_bit_cast(int, x), 0x121, 0xf, 0xf, true));
    return x; }
#define RK_MFMA(a, b, c) __builtin_amdgcn_mfma_f32_16x16x32_bf16((a), (b), (c), 0, 0, 0)

template <int PART  >
__device__ __forceinline__ void lora_inputs(Frame& F, unsigned char* ws, const float* mu, const float* ss) {
    const bf16* ZL = (const bf16*)(ws + Z_L); bf16* ZT = (bf16*)(ws + WS_ZT);
    LAS float* Zt = (LAS float*)(F.lds + 67584);
    const int lane = F.lane, wave = F.wave, tid = F.tid, fr = lane & 15, fq = lane >> 4;
    if constexpr (PART == 0) {
    { u32x4 wv[8];
#pragma unroll
      for (int k = 0; k < 8; ++k) { const int i = tid + NTHR * k, n = i >> 7, c = i & 127; wv[k] = *(const u32x4*)((const bf16*)(ws + WS_WTAIL) + (size_t)n * D + 8 * c); }
#pragma unroll
      for (int k = 0; k < 8; ++k) { const int i = tid + NTHR * k, n = i >> 7, c = i & 127; *(LAS u32x4*)(F.lds + n * 2064 + c * 16) = wv[k]; } }
    __syncthreads();
#pragma unroll 1
    for (int blk = F.vcu; blk < M / 64; blk += F.G) {
        const int r0 = 64 * blk;
        if (tid < 32) Zt[tid] = 0.f;
        __syncthreads();
        if (wave < 4) {
            const int mt = wave, row = r0 + 16 * mt + fr;
            const bf16x8* ap = (const bf16x8*)((const bf16*)(ws + WS_XB) + (size_t)row * D + 8 * fq);
            bf16x8 af[32];
#pragma unroll
            for (int s = 0; s < 32; ++s) af[s] = ap[4 * s];
            f32x4 acc0 = (f32x4){0.f, 0.f, 0.f, 0.f}, acc1 = acc0;
#pragma unroll
            for (int s = 0; s < 32; ++s) { acc0 = pg8::mfma16(true, af[s], *(const LAS bf16x8*)(F.lds + fr * 2064 + (32 * s + 8 * fq) * 2), acc0); acc1 = pg8::mfma16(true, af[s], *(const LAS bf16x8*)(F.lds + (16 + fr) * 2064 + (32 * s + 8 * fq) * 2), acc1); }
#pragma unroll
            for (int r = 0; r < 4; ++r) { const int rl = 16 * mt + 4 * fq + r; const float rs = __builtin_amdgcn_rsqf(ss[r0 + rl] * (1.f / 1024.f) + RMS_EPS);
                Zt[(rl + 1) * 33 + fr] = acc0[r] * rs; Zt[(rl + 1) * 33 + 16 + fr] = acc1[r] * rs; }
        } else if ((r0 & (SEQ - 1)) != 0) {
            const int t2 = tid - 256, c = t2 & 31, kc = t2 >> 5;
            const u32x4* xp = (const u32x4*)((const bf16*)(ws + WS_XB) + (size_t)(r0 - 1) * D + 128 * kc);
            float s = 0.f;
#pragma unroll 4
            for (int i = 0; i < 16; ++i) { const u32x4 xv = xp[i]; const u32x4 wv = *(const LAS u32x4*)(F.lds + c * 2064 + (128 * kc + 8 * i) * 2);
#pragma unroll
                for (int e = 0; e < 4; ++e) s += pg8::hfl(xv[e]) * pg8::hfl(wv[e]) + pg8::hfh(xv[e]) * pg8::hfh(wv[e]); }
            s += shx(s, 32, lane);
            if (lane < 32) atomicAdd((float*)&Zt[c], s * __builtin_amdgcn_rsqf(ss[r0 - 1] * (1.f / 1024.f) + RMS_EPS));
        }
        __syncthreads();
        {
            const int i = tid >> 3, c4 = (tid & 7) * 4; const int m = r0 + i;
            float f[4];
#pragma unroll
            for (int e = 0; e < 4; ++e) { const float cur = Zt[(i + 1) * 33 + c4 + e], prev = (m & (SEQ - 1)) ? Zt[i * 33 + c4 + e] : 0.f; const float v = cur + (prev - cur) * mu[1536 + 256 + c4 + e];
                f[e] = __builtin_amdgcn_rcpf(1.f + __expf(-v)); }
            *(u32x2*)(ZT + (size_t)m * 224 + 192 + c4) = (u32x2){cvtpk(f[0], f[1]), cvtpk(f[2], f[3])};
        }
        __syncthreads();
    }
    } else {
    const int stride = F.G * NTHR;
    for (int it0 = F.vcu * NTHR + F.tid; it0 < M * 24; it0 += 3 * stride) {
        u32x4 cuv[3], puv[3];
#pragma unroll
        for (int u = 0; u < 3; ++u) { const int it = it0 + u * stride; cuv[u] = (u32x4){0u, 0u, 0u, 0u}; puv[u] = cuv[u];
            if (it < M * 24) { const int m = it / 24, p = it - m * 24; const int cc = p < 8 ? 8 * p : 128 + 8 * (p - 8);
                cuv[u] = *(const u32x4*)(ZL + (size_t)m * 288 + cc); if ((m & (SEQ - 1)) != 0) puv[u] = *(const u32x4*)(ZL + (size_t)(m - 1) * 288 + cc); } }
        __builtin_amdgcn_sched_barrier(0);
#pragma unroll
        for (int u = 0; u < 3; ++u) { const int it = it0 + u * stride; if (it < M * 24) { const int m = it / 24, p = it - m * 24; const int cc = p < 8 ? 8 * p : 128 + 8 * (p - 8);
            const u32x4 cu = cuv[u], pu = puv[u];
            float f[8];
#pragma unroll
            for (int e = 0; e < 4; ++e) { const float c0 = bf2f(cu[e] & 0xffffu), c1 = bf2f(cu[e] >> 16), p0 = bf2f(pu[e] & 0xffffu), p1 = bf2f(pu[e] >> 16);
                f[2 * e] = c0 + (p0 - c0) * mu[1536 + cc + 2 * e]; f[2 * e + 1] = c1 + (p1 - c1) * mu[1536 + cc + 2 * e + 1]; }
            if (p < 8) {
#pragma unroll
                for (int e = 0; e < 8; ++e) f[e] = 1.f - 2.f * __builtin_amdgcn_rcpf(1.f + __expf(2.f * f[e])); }
            else {
#pragma unroll
                for (int e = 0; e < 8; ++e) f[e] = __builtin_amdgcn_rcpf(1.f + __expf(-f[e])); }
            *(u32x4*)(ZT + (size_t)m * 224 + 8 * p) = (u32x4){cvtpk(f[0], f[1]), cvtpk(f[2], f[3]), cvtpk(f[4], f[5]), cvtpk(f[6], f[7])}; } }
    }
    }
}
template <int PASS>
__device__ __forceinline__ void item(Frame& F, unsigned char* ws, const RwkvP& P, int b, int h, int g) {
    LAS unsigned char* L = F.lds;
    const int tid = F.tid, lane = F.lane, wave = F.wave, fr = lane & 15, fq = lane >> 4;
    LAS float* VEC = (LAS float*)(L + O_VEC);
    const bf16* ZR = (const bf16*)(ws + Z_R); const bf16* ZK = (const bf16*)(ws + Z_K); const bf16* ZV = (const bf16*)(ws + Z_V); const bf16* ZL = (const bf16*)(ws + Z_L);
    float* SEGPQ = (float*)(ws + WS_RKPQ);
    const int itm = (b * 8 + h) * NSEG + g;
    {
        const int j = tid & 63, cg = tid >> 6;
        { float v[8];
#pragma unroll
          for (int e = 0; e < 8; ++e) v[e] = P.w_up[(cg * 8 + e) * 512 + h * 64 + j];
          *(LAS u32x4*)(L + O_WUPT + (j * 72 + cg * 8) * 2) = (u32x4){cvtpk(v[0], v[1]), cvtpk(v[2], v[3]), cvtpk(v[4], v[5]), cvtpk(v[6], v[7])};
#pragma unroll
          for (int e = 0; e < 8; ++e) v[e] = P.a_up[(cg * 8 + e) * 512 + h * 64 + j];
          *(LAS u32x4*)(L + O_AUPT + (j * 72 + cg * 8) * 2) = (u32x4){cvtpk(v[0], v[1]), cvtpk(v[2], v[3]), cvtpk(v[4], v[5]), cvtpk(v[6], v[7])}; }
#pragma unroll 1
        for (int c8 = cg; c8 < 20; c8 += 8) { float v[8];
#pragma unroll
          for (int e = 0; e < 8; ++e) v[e] = P.g_up[(c8 * 8 + e) * 512 + h * 64 + j];
          *(LAS u32x4*)(L + O_GUPT + (j * 168 + c8 * 8) * 2) = (u32x4){cvtpk(v[0], v[1]), cvtpk(v[2], v[3]), cvtpk(v[4], v[5]), cvtpk(v[6], v[7])}; }
        if (tid < 64) { const int c = h * 64 + tid; VEC[V_W0 + tid] = P.w0[c]; VEC[V_A0 + tid] = P.a0[c]; VEC[V_KK + tid] = P.k_k[c]; VEC[V_KA + tid] = P.k_a[c]; VEC[V_RK + tid] = P.r_k[c];
            VEC[V_LNG + tid] = P.ln_g[c]; VEC[V_LNB + tid] = P.ln_b[c]; VEC[V_MUR + tid] = P.mu[c]; VEC[V_MUR + 64 + tid] = P.mu[512 + c]; VEC[V_MUR + 128 + tid] = P.mu[1024 + c]; }
        if (tid < 288) VEC[V_MUL + tid] = P.mu[1536 + tid];
    }
    f32x4 Sreg[4];
    const int i0 = 16 * (wave & 3);
#pragma unroll
    for (int jt = 0; jt < 4; ++jt) Sreg[jt] = (f32x4){0.f, 0.f, 0.f, 0.f};
    if (PASS == 0) { if (wave >= 4) {
#pragma unroll
        for (int jt = 0; jt < 4; ++jt)
#pragma unroll
            for (int r = 0; r < 4; ++r) Sreg[jt][r] = (16 * jt + 4 * fq + r == i0 + fr) ? 1.f : 0.f; } }
    else if (wave < 4 && g > 0) {
        const float* Pb = SEGPQ + (size_t)((b * 8 + h) * NSEG) * 8192;
        f32x4 praw[4][2][2]; f32x4 qraw[4];
#define FOLD_LOAD_JT(GP, jt) do { const float* Pm_ = Pb + (size_t)(GP) * 8192; const float* Qm_ = Pm_ + 4096; \
            _Pragma("unroll") for (int r = 0; r < 4; ++r) qraw[jt][r] = Qm_[(16 * (jt) + 4 * fq + r) * 64 + i0 + fr]; \
            _Pragma("unroll") for (int s = 0; s < 2; ++s) { praw[jt][s][0] = *(const f32x4*)(Pm_ + (16 * (jt) + fr) * 64 + 32 * s + 4 * fq); praw[jt][s][1] = *(const f32x4*)(Pm_ + (16 * (jt) + fr) * 64 + 32 * s + 16 + 4 * fq); } } while (0)
#pragma unroll
        for (int jt = 0; jt < 4; ++jt) FOLD_LOAD_JT(0, jt);
#pragma unroll 1
        for (int gp = 0; gp < g; ++gp) {
            bf16x8 Sh[2], Sl[2];
#pragma unroll
            for (int s = 0; s < 2; ++s) { unsigned hi[4], lo[4];
#pragma unroll
                for (int e = 0; e < 4; ++e) { const float x0 = Sreg[2 * s + (e >> 1)][2 * (e & 1)], x1 = Sreg[2 * s + (e >> 1)][2 * (e & 1) + 1];
                    hi[e] = cvtpk(x0, x1); lo[e] = cvtpk(x0 - bf2f(hi[e] & 0xffffu), x1 - bf2f(hi[e] >> 16)); }
                Sh[s] = __builtin_bit_cast(bf16x8, (u32x4){hi[0], hi[1], hi[2], hi[3]}); Sl[s] = __builtin_bit_cast(bf16x8, (u32x4){lo[0], lo[1], lo[2], lo[3]}); }
            f32x4 Sn[4];
#pragma unroll
            for (int jt = 0; jt < 4; ++jt) {
                bf16x8 Ph[2], Pl[2]; Sn[jt] = qraw[jt];
#pragma unroll
                for (int s = 0; s < 2; ++s) { const f32x4 p0 = praw[jt][s][0], p1 = praw[jt][s][1]; unsigned hi[4], lo[4];
                    hi[0] = cvtpk(p0[0], p0[1]); hi[1] = cvtpk(p0[2], p0[3]); hi[2] = cvtpk(p1[0], p1[1]); hi[3] = cvtpk(p1[2], p1[3]);
                    lo[0] = cvtpk(p0[0] - bf2f(hi[0] & 0xffffu), p0[1] - bf2f(hi[0] >> 16)); lo[1] = cvtpk(p0[2] - bf2f(hi[1] & 0xffffu), p0[3] - bf2f(hi[1] >> 16));
                    lo[2] = cvtpk(p1[0] - bf2f(hi[2] & 0xffffu), p1[1] - bf2f(hi[2] >> 16)); lo[3] = cvtpk(p1[2] - bf2f(hi[3] & 0xffffu), p1[3] - bf2f(hi[3] >> 16));
                    Ph[s] = __builtin_bit_cast(bf16x8, (u32x4){hi[0], hi[1], hi[2], hi[3]}); Pl[s] = __builtin_bit_cast(bf16x8, (u32x4){lo[0], lo[1], lo[2], lo[3]}); }
                if (gp + 1 < g) FOLD_LOAD_JT(gp + 1, jt);
#pragma unroll
                for (int s = 0; s < 2; ++s) { Sn[jt] = RK_MFMA(Ph[s], Sh[s], Sn[jt]); Sn[jt] = RK_MFMA(Ph[s], Sl[s], Sn[jt]); Sn[jt] = RK_MFMA(Pl[s], Sh[s], Sn[jt]); }
            }
#pragma unroll
            for (int jt = 0; jt < 4; ++jt) Sreg[jt] = Sn[jt];
        }
#undef FOLD_LOAD_JT
    }
    __syncthreads();
    const int tseg0 = g * SEGLEN;
    u32x4 pre[5];
    {
        int ln0; asm volatile("v_mbcnt_lo_u32_b32 %0, -1, 0\n\tv_mbcnt_hi_u32_b32 %0, -1, %0" : "=v"(ln0));
        const int t0 = wave * 64 + ln0, cp = t0 % 60, rg = t0 / 60;
        const bf16* ZT = (const bf16*)(ws + WS_ZT);
        const bf16* src = cp < 8 ? ZR : (cp < 16 ? ZK : (cp < 24 ? ZV : (cp < 32 ? ZL : ZT))); const int ld = cp < 24 ? 512 : (cp < 32 ? 288 : 224), col = cp < 24 ? h * 64 + 8 * (cp & 7) : (cp < 32 ? 64 + 8 * (cp - 24) : 8 * (cp - 32));
#pragma unroll
        for (int e = 0; e < 5; ++e) { const int tt = tseg0 + 4 * rg - 1 + e; pre[e] = (u32x4){0u, 0u, 0u, 0u};
            if (t0 < 480 && tt >= 0 && (PASS == 1 || cp < 40)) pre[e] = *(const u32x4*)(src + ((size_t)b * SEQ + tt) * ld + col); }
    }
#pragma unroll 1
    for (int ch = 0; ch < SEGLEN / T; ++ch) {
        int lane_c; asm volatile("v_mbcnt_lo_u32_b32 %0, -1, 0\n\tv_mbcnt_hi_u32_b32 %0, -1, %0" : "=v"(lane_c));
        const int lane = lane_c, tid = wave * 64 + lane, fr = lane & 15, fq = lane >> 4;
        const int tc0 = tseg0 + ch * T;
        const size_t m0 = (size_t)b * SEQ + tc0;
        if (PASS == 1 && ch > 0) {
            const int t = tid >> 4, iq = tid & 15;
            const f32x4 y = *(const LAS f32x4*)(L + O_YB + (t * 64 + 4 * iq) * 4);
            float s1 = (y[0] + y[1]) + (y[2] + y[3]);
#pragma unroll
            for (int o = 1; o < 16; o <<= 1) s1 += shx(s1, o, lane);
            const float mean = s1 * (1.f / 64.f); const f32x4 dy = y - mean;
            float s2 = (dy[0] * dy[0] + dy[1] * dy[1]) + (dy[2] * dy[2] + dy[3] * dy[3]);
#pragma unroll
            for (int o = 1; o < 16; o <<= 1) s2 += shx(s2, o, lane);
            const float rstd = __builtin_amdgcn_rsqf(s2 * (1.f / 64.f) + GN_EPS), bo = ((LAS float*)(L + O_SC))[32 + t];
            const f32x4 gg = *(const LAS f32x4*)(L + O_GG + (t * 64 + 4 * iq) * 4);
            float o4[4];
#pragma unroll
            for (int e = 0; e < 4; ++e) { const int i = 4 * iq + e; const float vv = bf2f(((const LAS bf16*)(L + O_VT))[i * TS + t]); o4[e] = (dy[e] * rstd * VEC[V_LNG + i] + VEC[V_LNB + i] + bo * vv) * gg[e]; }
            *(u32x2*)((bf16*)(ws + WS_OA) + (m0 - T + t) * 512 + h * 64 + 4 * iq) = (u32x2){cvtpk(o4[0], o4[1]), cvtpk(o4[2], o4[3])};
        }
        for (int rp_ = 0; rp_ < ((RK_REP == 1) ? 3 : 1); ++rp_) {
        if (tid < 480 && (PASS == 1 || (tid % 60) < 40)) {
            const int cp = tid % 60, rg = tid / 60;
            if (cp < 32) {
                const int which = cp >> 3, p = cp & 7;
                const LAS float* muv = which < 3 ? VEC + V_MUR + which * 64 + 8 * p : VEC + V_MUL + 64 + 8 * p;
                float mu[8];
#pragma unroll
                for (int e = 0; e < 8; ++e) mu[e] = muv[e];
#pragma unroll
                for (int rr = 0; rr < 4; ++rr) { const int t = 4 * rg + rr; const u32x4 cu = pre[rr + 1], pu = pre[rr];
                    float f[8];
#pragma unroll
                    for (int e = 0; e < 4; ++e) { const float c0 = bf2f(cu[e] & 0xffffu), c1 = bf2f(cu[e] >> 16), p0 = bf2f(pu[e] & 0xffffu), p1 = bf2f(pu[e] >> 16);
                        f[2 * e] = c0 + (p0 - c0) * mu[2 * e]; f[2 * e + 1] = c1 + (p1 - c1) * mu[2 * e + 1]; }
                    if (which < 3) { LAS float* dst = (LAS float*)(L + (which == 0 ? O_XR : (which == 1 ? O_XK : O_XV))) + t * 64 + 8 * p;
                        *(LAS f32x4*)dst = (f32x4){f[0], f[1], f[2], f[3]}; *(LAS f32x4*)(dst + 4) = (f32x4){f[4], f[5], f[6], f[7]}; }
                    else *(LAS u32x4*)(L + O_XA + (t * 72 + 8 * p) * 2) = (u32x4){cvtpk(f[0], f[1]), cvtpk(f[2], f[3]), cvtpk(f[4], f[5]), cvtpk(f[6], f[7])};
                }
            } else {
#pragma unroll
                for (int rr = 0; rr < 4; ++rr) { const int t = 4 * rg + rr;
                    if (cp < 40) *(LAS u32x4*)(L + O_TXW + (t * 72 + 8 * (cp - 32)) * 2) = pre[rr + 1];
                    else *(LAS u32x4*)(L + O_SG + (t * 168 + 8 * (cp - 40)) * 2) = pre[rr + 1]; }
            }
            if (ch + 1 < SEGLEN / T && (RK_REP != 1 || rp_ == 2)) {
                const bf16* ZT = (const bf16*)(ws + WS_ZT);
                const bf16* src = cp < 8 ? ZR : (cp < 16 ? ZK : (cp < 24 ? ZV : (cp < 32 ? ZL : ZT))); const int ld = cp < 24 ? 512 : (cp < 32 ? 288 : 224), col = cp < 24 ? h * 64 + 8 * (cp & 7) : (cp < 32 ? 64 + 8 * (cp - 24) : 8 * (cp - 32));
#pragma unroll
                for (int e = 0; e < 5; ++e) pre[e] = *(const u32x4*)(src + (m0 + T + 4 * rg - 1 + e) * ld + col);
            }
        }
        __syncthreads();
        }
        for (int rp_ = 0; rp_ < ((RK_REP == 2) ? 3 : 1); ++rp_) {
        {
            const int nt = wave & 3, jn = 16 * nt + fr;
            if (wave < 4) {
                f32x4 aw[2];
#pragma unroll
                for (int mt = 0; mt < 2; ++mt) aw[mt] = (f32x4){0.f, 0.f, 0.f, 0.f};
#pragma unroll
                for (int s = 0; s < 2; ++s) {
                    const bf16x8 bw = *(const LAS bf16x8*)(L + O_WUPT + (jn * 72 + 32 * s + 8 * fq) * 2);
#pragma unroll
                    for (int mt = 0; mt < 2; ++mt) { const bf16x8 xw = *(const LAS bf16x8*)(L + O_TXW + ((16 * mt + fr) * 72 + 32 * s + 8 * fq) * 2); aw[mt] = RK_MFMA(xw, bw, aw[mt]); }
                }
                const float w0 = VEC[V_W0 + jn];
#pragma unroll
                for (int mt = 0; mt < 2; ++mt) {
                    float ldv[4];
#pragma unroll
                    for (int r = 0; r < 4; ++r) {
                        const float xq = -(aw[mt][r] + w0);
                        const float sp = fmaxf(xq, 0.f) + __logf(1.f + __expf(-fabsf(xq)));
                        ldv[r] = -__expf(-sp - 0.5f); }
                    ldv[1] += ldv[0]; ldv[2] += ldv[1]; ldv[3] += ldv[2];
                    const float tot = ldv[3];
                    const float s1 = shx(tot, 16, lane);
                    const float pair = tot + s1;
                    const float s2 = shx(pair, 32, lane);
                    const float excl = ((fq & 1) ? s1 : 0.f) + ((fq & 2) ? s2 : 0.f);
#pragma unroll
                    for (int r = 0; r < 4; ++r) ((LAS float*)(L + O_DEC))[(16 * mt + 4 * fq + r) * 64 + jn] = ldv[r] + excl;
                }
            } else {
                f32x4 ai[2], ag[2];
#pragma unroll
                for (int mt = 0; mt < 2; ++mt) { ai[mt] = (f32x4){0.f, 0.f, 0.f, 0.f}; ag[mt] = ai[mt]; }
#pragma unroll
                for (int s = 0; s < 2; ++s) {
                    const bf16x8 ba = *(const LAS bf16x8*)(L + O_AUPT + (jn * 72 + 32 * s + 8 * fq) * 2);
#pragma unroll
                    for (int mt = 0; mt < 2; ++mt) { const bf16x8 xa = *(const LAS bf16x8*)(L + O_XA + ((16 * mt + fr) * 72 + 32 * s + 8 * fq) * 2); ai[mt] = RK_MFMA(xa, ba, ai[mt]); }
                }
                if (PASS == 1) {
#pragma unroll
                    for (int s = 0; s < 5; ++s) {
                        const bf16x8 bg = *(const LAS bf16x8*)(L + O_GUPT + (jn * 168 + 32 * s + 8 * fq) * 2);
#pragma unroll
                        for (int mt = 0; mt < 2; ++mt) { const bf16x8 xg = *(const LAS bf16x8*)(L + O_SG + ((16 * mt + fr) * 168 + 32 * s + 8 * fq) * 2); ag[mt] = RK_MFMA(xg, bg, ag[mt]); }
                    }
                }
                const float a0 = VEC[V_A0 + jn];
#pragma unroll
                for (int mt = 0; mt < 2; ++mt)
#pragma unroll
                    for (int r = 0; r < 4; ++r) { const int t = 16 * mt + 4 * fq + r;
                        ((LAS float*)(L + O_AA))[t * 64 + jn] = __builtin_amdgcn_rcpf(1.f + __expf(-(ai[mt][r] + a0)));
                        if (PASS == 1) ((LAS float*)(L + O_GG))[t * 64 + jn] = ag[mt][r]; }
            }
        }
        __syncthreads();
        }
        for (int rp_ = 0; rp_ < ((RK_REP == 3) ? 3 : 1); ++rp_) {
        {
            const int t = tid >> 4, jq = tid & 15, q = t >> 4;
            const f32x4 xk = *(const LAS f32x4*)(L + O_XK + (t * 64 + 4 * jq) * 4), xr = *(const LAS f32x4*)(L + O_XR + (t * 64 + 4 * jq) * 4), aa = *(const LAS f32x4*)(L + O_AA + (t * 64 + 4 * jq) * 4);
            const f32x4 xv = *(const LAS f32x4*)(L + O_XV + (t * 64 + 4 * jq) * 4);
            const f32x4 kkc = *(const LAS f32x4*)(VEC + V_KK + 4 * jq), kac = *(const LAS f32x4*)(VEC + V_KA + 4 * jq), rkc = *(const LAS f32x4*)(VEC + V_RK + 4 * jq);
            f32x4 kkv, kmod; float n2 = 0.f, bo = 0.f;
#pragma unroll
            for (int e = 0; e < 4; ++e) { kkv[e] = xk[e] * kkc[e]; n2 += kkv[e] * kkv[e]; kmod[e] = xk[e] * (1.f + (aa[e] - 1.f) * kac[e]); bo += xr[e] * kmod[e] * rkc[e]; }
#pragma unroll
            for (int o = 1; o < 16; o <<= 1) { n2 += shx(n2, o, lane); bo += shx(bo, o, lane); }
            const float invn = 1.f / fmaxf(sqrtf(n2), 1e-12f);
            if (jq == 0) ((LAS float*)(L + O_SC))[32 + t] = bo;
            const f32x4 cum = *(const LAS f32x4*)(L + O_DEC + (t * 64 + 4 * jq) * 4);
            f32x4 cm1 = (f32x4){0.f, 0.f, 0.f, 0.f}; if (t & 15) cm1 = *(const LAS f32x4*)(L + O_DEC + ((t - 1) * 64 + 4 * jq) * 4);
            float a_t[4], r_t[4], b_t[4], k_t[4], Wv[4];
#pragma unroll
            for (int e = 0; e < 4; ++e) { const float W = __expf(cum[e]), Wm1 = __expf(cm1[e]), iW = __expf(-cum[e]); const float kk = kkv[e] * invn;
                a_t[e] = -kk * Wm1; r_t[e] = xr[e] * W; b_t[e] = kk * aa[e] * iW; k_t[e] = kmod[e] * iW; Wv[e] = W; }
            *(LAS f32x4*)(L + O_ATF + (t * 64 + 4 * jq) * 4) = (f32x4){a_t[0], a_t[1], a_t[2], a_t[3]};
            *(LAS u32x2*)(L + O_AT + (t * 72 + 4 * jq) * 2) = (u32x2){cvtpk(a_t[0], a_t[1]), cvtpk(a_t[2], a_t[3])};
            *(LAS u32x2*)(L + O_RT + (t * 72 + 4 * jq) * 2) = (u32x2){cvtpk(r_t[0], r_t[1]), cvtpk(r_t[2], r_t[3])};
            const unsigned b01 = cvtpk(b_t[0], b_t[1]), b23 = cvtpk(b_t[2], b_t[3]), k01 = cvtpk(k_t[0], k_t[1]), k23 = cvtpk(k_t[2], k_t[3]), v01 = cvtpk(xv[0], xv[1]), v23 = cvtpk(xv[2], xv[3]);
            *(LAS u32x2*)(L + O_BT + (t * 72 + 4 * jq) * 2) = (u32x2){b01, b23};
            *(LAS u32x2*)(L + O_KT + (t * 72 + 4 * jq) * 2) = (u32x2){k01, k23};
            LAS bf16* btt = (LAS bf16*)(L + O_BTT) + (4 * jq) * TS + t; LAS bf16* ktt = (LAS bf16*)(L + O_KTT) + (4 * jq) * TS + t; LAS bf16* vt = (LAS bf16*)(L + O_VT) + (4 * jq) * TS + t;
            btt[0] = (bf16)(b01 & 0xffffu); btt[TS] = (bf16)(b01 >> 16); btt[2 * TS] = (bf16)(b23 & 0xffffu); btt[3 * TS] = (bf16)(b23 >> 16);
            ktt[0] = (bf16)(k01 & 0xffffu); ktt[TS] = (bf16)(k01 >> 16); ktt[2 * TS] = (bf16)(k23 & 0xffffu); ktt[3 * TS] = (bf16)(k23 >> 16);
            vt[0] = (bf16)(v01 & 0xffffu); vt[TS] = (bf16)(v01 >> 16); vt[2 * TS] = (bf16)(v23 & 0xffffu); vt[3 * TS] = (bf16)(v23 >> 16);
            if ((t & 15) == 15) *(LAS f32x4*)(L + O_WL + (q * 64 + 4 * jq) * 4) = (f32x4){Wv[0], Wv[1], Wv[2], Wv[3]};
        }
        __syncthreads();
        }
        for (int rp_ = 0; rp_ < ((RK_REP == 4) ? 3 : 1); ++rp_) {
        {
            const int q = wave >> 2, tile = wave & 3;
            const int ao = (tile & 2) ? O_RT : O_AT, bo = (tile & 1) ? O_KT : O_BT;
            f32x4 acc = (f32x4){0.f, 0.f, 0.f, 0.f};
            if (PASS == 1 || tile < 2)
#pragma unroll
            for (int s = 0; s < 2; ++s) { const bf16x8 av = *(const LAS bf16x8*)(L + ao + ((16 * q + fr) * 72 + 32 * s + 8 * fq) * 2), bv = *(const LAS bf16x8*)(L + bo + ((16 * q + fr) * 72 + 32 * s + 8 * fq) * 2);
                acc = RK_MFMA(av, bv, acc); }
#pragma unroll
            for (int r = 0; r < 4; ++r) { const int t = 4 * fq + r; const bool keep = (tile & 2) ? (fr <= t) : (fr < t); const float v = keep ? acc[r] : 0.f;
                if (tile == 0) ((LAS float*)(L + O_NM))[q * 256 + fr * 16 + t] = v;
                else if (tile == 1) ((LAS float*)(L + O_AAK))[q * 256 + t * 16 + fr] = v;
                else if (tile == 2) ((LAS bf16*)(L + O_ARB))[q * 256 + t * 16 + fr] = (bf16)f2bf(v);
                else ((LAS bf16*)(L + O_ARK))[q * 256 + t * 16 + fr] = (bf16)f2bf(v); }
        }
        __syncthreads();
        }
        for (int rp_ = 0; rp_ < ((RK_REP == 5) ? 3 : 1); ++rp_) {
        if (wave < 2) {
            const int q = wave, j = lane; const LAS float* NT = (const LAS float*)(L + O_NM) + q * 256;
            float X[16];
#pragma unroll
            for (int t = 0; t < 16; ++t) X[t] = ((const LAS float*)(L + O_ATF))[(16 * q + t) * 64 + j];
#pragma unroll
            for (int s = 0; s < 15; ++s) {
#pragma unroll
                for (int t4 = (s + 1) / 4; t4 < 4; ++t4) { const f32x4 n4 = *(const LAS f32x4*)(NT + s * 16 + 4 * t4);
#pragma unroll
                    for (int e = 0; e < 4; ++e) if (4 * t4 + e > s) X[4 * t4 + e] += n4[e] * X[s]; }
            }
#pragma unroll
            for (int t = 0; t < 16; ++t) ((LAS bf16*)(L + O_AH))[(16 * q + t) * 72 + j] = (bf16)f2bf(X[t]);
        } else if (wave == 2) {
            const int q = (lane >> 4) & 1, sc = lane & 15; const LAS float* NT = (const LAS float*)(L + O_NM) + q * 256; const LAS float* Ak = (const LAS float*)(L + O_AAK) + q * 256;
            float X[16];
#pragma unroll
            for (int t = 0; t < 16; ++t) X[t] = Ak[t * 16 + sc];
#pragma unroll
            for (int s = 0; s < 15; ++s) {
#pragma unroll
                for (int t4 = (s + 1) / 4; t4 < 4; ++t4) { const f32x4 n4 = *(const LAS f32x4*)(NT + s * 16 + 4 * t4);
#pragma unroll
                    for (int e = 0; e < 4; ++e) if (4 * t4 + e > s) X[4 * t4 + e] += n4[e] * X[s]; }
            }
            if (lane < 32) {
#pragma unroll
                for (int t = 0; t < 16; ++t) ((LAS bf16*)(L + O_AKH))[q * 256 + t * 16 + sc] = (bf16)f2bf(X[t]); }
        }
        __syncthreads();
        }
        f32x4 Ssave[4];
#pragma unroll
        for (int jt = 0; jt < 4; ++jt) Ssave[jt] = Sreg[jt];
        for (int rp6_ = 0; rp6_ < ((RK_REP == 6) ? 3 : 1); ++rp6_) {
        if (RK_REP == 6) {
#pragma unroll
            for (int jt = 0; jt < 4; ++jt) Sreg[jt] = Ssave[jt]; }
        if (wave < 4 || PASS == 0) {
            const bool qpart = wave < 4;
#pragma unroll
            for (int q = 0; q < 2; ++q) {
                bf16x8 Sf[2];
#pragma unroll
                for (int s = 0; s < 2; ++s) Sf[s] = __builtin_bit_cast(bf16x8, (u32x4){cvtpk(Sreg[2 * s][0], Sreg[2 * s][1]), cvtpk(Sreg[2 * s][2], Sreg[2 * s][3]), cvtpk(Sreg[2 * s + 1][0], Sreg[2 * s + 1][1]), cvtpk(Sreg[2 * s + 1][2], Sreg[2 * s + 1][3])});
                const int rowA = (16 * q + fr) * 72;
                f32x4 U = (f32x4){0.f, 0.f, 0.f, 0.f};
#pragma unroll
                for (int s = 0; s < 2; ++s) { const bf16x8 af = mk8(*(const LAS u32x2*)(L + O_AH + (rowA + 32 * s + 4 * fq) * 2), *(const LAS u32x2*)(L + O_AH + (rowA + 32 * s + 16 + 4 * fq) * 2)); U = RK_MFMA(af, Sf[s], U); }
                u32x2 vv = {0u, 0u};
                if (qpart) { vv = *(const LAS u32x2*)(L + O_VT + ((i0 + fr) * TS + 16 * q + 4 * fq) * 2);
                    const bf16x8 akf = mk8(*(const LAS u32x2*)(L + O_AKH + (q * 256 + fr * 16 + 4 * fq) * 2), (u32x2){0u, 0u}); U = RK_MFMA(akf, mk8(vv, (u32x2){0u, 0u}), U); }
                const bf16x8 UV = mk8((u32x2){cvtpk(U[0], U[1]), cvtpk(U[2], U[3])}, vv);
                if (PASS == 1) {
                    f32x4 Y = (f32x4){0.f, 0.f, 0.f, 0.f};
#pragma unroll
                    for (int s = 0; s < 2; ++s) { const bf16x8 rf = mk8(*(const LAS u32x2*)(L + O_RT + (rowA + 32 * s + 4 * fq) * 2), *(const LAS u32x2*)(L + O_RT + (rowA + 32 * s + 16 + 4 * fq) * 2)); Y = RK_MFMA(rf, Sf[s], Y); }
                    const bf16x8 abf = mk8(*(const LAS u32x2*)(L + O_ARB + (q * 256 + fr * 16 + 4 * fq) * 2), *(const LAS u32x2*)(L + O_ARK + (q * 256 + fr * 16 + 4 * fq) * 2)); Y = RK_MFMA(abf, UV, Y);
#pragma unroll
                    for (int r = 0; r < 4; ++r) ((LAS float*)(L + O_YB))[(16 * q + 4 * fq + r) * 64 + i0 + fr] = Y[r];
                }
#pragma unroll
                for (int jt = 0; jt < 4; ++jt) {
                    const bf16x8 bkf = mk8(*(const LAS u32x2*)(L + O_BTT + ((16 * jt + fr) * TS + 16 * q + 4 * fq) * 2), *(const LAS u32x2*)(L + O_KTT + ((16 * jt + fr) * TS + 16 * q + 4 * fq) * 2));
                    Sreg[jt] = RK_MFMA(bkf, UV, Sreg[jt]);
                    const f32x4 wl = *(const LAS f32x4*)(L + O_WL + (q * 64 + 16 * jt + 4 * fq) * 4);
                    Sreg[jt] = Sreg[jt] * wl;
                }
            }
        }
        __syncthreads();
        }
    }
    if (PASS == 1) {
        int lane_c; asm volatile("v_mbcnt_lo_u32_b32 %0, -1, 0\n\tv_mbcnt_hi_u32_b32 %0, -1, %0" : "=v"(lane_c));
        const int lane = lane_c, tid = wave * 64 + lane;
        const size_t m0 = (size_t)b * SEQ + tseg0 + SEGLEN;
        const int t = tid >> 4, iq = tid & 15;
        const f32x4 y = *(const LAS f32x4*)(L + O_YB + (t * 64 + 4 * iq) * 4);
        float s1 = (y[0] + y[1]) + (y[2] + y[3]);
#pragma unroll
        for (int o = 1; o < 16; o <<= 1) s1 += shx(s1, o, lane);
        const float mean = s1 * (1.f / 64.f); const f32x4 dy = y - mean;
        float s2 = (dy[0] * dy[0] + dy[1] * dy[1]) + (dy[2] * dy[2] + dy[3] * dy[3]);
#pragma unroll
        for (int o = 1; o < 16; o <<= 1) s2 += shx(s2, o, lane);
        const float rstd = __builtin_amdgcn_rsqf(s2 * (1.f / 64.f) + GN_EPS), bo = ((LAS float*)(L + O_SC))[32 + t];
        const f32x4 gg = *(const LAS f32x4*)(L + O_GG + (t * 64 + 4 * iq) * 4);
        float o4[4];
#pragma unroll
        for (int e = 0; e < 4; ++e) { const int i = 4 * iq + e; const float vv = bf2f(((const LAS bf16*)(L + O_VT))[i * TS + t]); o4[e] = (dy[e] * rstd * VEC[V_LNG + i] + VEC[V_LNB + i] + bo * vv) * gg[e]; }
        *(u32x2*)((bf16*)(ws + WS_OA) + (m0 - T + t) * 512 + h * 64 + 4 * iq) = (u32x2){cvtpk(o4[0], o4[1]), cvtpk(o4[2], o4[3])};
    }
    if (PASS == 0) {
        float* dst = SEGPQ + (size_t)itm * 8192 + (wave < 4 ? 4096 : 0);
#pragma unroll
        for (int jt = 0; jt < 4; ++jt)
#pragma unroll
            for (int r = 0; r < 4; ++r) dst[(16 * jt + 4 * fq + r) * 64 + i0 + fr] = Sreg[jt][r];
    }
    __syncthreads();
}
#undef RK_MFMA
}

namespace rk2 {
using rk::bf16x8; using rk::f32x4; using rk::u32x4; using rk::u32x2; using rk::cvtpk; using rk::mk8; using rk::shx;
using rk::V_W0; using rk::V_A0; using rk::V_KK; using rk::V_KA; using rk::V_RK; using rk::V_LNG; using rk::V_LNB; using rk::V_MUR; using rk::V_MUL;
constexpr int T = 32, SEGLEN = 512, NSEG = SEQ / SEGLEN, TS = 36;
constexpr int O_VEC = 0, O_XR = 3712, O_XK = O_XR + 8192, O_XV = O_XK + 8192;
constexpr int O_TXW = O_XV + 8192, O_XA = O_TXW + 4608, O_SG = O_XA + 4608;
constexpr int O_DEC = O_SG + 10752, O_AA = O_DEC + 8192, O_GG = O_AA + 8192  , O_SC = O_GG + 24576  ;
constexpr int O_AT = O_SC + 256, O_RT = O_AT + 4608, O_BT = O_RT + 4608, O_KT = O_BT + 4608;
constexpr int O_VB = O_KT + 4608  , O_WL = O_VB + 9216;
constexpr int O_NM = O_WL + 512, O_AAK = O_NM + 2048, O_ARB = O_AAK + 2048, O_ARK = O_ARB + 1024, O_AH = O_ARK + 1024, O_AKH = O_AH + 4608, O_ATF = O_AKH + 1024, O_YB = O_ATF + 8192  , O_END = O_YB + 16384;
static_assert(O_END <= 163840 - 512, "rk2 LDS map");
#define RK_MFMA(a, b, c) __builtin_amdgcn_mfma_f32_16x16x32_bf16((a), (b), (c), 0, 0, 0)
#define RK2_LANE() int lane_c_; asm volatile("v_mbcnt_lo_u32_b32 %0, -1, 0\n\tv_mbcnt_hi_u32_b32 %0, -1, %0" : "=v"(lane_c_)); const int lane = lane_c_, tid = wave * 64 + lane, fr = lane & 15, fq = lane >> 4; (void)tid; (void)fr; (void)fq;

typedef short v4i16_t __attribute__((ext_vector_type(4)));
__device__ __forceinline__ u32x2 tr4(LAS unsigned char* img, int tok0, int c0, int fr, int fq) {
    const v4i16_t v = __builtin_amdgcn_ds_read_tr16_b64_v4i16((LAS v4i16_t*)(img + ((tok0 + 4 * fq + (fr >> 2)) * 72 + c0 + 4 * (fr & 3)) * 2));
    return __builtin_bit_cast(u32x2, v); }
template <int PASS>
__device__ __forceinline__ void item(Frame& F, unsigned char* ws, const RwkvP& P, int b, int h, int g) {
    LAS unsigned char* L = F.lds;
    const int wave = F.wave;
    LAS float* VEC = (LAS float*)(L + O_VEC);
    const bf16* ZR = (const bf16*)(ws + Z_R); const bf16* ZK = (const bf16*)(ws + Z_K); const bf16* ZV = (const bf16*)(ws + Z_V); const bf16* ZL = (const bf16*)(ws + Z_L); const bf16* ZT = (const bf16*)(ws + WS_ZT);
    float* SEGPQ = (float*)(ws + WS_RKPQ);
    const int itm = (b * 8 + h) * NSEG + g;
    const int tseg0 = g * SEGLEN;
    u32x4 pre[1][5];
#define RK2_TASK(k, id, cp, rg) const int id = tid; int cp, rg; bool on_##k; \
    if (id < 64) { cp = 32 + (id & 7); rg = id >> 3; on_##k = true; } \
    else if (id < 192) { const int k_ = id - 64; cp = 40 + (k_ & 15); rg = k_ >> 4; on_##k = (PASS == 1); } \
    else if (id < 256) { const int k_ = id - 192; cp = 24 + (k_ & 7); rg = k_ >> 3; on_##k = true; } \
    else { const int k_ = id - 256; if (k_ < 192) { cp = k_ % 24; rg = k_ / 24; on_##k = true; } else { const int m_ = k_ - 192; cp = 56 + (m_ & 3); rg = (m_ >> 2) & 7; on_##k = (PASS == 1) && m_ < 32; } }
#define RK2_SRC(cp) const bf16* src = cp < 8 ? ZR : (cp < 16 ? ZK : (cp < 24 ? ZV : (cp < 32 ? ZL : ZT))); const int ld = cp < 24 ? 512 : (cp < 32 ? 288 : 224), col = cp < 24 ? h * 64 + 8 * (cp & 7) : (cp < 32 ? 64 + 8 * (cp - 24) : 8 * (cp - 32));
#define RK2_PREFETCH(k, tc0n) do { RK2_TASK(k, id_, cp_, rg_) if (on_##k) { RK2_SRC(cp_) _Pragma("unroll") for (int e = 0; e < 5; ++e) { const int tt = (tc0n) + 4 * rg_ - 1 + e; pre[k][e] = (u32x4){0u, 0u, 0u, 0u}; \
            if (tt >= 0) pre[k][e] = *(const u32x4*)(src + ((size_t)b * SEQ + tt) * ld + col); } } } while (0)
    { RK2_LANE(); RK2_PREFETCH(0, tseg0); }
    bf16x8 bw[2], ba[2], bg[5];
    f32x4 Sreg[4];
    const int i0 = 16 * (wave & 3);
    {
        RK2_LANE();
        {
            float cv[10]; float ml = 0.f;
            if (tid < 64) { const int c = h * 64 + tid; cv[0] = P.w0[c]; cv[1] = P.a0[c]; cv[2] = P.k_k[c]; cv[3] = P.k_a[c]; cv[4] = P.r_k[c]; cv[5] = P.ln_g[c]; cv[6] = P.ln_b[c]; cv[7] = P.mu[c]; cv[8] = P.mu[512 + c]; cv[9] = P.mu[1024 + c]; }
            if (tid < 288) ml = P.mu[1536 + tid];
            __builtin_amdgcn_sched_barrier(0);
            if (tid < 64) { VEC[V_W0 + tid] = cv[0]; VEC[V_A0 + tid] = cv[1]; VEC[V_KK + tid] = cv[2]; VEC[V_KA + tid] = cv[3]; VEC[V_RK + tid] = cv[4];
                VEC[V_LNG + tid] = cv[5]; VEC[V_LNB + tid] = cv[6]; VEC[V_MUR + tid] = cv[7]; VEC[V_MUR + 64 + tid] = cv[8]; VEC[V_MUR + 128 + tid] = cv[9]; }
            if (tid < 288) VEC[V_MUL + tid] = ml;
        }
#pragma unroll
        for (int jt = 0; jt < 4; ++jt) Sreg[jt] = (f32x4){0.f, 0.f, 0.f, 0.f};
        if (PASS == 0) { if (wave >= 4) {
#pragma unroll
            for (int jt = 0; jt < 4; ++jt)
#pragma unroll
                for (int r = 0; r < 4; ++r) Sreg[jt][r] = (16 * jt + 4 * fq + r == i0 + fr) ? 1.f : 0.f; } }
        else if (g > 0) {
            const unsigned char* Mb = (const unsigned char*)(SEGPQ + (size_t)((b * 8 + h) * NSEG) * 8192);
            constexpr int RING = 16384;
#define FOLD_ISSUE(GP) do { const unsigned char* m_ = Mb + (size_t)(GP) * 32768 + wave * 4096 + lane * 16; LAS unsigned char* d_ = L + RING + ((GP) & 3) * 32768 + wave * 4096; \
            _Pragma("unroll") for (int c_ = 0; c_ < 4; ++c_) __builtin_amdgcn_global_load_lds((const unsigned*)(m_ + c_ * 1024), (LAS unsigned*)(d_ + c_ * 1024), 16, 0, 0); } while (0)
            FOLD_ISSUE(0); if (g > 1) FOLD_ISSUE(1); if (g > 2) FOLD_ISSUE(2);
#pragma unroll 1
            for (int gp = 0; gp < g; ++gp) {
                const int later = (g < gp + 3 ? g : gp + 3) - gp - 1;
                if (later == 2) asm volatile("s_waitcnt vmcnt(8)" ::: "memory"); else if (later == 1) asm volatile("s_waitcnt vmcnt(4)" ::: "memory"); else asm volatile("s_waitcnt vmcnt(0)" ::: "memory");
                __builtin_amdgcn_s_barrier(); asm volatile("" ::: "memory");
                if (gp + 3 < g) FOLD_ISSUE(gp + 3);
                if (wave < 4) {
                    const LAS unsigned char* sl = L + RING + (gp & 3) * 32768;
                    bf16x8 Sh[2], Sl[2];
#pragma unroll
                    for (int s = 0; s < 2; ++s) { unsigned hi[4], lo[4];
#pragma unroll
                        for (int e = 0; e < 4; ++e) { const float x0 = Sreg[2 * s + (e >> 1)][2 * (e & 1)], x1 = Sreg[2 * s + (e >> 1)][2 * (e & 1) + 1];
                            hi[e] = cvtpk(x0, x1); lo[e] = cvtpk(x0 - bf2f(hi[e] & 0xffffu), x1 - bf2f(hi[e] >> 16)); }
                        Sh[s] = __builtin_bit_cast(bf16x8, (u32x4){hi[0], hi[1], hi[2], hi[3]}); Sl[s] = __builtin_bit_cast(bf16x8, (u32x4){lo[0], lo[1], lo[2], lo[3]}); }
                    f32x4 qv[4]; bf16x8 phv[4][2], plv[4][2];
#pragma unroll
                    for (int jt = 0; jt < 4; ++jt) { qv[jt] = *(const LAS f32x4*)(sl + ((wave * 4 + jt) * 64 + lane) * 16);
#pragma unroll
                        for (int s = 0; s < 2; ++s) { phv[jt][s] = *(const LAS bf16x8*)(sl + 16384 + ((jt * 2 + s) * 64 + lane) * 16); plv[jt][s] = *(const LAS bf16x8*)(sl + 24576 + ((jt * 2 + s) * 64 + lane) * 16); } }
                    __builtin_amdgcn_sched_barrier(0);
#pragma unroll
                    for (int jt = 0; jt < 4; ++jt) {
                        f32x4 acc = qv[jt];
#pragma unroll
                        for (int s = 0; s < 2; ++s) { acc = RK_MFMA(phv[jt][s], Sh[s], acc); acc = RK_MFMA(phv[jt][s], Sl[s], acc); acc = RK_MFMA(plv[jt][s], Sh[s], acc); }
                        Sreg[jt] = acc;
                    }
                }
            }
#undef FOLD_ISSUE
        }
    }
    {
        RK2_LANE();
        const int jn = h * 64 + 16 * (wave & 3) + fr;
#pragma unroll
        for (int s = 0; s < 2; ++s) { bw[s] = (bf16x8){0, 0, 0, 0, 0, 0, 0, 0}; ba[s] = bw[s]; }
#pragma unroll
        for (int s = 0; s < 5; ++s) bg[s] = (bf16x8){0, 0, 0, 0, 0, 0, 0, 0};
        if (wave >= 4) {
            float vw[2][8], va[2][8], vg[5][8];
#pragma unroll
            for (int s = 0; s < 2; ++s)
#pragma unroll
                for (int e = 0; e < 8; ++e) { vw[s][e] = P.w_up[(32 * s + 8 * fq + e) * 512 + jn]; va[s][e] = P.a_up[(32 * s + 8 * fq + e) * 512 + jn]; }
            if (PASS == 1) {
#pragma unroll
                for (int s = 0; s < 5; ++s)
#pragma unroll
                    for (int e = 0; e < 8; ++e) vg[s][e] = P.g_up[(32 * s + 8 * fq + e) * 512 + jn]; }
#pragma unroll
            for (int s = 0; s < 2; ++s) {
                bw[s] = __builtin_bit_cast(bf16x8, (u32x4){cvtpk(vw[s][0], vw[s][1]), cvtpk(vw[s][2], vw[s][3]), cvtpk(vw[s][4], vw[s][5]), cvtpk(vw[s][6], vw[s][7])});
                ba[s] = __builtin_bit_cast(bf16x8, (u32x4){cvtpk(va[s][0], va[s][1]), cvtpk(va[s][2], va[s][3]), cvtpk(va[s][4], va[s][5]), cvtpk(va[s][6], va[s][7])}); }
            if (PASS == 1) {
#pragma unroll
                for (int s = 0; s < 5; ++s) bg[s] = __builtin_bit_cast(bf16x8, (u32x4){cvtpk(vg[s][0], vg[s][1]), cvtpk(vg[s][2], vg[s][3]), cvtpk(vg[s][4], vg[s][5]), cvtpk(vg[s][6], vg[s][7])}); }
        }
    }
#define RK2_S1(k) do { RK2_TASK(k, id_, cp, rg) if (on_##k) { \
        if (cp < 32) { const int which = cp >> 3, p = cp & 7; const LAS float* muv = which < 3 ? VEC + V_MUR + which * 64 + 8 * p : VEC + V_MUL + 64 + 8 * p; float mu[8]; \
            _Pragma("unroll") for (int e = 0; e < 8; ++e) mu[e] = muv[e]; \
            _Pragma("unroll") for (int rr = 0; rr < 4; ++rr) { const int t = 4 * rg + rr; const u32x4 cu = pre[k][rr + 1], pu = pre[k][rr]; float f[8]; \
                _Pragma("unroll") for (int e = 0; e < 4; ++e) { const float c0 = bf2f(cu[e] & 0xffffu), c1 = bf2f(cu[e] >> 16), p0 = bf2f(pu[e] & 0xffffu), p1 = bf2f(pu[e] >> 16); \
                    f[2 * e] = c0 + (p0 - c0) * mu[2 * e]; f[2 * e + 1] = c1 + (p1 - c1) * mu[2 * e + 1]; } \
                if (which < 3) { LAS float* dst = (LAS float*)(L + (which == 0 ? O_XR : (which == 1 ? O_XK : O_XV))) + t * 64 + 8 * p; \
                    *(LAS f32x4*)dst = (f32x4){f[0], f[1], f[2], f[3]}; *(LAS f32x4*)(dst + 4) = (f32x4){f[4], f[5], f[6], f[7]}; } \
                else *(LAS u32x4*)(L + O_XA + (t * 72 + 8 * p) * 2) = (u32x4){cvtpk(f[0], f[1]), cvtpk(f[2], f[3]), cvtpk(f[4], f[5]), cvtpk(f[6], f[7])}; } } \
        else { _Pragma("unroll") for (int rr = 0; rr < 4; ++rr) { const int t = 4 * rg + rr; \
                if (cp < 40) *(LAS u32x4*)(L + O_TXW + (t * 72 + 8 * (cp - 32)) * 2) = pre[k][rr + 1]; else *(LAS u32x4*)(L + O_SG + (t * 168 + 8 * (cp - 40)) * 2) = pre[k][rr + 1]; } } } } while (0)
#define RK2_S2W(cn) do { const int jn = 16 * (wave & 3) + fr; f32x4 aw[2]; \
        _Pragma("unroll") for (int mt = 0; mt < 2; ++mt) aw[mt] = (f32x4){0.f, 0.f, 0.f, 0.f}; \
        { bf16x8 xwv[2][2]; _Pragma("unroll") for (int s = 0; s < 2; ++s) _Pragma("unroll") for (int mt = 0; mt < 2; ++mt) xwv[s][mt] = *(const LAS bf16x8*)(L + O_TXW + ((16 * mt + fr) * 72 + 32 * s + 8 * fq) * 2); \
          __builtin_amdgcn_sched_barrier(0);     \
          _Pragma("unroll") for (int s = 0; s < 2; ++s) _Pragma("unroll") for (int mt = 0; mt < 2; ++mt) aw[mt] = RK_MFMA(xwv[s][mt], bw[s], aw[mt]); } \
        const float w0 = VEC[V_W0 + jn]; \
        _Pragma("unroll") for (int mt = 0; mt < 2; ++mt) { float ldv[4]; \
            _Pragma("unroll") for (int r = 0; r < 4; ++r) ldv[r] = -0.8750387749145276f * __builtin_amdgcn_rcpf(1.f + __expf(-(aw[mt][r] + w0)));     \
            ldv[1] += ldv[0]; ldv[2] += ldv[1]; ldv[3] += ldv[2]; const float tot = ldv[3]; const float s1 = shx(tot, 16, lane); const float pair = tot + s1; const float s2 = shx(pair, 32, lane); \
            const float excl = ((fq & 1) ? s1 : 0.f) + ((fq & 2) ? s2 : 0.f); \
            _Pragma("unroll") for (int r = 0; r < 4; ++r) ((LAS float*)(L + O_DEC))[(16 * mt + 4 * fq + r) * 64 + jn] = ldv[r] + excl; } } while (0)
#define RK2_S2A(cn) do { const int jn = 16 * (wave & 3) + fr; f32x4 ai[2]; \
        _Pragma("unroll") for (int mt = 0; mt < 2; ++mt) ai[mt] = (f32x4){0.f, 0.f, 0.f, 0.f}; \
        { bf16x8 xav[2][2]; _Pragma("unroll") for (int s = 0; s < 2; ++s) _Pragma("unroll") for (int mt = 0; mt < 2; ++mt) xav[s][mt] = *(const LAS bf16x8*)(L + O_XA + ((16 * mt + fr) * 72 + 32 * s + 8 * fq) * 2); \
          __builtin_amdgcn_sched_barrier(0); \
          _Pragma("unroll") for (int s = 0; s < 2; ++s) _Pragma("unroll") for (int mt = 0; mt < 2; ++mt) ai[mt] = RK_MFMA(xav[s][mt], ba[s], ai[mt]); } \
        const float a0 = VEC[V_A0 + jn]; \
        _Pragma("unroll") for (int mt = 0; mt < 2; ++mt) _Pragma("unroll") for (int r = 0; r < 4; ++r) ((LAS float*)(L + O_AA))[(16 * mt + 4 * fq + r) * 64 + jn] = __builtin_amdgcn_rcpf(1.f + __expf(-(ai[mt][r] + a0))); } while (0)
#define RK2_S2G(cn) do { const int jn = 16 * (wave & 3) + fr; f32x4 ag[2]; \
        _Pragma("unroll") for (int mt = 0; mt < 2; ++mt) ag[mt] = (f32x4){0.f, 0.f, 0.f, 0.f}; \
        { bf16x8 xgv[5][2]; _Pragma("unroll") for (int s = 0; s < 5; ++s) _Pragma("unroll") for (int mt = 0; mt < 2; ++mt) xgv[s][mt] = *(const LAS bf16x8*)(L + O_SG + ((16 * mt + fr) * 168 + 32 * s + 8 * fq) * 2); \
          __builtin_amdgcn_sched_barrier(0); \
          _Pragma("unroll") for (int s = 0; s < 5; ++s) _Pragma("unroll") for (int mt = 0; mt < 2; ++mt) ag[mt] = RK_MFMA(xgv[s][mt], bg[s], ag[mt]); } \
        _Pragma("unroll") for (int mt = 0; mt < 2; ++mt) _Pragma("unroll") for (int r = 0; r < 4; ++r) ((LAS float*)(L + O_GG + ((cn) % 3) * 8192))[(16 * mt + 4 * fq + r) * 64 + jn] = ag[mt][r]; } while (0)
#define RK2_S7(cp_, t, iq) do { const int bufp = (cp_) & 1; \
        const f32x4 y = *(const LAS f32x4*)(L + O_YB + bufp * 8192 + ((t) * 64 + 4 * (iq)) * 4); float s1 = rk::row_sum16((y[0] + y[1]) + (y[2] + y[3])); \
        const float mean = s1 * (1.f / 64.f); const f32x4 dy = y - mean; const float s2 = rk::row_sum16((dy[0] * dy[0] + dy[1] * dy[1]) + (dy[2] * dy[2] + dy[3] * dy[3])); \
        const float rstd = __builtin_amdgcn_rsqf(s2 * (1.f / 64.f) + GN_EPS), bo = ((LAS float*)(L + O_SC))[bufp * 32 + (t)]; \
        const f32x4 gg = *(const LAS f32x4*)(L + O_GG + ((cp_) % 3) * 8192 + ((t) * 64 + 4 * (iq)) * 4); float o4[4]; \
        const u32x2 vb = *(const LAS u32x2*)(L + O_VB + bufp * 4608 + ((t) * 72 + 4 * (iq)) * 2); const float vf[4] = {bf2f(vb.x & 0xffffu), bf2f(vb.x >> 16), bf2f(vb.y & 0xffffu), bf2f(vb.y >> 16)}; \
        _Pragma("unroll") for (int e = 0; e < 4; ++e) { const int i = 4 * (iq) + e; o4[e] = (dy[e] * rstd * VEC[V_LNG + i] + VEC[V_LNB + i] + bo * vf[e]) * gg[e]; } \
        *(u32x2*)((bf16*)(ws + WS_OA) + ((size_t)b * SEQ + tseg0 + (cp_) * T + (t)) * 512 + h * 64 + 4 * (iq)) = (u32x2){cvtpk(o4[0], o4[1]), cvtpk(o4[2], o4[3])}; } while (0)

    lds_barrier();
    {
        RK2_LANE();
        RK2_S1(0); RK2_PREFETCH(0, tseg0 + T);
        lds_barrier();
        if (wave >= 4) { RK2_S2W(0); RK2_S2A(0); if (PASS == 1) RK2_S2G(0); }
        lds_barrier();
    }
#pragma unroll 1
    for (int ch = 0; ch < SEGLEN / T; ++ch) {
        RK2_LANE();
        const int buf = ch & 1;
        for (int rp1 = 0; rp1 < (RK2_REP == 1 ? 3 : 1); ++rp1) {
        {
            const int t = tid >> 4, jq = tid & 15, q = t >> 4;
            const f32x4 xk = *(const LAS f32x4*)(L + O_XK + (t * 64 + 4 * jq) * 4), xr = *(const LAS f32x4*)(L + O_XR + (t * 64 + 4 * jq) * 4), aa = *(const LAS f32x4*)(L + O_AA + (t * 64 + 4 * jq) * 4);
            const f32x4 xv = *(const LAS f32x4*)(L + O_XV + (t * 64 + 4 * jq) * 4);
            const f32x4 kkc = *(const LAS f32x4*)(VEC + V_KK + 4 * jq), kac = *(const LAS f32x4*)(VEC + V_KA + 4 * jq), rkc = *(const LAS f32x4*)(VEC + V_RK + 4 * jq);
            f32x4 kkv, kmod; float n2 = 0.f, bo = 0.f;
#pragma unroll
            for (int e = 0; e < 4; ++e) { kkv[e] = xk[e] * kkc[e]; n2 += kkv[e] * kkv[e]; kmod[e] = xk[e] * (1.f + (aa[e] - 1.f) * kac[e]); bo += xr[e] * kmod[e] * rkc[e]; }
            n2 = rk::row_sum16(n2); bo = rk::row_sum16(bo);
            const float invn = __builtin_amdgcn_rsqf(fmaxf(n2, 1e-24f));
            if (jq == 0) ((LAS float*)(L + O_SC))[buf * 32 + t] = bo;
            const f32x4 cum = *(const LAS f32x4*)(L + O_DEC + (t * 64 + 4 * jq) * 4);
            f32x4 cm1 = (f32x4){0.f, 0.f, 0.f, 0.f}; if (t & 15) cm1 = *(const LAS f32x4*)(L + O_DEC + ((t - 1) * 64 + 4 * jq) * 4);
            float a_t[4], r_t[4], b_t[4], k_t[4], Wv[4];
#pragma unroll
            for (int e = 0; e < 4; ++e) { const float W = __builtin_amdgcn_exp2f(cum[e]), Wm1 = __builtin_amdgcn_exp2f(cm1[e]), iW = __builtin_amdgcn_exp2f(-cum[e]); const float kk = kkv[e] * invn;
                a_t[e] = -kk * Wm1; r_t[e] = xr[e] * W; b_t[e] = kk * aa[e] * iW; k_t[e] = kmod[e] * iW; Wv[e] = W; }
            *(LAS f32x4*)(L + O_ATF + (t * 64 + 4 * jq) * 4) = (f32x4){a_t[0], a_t[1], a_t[2], a_t[3]};
            *(LAS u32x2*)(L + O_AT + (t * 72 + 4 * jq) * 2) = (u32x2){cvtpk(a_t[0], a_t[1]), cvtpk(a_t[2], a_t[3])};
            *(LAS u32x2*)(L + O_RT + (t * 72 + 4 * jq) * 2) = (u32x2){cvtpk(r_t[0], r_t[1]), cvtpk(r_t[2], r_t[3])};
            const unsigned b01 = cvtpk(b_t[0], b_t[1]), b23 = cvtpk(b_t[2], b_t[3]), k01 = cvtpk(k_t[0], k_t[1]), k23 = cvtpk(k_t[2], k_t[3]), v01 = cvtpk(xv[0], xv[1]), v23 = cvtpk(xv[2], xv[3]);
            *(LAS u32x2*)(L + O_BT + (t * 72 + 4 * jq) * 2) = (u32x2){b01, b23};
            *(LAS u32x2*)(L + O_KT + (t * 72 + 4 * jq) * 2) = (u32x2){k01, k23};
            *(LAS u32x2*)(L + O_VB + buf * 4608 + (t * 72 + 4 * jq) * 2) = (u32x2){v01, v23};
            if ((t & 15) == 15) *(LAS f32x4*)(L + O_WL + (q * 64 + 4 * jq) * 4) = (f32x4){Wv[0], Wv[1], Wv[2], Wv[3]};
        }
        lds_barrier();
        }
        for (int rp2 = 0; rp2 < (RK2_REP == 2 ? 3 : 1); ++rp2) {
        {
            const int q = wave >> 2, tile = wave & 3;
            const int ao = (tile & 2) ? O_RT : O_AT, bo = (tile & 1) ? O_KT : O_BT;
            f32x4 acc = (f32x4){0.f, 0.f, 0.f, 0.f};
            if (PASS == 1 || tile < 2)
#pragma unroll
            for (int s = 0; s < 2; ++s) { const bf16x8 av = *(const LAS bf16x8*)(L + ao + ((16 * q + fr) * 72 + 32 * s + 8 * fq) * 2), bv = *(const LAS bf16x8*)(L + bo + ((16 * q + fr) * 72 + 32 * s + 8 * fq) * 2);
                acc = RK_MFMA(av, bv, acc); }
            float vv[4];
#pragma unroll
            for (int r = 0; r < 4; ++r) { const int t = 4 * fq + r; const bool keep = (tile & 2) ? (fr <= t) : (fr < t); vv[r] = keep ? acc[r] : 0.f; }
            if (tile == 0) *(LAS f32x4*)((LAS float*)(L + O_NM) + q * 256 + fr * 16 + 4 * fq) = (f32x4){vv[0], vv[1], vv[2], vv[3]};
            else if (tile == 1) {
#pragma unroll
                for (int r = 0; r < 4; ++r) ((LAS float*)(L + O_AAK))[q * 256 + (4 * fq + r) * 16 + fr] = vv[r]; }
            else { LAS bf16* dst = (LAS bf16*)(L + (tile == 2 ? O_ARB : O_ARK)) + q * 256 + (4 * fq) * 16 + fr;
                const unsigned p01 = cvtpk(vv[0], vv[1]), p23 = cvtpk(vv[2], vv[3]);
                dst[0] = (bf16)(p01 & 0xffffu); dst[16] = (bf16)(p01 >> 16); dst[32] = (bf16)(p23 & 0xffffu); dst[48] = (bf16)(p23 >> 16); }
        }
        if (wave < 3 && ch + 1 < SEGLEN / T) { RK2_S1(0); if (ch + 2 < SEGLEN / T && (RK2_REP != 2 || rp2 == 2)) RK2_PREFETCH(0, tseg0 + (ch + 2) * T); }
        lds_barrier();
        }
        for (int rp3 = 0; rp3 < (RK2_REP == 3 ? 3 : 1); ++rp3) {
        if (wave < 2) {
            const int q = wave, j = lane; const LAS float* NT = (const LAS float*)(L + O_NM) + q * 256;
            float X[16];
#pragma unroll
            for (int t = 0; t < 16; ++t) X[t] = ((const LAS float*)(L + O_ATF))[(16 * q + t) * 64 + j];
#pragma unroll
            for (int s = 0; s < 15; ++s) {
#pragma unroll
                for (int t4 = (s + 1) / 4; t4 < 4; ++t4) { const f32x4 n4 = *(const LAS f32x4*)(NT + s * 16 + 4 * t4);
#pragma unroll
                    for (int e = 0; e < 4; ++e) if (4 * t4 + e > s) X[4 * t4 + e] += n4[e] * X[s]; }
            }
#pragma unroll
            for (int t = 0; t < 16; t += 2) { const unsigned pk = cvtpk(X[t], X[t + 1]);
                ((LAS bf16*)(L + O_AH))[(16 * q + t) * 72 + j] = (bf16)(pk & 0xffffu); ((LAS bf16*)(L + O_AH))[(16 * q + t + 1) * 72 + j] = (bf16)(pk >> 16); }
        } else if (wave == 2) {
            const int q = (lane >> 4) & 1, sc = lane & 15; const LAS float* NT = (const LAS float*)(L + O_NM) + q * 256; const LAS float* Ak = (const LAS float*)(L + O_AAK) + q * 256;
            float X[16];
#pragma unroll
            for (int t = 0; t < 16; ++t) X[t] = Ak[t * 16 + sc];
#pragma unroll
            for (int s = 0; s < 15; ++s) {
#pragma unroll
                for (int t4 = (s + 1) / 4; t4 < 4; ++t4) { const f32x4 n4 = *(const LAS f32x4*)(NT + s * 16 + 4 * t4);
#pragma unroll
                    for (int e = 0; e < 4; ++e) if (4 * t4 + e > s) X[4 * t4 + e] += n4[e] * X[s]; }
            }
            if (lane < 32) {
#pragma unroll
                for (int t = 0; t < 16; t += 2) { const unsigned pk = cvtpk(X[t], X[t + 1]);
                    ((LAS bf16*)(L + O_AKH))[q * 256 + t * 16 + sc] = (bf16)(pk & 0xffffu); ((LAS bf16*)(L + O_AKH))[q * 256 + (t + 1) * 16 + sc] = (bf16)(pk >> 16); } }
        } else if (PASS == 0 && wave >= 4 && ch + 1 < SEGLEN / T) {
            RK2_S2W(ch + 1);
        }
        if (wave >= 3 && ch + 1 < SEGLEN / T) { RK2_S1(0); if (ch + 2 < SEGLEN / T && (RK2_REP != 3 || rp3 == 2)) RK2_PREFETCH(0, tseg0 + (ch + 2) * T); }
        lds_barrier();
        }
        if (wave >= 4) {
            if (ch + 1 < SEGLEN / T) { if (PASS == 1) RK2_S2W(ch + 1); RK2_S2A(ch + 1); if (PASS == 1) RK2_S2G(ch + 1); }
        }
        if (wave < 4 || PASS == 0) {
            const bool qpart = wave < 4;
            u32x2 ahv[2][2][2], rtv[2][2][2], abv[2][2], akv[2], vvv[2], btv[2][4], ktv[2][4]; f32x4 wlv[2][4];
#pragma unroll
            for (int q = 0; q < 2; ++q) { const int rowA = (16 * q + fr) * 72;
#pragma unroll
                for (int s = 0; s < 2; ++s) { ahv[q][s][0] = *(const LAS u32x2*)(L + O_AH + (rowA + 32 * s + 4 * fq) * 2); ahv[q][s][1] = *(const LAS u32x2*)(L + O_AH + (rowA + 32 * s + 16 + 4 * fq) * 2);
                    if (PASS == 1) { rtv[q][s][0] = *(const LAS u32x2*)(L + O_RT + (rowA + 32 * s + 4 * fq) * 2); rtv[q][s][1] = *(const LAS u32x2*)(L + O_RT + (rowA + 32 * s + 16 + 4 * fq) * 2); } }
                vvv[q] = (u32x2){0u, 0u}; akv[q] = (u32x2){0u, 0u};
                if (qpart) { vvv[q] = tr4(L + O_VB + buf * 4608, 16 * q, i0, fr, fq); akv[q] = *(const LAS u32x2*)(L + O_AKH + (q * 256 + fr * 16 + 4 * fq) * 2); }
                if (PASS == 1) { abv[q][0] = *(const LAS u32x2*)(L + O_ARB + (q * 256 + fr * 16 + 4 * fq) * 2); abv[q][1] = *(const LAS u32x2*)(L + O_ARK + (q * 256 + fr * 16 + 4 * fq) * 2); }
#pragma unroll
                for (int jt = 0; jt < 4; ++jt) { btv[q][jt] = tr4(L + O_BT, 16 * q, 16 * jt, fr, fq); ktv[q][jt] = tr4(L + O_KT, 16 * q, 16 * jt, fr, fq); wlv[q][jt] = *(const LAS f32x4*)(L + O_WL + (q * 64 + 16 * jt + 4 * fq) * 4); } }
            __builtin_amdgcn_sched_barrier(0);
#pragma unroll
            for (int q = 0; q < 2; ++q) {
                bf16x8 Sf[2];
#pragma unroll
                for (int s = 0; s < 2; ++s) Sf[s] = __builtin_bit_cast(bf16x8, (u32x4){cvtpk(Sreg[2 * s][0], Sreg[2 * s][1]), cvtpk(Sreg[2 * s][2], Sreg[2 * s][3]), cvtpk(Sreg[2 * s + 1][0], Sreg[2 * s + 1][1]), cvtpk(Sreg[2 * s + 1][2], Sreg[2 * s + 1][3])});
                f32x4 U = (f32x4){0.f, 0.f, 0.f, 0.f};
#pragma unroll
                for (int s = 0; s < 2; ++s) U = RK_MFMA(mk8(ahv[q][s][0], ahv[q][s][1]), Sf[s], U);
                const u32x2 vv = vvv[q];
                if (qpart) U = RK_MFMA(mk8(akv[q], (u32x2){0u, 0u}), mk8(vv, (u32x2){0u, 0u}), U);
                const bf16x8 UV = mk8((u32x2){cvtpk(U[0], U[1]), cvtpk(U[2], U[3])}, vv);
                if (PASS == 1) {
                    f32x4 Y = (f32x4){0.f, 0.f, 0.f, 0.f};
#pragma unroll
                    for (int s = 0; s < 2; ++s) Y = RK_MFMA(mk8(rtv[q][s][0], rtv[q][s][1]), Sf[s], Y);
                    Y = RK_MFMA(mk8(abv[q][0], abv[q][1]), UV, Y);
#pragma unroll
                    for (int r = 0; r < 4; ++r) ((LAS float*)(L + O_YB + buf * 8192))[(16 * q + 4 * fq + r) * 64 + i0 + fr] = Y[r];
                }
#pragma unroll
                for (int jt = 0; jt < 4; ++jt) { Sreg[jt] = RK_MFMA(mk8(btv[q][jt], ktv[q][jt]), UV, Sreg[jt]); Sreg[jt] = Sreg[jt] * wlv[q][jt]; }
            }
            if (PASS == 1 && ch > 0) { RK2_S7(ch - 1, tid >> 4, tid & 15); RK2_S7(ch - 1, 16 + (tid >> 4), tid & 15); }
        }
        lds_barrier();
    }
    if (PASS == 1) { RK2_LANE(); RK2_S7(SEGLEN / T - 1, tid >> 4, tid & 15); }
    if (PASS == 0) {
        RK2_LANE();
        unsigned char* mp = (unsigned char*)(SEGPQ + (size_t)itm * 8192);
        LAS float* Pt = (LAS float*)L;
        if (wave < 4) {
#pragma unroll
            for (int jt = 0; jt < 4; ++jt) *(f32x4*)(mp + ((wave * 4 + jt) * 64 + lane) * 16) = Sreg[jt];
        } else {
#pragma unroll
            for (int jt = 0; jt < 4; ++jt)
#pragma unroll
                for (int r = 0; r < 4; ++r) Pt[(16 * jt + 4 * fq + r) * 65 + i0 + fr] = Sreg[jt][r];
        }
        lds_barrier();
        {
            const int jt = wave >> 1, s = wave & 1; const LAS float* pr = Pt + (16 * jt + fr) * 65 + 32 * s + 4 * fq;
            float p[8];
#pragma unroll
            for (int e = 0; e < 4; ++e) { p[e] = pr[e]; p[4 + e] = pr[16 + e]; }
            unsigned hi[4], lo[4];
#pragma unroll
            for (int e = 0; e < 4; ++e) { hi[e] = cvtpk(p[2 * e], p[2 * e + 1]); lo[e] = cvtpk(p[2 * e] - bf2f(hi[e] & 0xffffu), p[2 * e + 1] - bf2f(hi[e] >> 16)); }
            *(u32x4*)(mp + 16384 + ((jt * 2 + s) * 64 + lane) * 16) = (u32x4){hi[0], hi[1], hi[2], hi[3]};
            *(u32x4*)(mp + 24576 + ((jt * 2 + s) * 64 + lane) * 16) = (u32x4){lo[0], lo[1], lo[2], lo[3]};
        }
    }
    lds_barrier();
#undef RK2_TASK
#undef RK2_SRC
#undef RK2_PREFETCH
#undef RK2_S1
#undef RK2_S2W
#undef RK2_S2A
#undef RK2_S2G
#undef RK2_S7
}
#undef RK_MFMA
#undef RK2_LANE
}

struct LruP { const float *cw, *cb, *wa, *ba, *wx, *bx, *lam; };
__device__ __forceinline__ float gelu_tanh_(float x) { const float u = 0.7978845608028654f * (x + 0.044715f * x * x * x); return 0.5f * x * (1.f + tanhf(u)); }
__device__ __forceinline__ void lru_naive_item(Frame& F, unsigned char* ws, const LruP& P, int b, int blk) {
    LAS float* L = (LAS float*)F.lds;
    LAS float* Lxc = L;
    LAS float* Lwa = L + 4096;
    LAS float* Lwx = L + 8192;
    LAS float* Laa = L + 12288;
    LAS float* Lbb = L + 16384;
    const bf16* ZBX = (const bf16*)(ws + Z_BX); bf16* ZBY = (bf16*)(ws + Z_BY);
    const int tid = F.tid;
    for (int idx = tid; idx < 4096; idx += NTHR) { Lwa[idx] = P.wa[blk * 4096 + idx]; Lwx[idx] = P.wx[blk * 4096 + idx]; }
    float hcar = 0.f;
    for (int tile = 0; tile < SEQ / 64; ++tile) {
        const int t0 = tile * 64;
        __syncthreads();
        for (int idx = tid; idx < 4096; idx += NTHR) {
            const int tt = idx >> 6, c = idx & 63, ch = blk * 64 + c, t = t0 + tt;
            float s = P.cb[ch];
#pragma unroll
            for (int i = 0; i < 4; ++i) { const int ts = t - 3 + i; if (ts >= 0) s += P.cw[i * 512 + ch] * bf2f(ZBX[((size_t)b * SEQ + ts) * 512 + ch]); }
            Lxc[idx] = s;
        }
        __syncthreads();
        for (int idx = tid; idx < 4096; idx += NTHR) {
            const int tt = idx >> 6, j = idx & 63, ch = blk * 64 + j;
            float sa = P.ba[ch], sx = P.bx[ch];
            for (int i = 0; i < 64; ++i) { const float xv = Lxc[tt * 64 + i]; sa += xv * Lwa[i * 64 + j]; sx += xv * Lwx[i * 64 + j]; }
            const float ga = sigmoidf_(sa), gx = sigmoidf_(sx);
            const float log_a = -8.0f * ga * softplusf_(-P.lam[ch]);
            const float a = expf(log_a); float mult = sqrtf(fmaxf(-expm1f(2.f * log_a), 0.f));
            if (t0 + tt == 0) mult = 1.f;
            Laa[idx] = a; Lbb[idx] = Lxc[idx] * gx * mult;
        }
        __syncthreads();
        if (tid < 64) {
            const int ch = blk * 64 + tid;
            for (int tt = 0; tt < 64; ++tt) {
                hcar = Laa[tt * 64 + tid] * hcar + Lbb[tt * 64 + tid];
                const size_t off = ((size_t)b * SEQ + t0 + tt) * 512 + ch;
                ZBY[off] = (bf16)f2bf(hcar * gelu_tanh_(bf2f(ZBY[off])));
            }
        }
    }
    __syncthreads();
}

__device__ __forceinline__ int t5_bucket(int d) {
    if (d < 16) return d;
    int v = 16 + (int)(logf((float)d / 16.f) / logf(128.f) * 16.f);
    return v > 31 ? 31 : v;
}
__device__ __forceinline__ void attn_naive(Frame& F, unsigned char* ws, const float* relb, const float* qg, const float* kg, int worker, int nworkers) {
    LAS float* Lbias = (LAS float*)F.lds;
    for (int idx = F.tid; idx < 12 * 129; idx += NTHR) { const int hd = idx / 129, rel = idx % 129, g = hd >> 2; const int dil = g == 0 ? 1 : (g == 1 ? 4 : 16);
        Lbias[idx] = relb[t5_bucket(rel * dil) * 12 + hd]; }
    __syncthreads();
    bf16* AQ = (bf16*)(ws + A_Q); const bf16* AK = (const bf16*)(ws + A_K); const bf16* AV = (const bf16*)(ws + A_V); float* LSE = (float*)(ws + WS_LSE);
    for (long it2 = (long)worker * NTHR + F.tid; it2 < (long)M * 24; it2 += (long)nworkers * NTHR) {
        const long it = it2 >> 1; const int half = (int)(it2 & 1);
        const int m = (int)(it / 12), hd = (int)(it % 12), g = hd >> 2; const int dil = g == 0 ? 1 : (g == 1 ? 4 : 16);
        const int t = m % SEQ;
        float q[32]; float s2 = 0.f;
        const unsigned* qp = (const unsigned*)(AQ + (size_t)m * 768 + hd * 64 + half * 32);
#pragma unroll
        for (int j = 0; j < 16; ++j) { const unsigned u = qp[j]; q[2 * j] = bf2f(u & 0xffffu); q[2 * j + 1] = bf2f(u >> 16); s2 += q[2 * j] * q[2 * j] + q[2 * j + 1] * q[2 * j + 1]; }
        s2 += shfl_xor_l(s2, 1, F.lane);
        const float qs = (1.f / sqrtf(s2 * (1.f / 64.f) + RMS_EPS)) * 0.125f;
#pragma unroll
        for (int j = 0; j < 32; ++j) q[j] = q[j] * qs * qg[half * 32 + j] * kg[half * 32 + j];
        float o[32];
#pragma unroll
        for (int j = 0; j < 32; ++j) o[j] = 0.f;
        float mx = -1e30f, l = 0.f;
        for (int rel = 0; rel <= 128; ++rel) {
            const int tk = t - rel * dil; if (tk < 0) break;
            const size_t mk = (size_t)(m - rel * dil);
            const unsigned* kp = (const unsigned*)(AK + mk * 768 + hd * 64 + half * 32);
            float dot = 0.f, k2 = 0.f;
#pragma unroll
            for (int j = 0; j < 16; ++j) { const unsigned u = kp[j]; const float k0 = bf2f(u & 0xffffu), k1 = bf2f(u >> 16); dot += q[2 * j] * k0 + q[2 * j + 1] * k1; k2 += k0 * k0 + k1 * k1; }
            dot += shfl_xor_l(dot, 1, F.lane); k2 += shfl_xor_l(k2, 1, F.lane);
            const float logit = dot * (1.f / sqrtf(k2 * (1.f / 64.f) + RMS_EPS)) + Lbias[hd * 129 + rel];
            const float mn = fmaxf(mx, logit); const float sc = __expf(mx - mn), p = __expf(logit - mn);
            l = l * sc + p; mx = mn;
            const unsigned* vp = (const unsigned*)(AV + mk * 768 + hd * 64 + half * 32);
#pragma unroll
            for (int j = 0; j < 16; ++j) { const unsigned u = vp[j]; o[2 * j] = o[2 * j] * sc + p * bf2f(u & 0xffffu); o[2 * j + 1] = o[2 * j + 1] * sc + p * bf2f(u >> 16); }
        }
        const float il = 1.f / l;
        unsigned* op = (unsigned*)(AQ + (size_t)m * 768 + hd * 64 + half * 32);
#pragma unroll
        for (int j = 0; j < 16; ++j) op[j] = f2bf(o[2 * j] * il) | (f2bf(o[2 * j + 1] * il) << 16);
        if (half == 0) LSE[(size_t)m * 12 + hd] = mx + logf(l);
    }
}
namespace at {
typedef short bf16x8 __attribute__((ext_vector_type(8)));
typedef float f32x4 __attribute__((ext_vector_type(4)));
typedef unsigned u32x4 __attribute__((ext_vector_type(4)));
typedef unsigned u32x2 __attribute__((ext_vector_type(2)));
constexpr int O_KL = 0, O_VT = 36864, O_LB = O_VT + 33792, O_QKG = O_LB + 9216, O_END = O_QKG + 256;
#define AT_MFMA(a, b, c) __builtin_amdgcn_mfma_f32_16x16x32_bf16((a), (b), (c), 0, 0, 0)
__device__ __forceinline__ unsigned cvtpk(float lo, float hi) { return pg8::cvt_pk_bf16(lo, hi); }
__device__ __forceinline__ bf16x8 mk8(u32x2 lo, u32x2 hi) { u32x4 v = {lo.x, lo.y, hi.x, hi.y}; return __builtin_bit_cast(bf16x8, v); }
__device__ __forceinline__ float shx(float v, int o, int lane) { return __builtin_bit_cast(float, __builtin_amdgcn_ds_bpermute((lane ^ o) << 2, __builtin_bit_cast(int, v))); }

__device__ __forceinline__ void bias_table(Frame& F, const float* relb, const float* qg, const float* kg) {
    LAS float* Lb = (LAS float*)(F.lds + O_LB);
    if (F.tid < 64) ((LAS float*)(F.lds + O_QKG))[F.tid] = qg[F.tid] * kg[F.tid] * (0.125f * 1.4426950408889634f);
    {
        float bv[5];
#pragma unroll
        for (int u = 0; u < 5; ++u) { const int idx = F.tid + u * NTHR; bv[u] = -1e30f;
            if (idx < 12 * 192) { const int hd = idx / 192, rel = idx - hd * 192 - 32, g = hd >> 2; const int dil = g == 0 ? 1 : (g == 1 ? 4 : 16);
                if (rel >= 0 && rel <= 128) bv[u] = relb[t5_bucket(rel * dil) * 12 + hd]; } }
        __builtin_amdgcn_sched_barrier(0);
#pragma unroll
        for (int u = 0; u < 5; ++u) { const int idx = F.tid + u * NTHR; if (idx < 12 * 192) Lb[idx] = bv[u] > -1e29f ? bv[u] * 1.4426950408889634f : -1e30f; }
    }
    lds_barrier();
}
struct Raw { u32x4 kv[4], v0[2], v1[2], q0, q1; };
struct Idx { int b, hd, dil, r, n; };
__device__ __forceinline__ Idx decode(int it) { Idx x; const int g = it >> 9, rem = it & 511; x.b = rem >> 8; const int hh = (rem >> 6) & 3, rn = rem & 63;
    x.dil = g == 0 ? 1 : (g == 1 ? 4 : 16); const int nb = 64 / x.dil; x.r = rn / nb; x.n = rn - x.r * nb; x.hd = g * 4 + hh; return x; }
__device__ __forceinline__ void load_raw(Raw& R, const unsigned char* ws, const Idx& x, int tid, int wave, int fr, int fq) {
    const bf16* AQ = (const bf16*)(ws + A_Q); const bf16* AK = (const bf16*)(ws + A_K); const bf16* AV = (const bf16*)(ws + A_V);
    const size_t mb = (size_t)x.b * SEQ;
    { const int key = tid >> 1, half = tid & 1; const int u = (x.n - 1) * 128 + key;
#pragma unroll
      for (int e = 0; e < 4; ++e) R.kv[e] = (u32x4){0u, 0u, 0u, 0u};
      if (u >= 0) { const u32x4* kp = (const u32x4*)(AK + (mb + (size_t)u * x.dil + x.r) * 768 + x.hd * 64 + half * 32);
#pragma unroll
        for (int e = 0; e < 4; ++e) R.kv[e] = kp[e]; } }
    { const int kp = tid >> 2, dq = tid & 3; const int u0 = (x.n - 1) * 128 + 2 * kp;
      R.v0[0] = R.v0[1] = R.v1[0] = R.v1[1] = (u32x4){0u, 0u, 0u, 0u};
      if (u0 >= 0) { const u32x4* p0 = (const u32x4*)(AV + (mb + (size_t)u0 * x.dil + x.r) * 768 + x.hd * 64 + dq * 16); const u32x4* p1 = (const u32x4*)(AV + (mb + (size_t)(u0 + 1) * x.dil + x.r) * 768 + x.hd * 64 + dq * 16);
        R.v0[0] = p0[0]; R.v0[1] = p0[1]; R.v1[0] = p1[0]; R.v1[1] = p1[1]; } }
    { const int qi = 16 * wave + fr; const size_t mq = mb + (size_t)(x.n * 128 + qi) * x.dil + x.r;
      R.q0 = *(const u32x4*)(AQ + mq * 768 + x.hd * 64 + 8 * fq); R.q1 = *(const u32x4*)(AQ + mq * 768 + x.hd * 64 + 32 + 8 * fq); }
}
__device__ __forceinline__ void run(Frame& F0, unsigned char* ws, const float* qg, const float* kg, int first, int stride, int nitems) {
    LAS unsigned char* L = F0.lds; const int wave = F0.wave;
    bf16* AQ = (bf16*)(ws + A_Q); float* LSE = (float*)(ws + WS_LSE);
    Raw R;
    { int ln; asm volatile("v_mbcnt_lo_u32_b32 %0, -1, 0\n\tv_mbcnt_hi_u32_b32 %0, -1, %0" : "=v"(ln));
      if (first < nitems) { const Idx x0 = decode(first); load_raw(R, ws, x0, wave * 64 + ln, wave, ln & 15, ln >> 4); } }
#pragma unroll 1
    for (int it = first; it < nitems; it += stride) {
        int lane_c; asm volatile("v_mbcnt_lo_u32_b32 %0, -1, 0\n\tv_mbcnt_hi_u32_b32 %0, -1, %0" : "=v"(lane_c));
        const int lane = lane_c, tid = wave * 64 + lane, fr = lane & 15, fq = lane >> 4;
        const Idx x = decode(it); const int n = x.n, hd = x.hd;
        const size_t mb = (size_t)x.b * SEQ;
        {
            const int key = tid >> 1, half = tid & 1;
            float s2 = 0.f;
#pragma unroll
            for (int e = 0; e < 4; ++e)
#pragma unroll
                for (int c = 0; c < 4; ++c) { const float a0 = bf2f(R.kv[e][c] & 0xffffu), a1 = bf2f(R.kv[e][c] >> 16); s2 += a0 * a0 + a1 * a1; }
            s2 += shx(s2, 1, lane);
            const float rs = __builtin_amdgcn_rsqf(s2 * (1.f / 64.f) + RMS_EPS);
#pragma unroll
            for (int e = 0; e < 4; ++e) { u32x4 o;
#pragma unroll
                for (int c = 0; c < 4; ++c) o[c] = cvtpk(bf2f(R.kv[e][c] & 0xffffu) * rs, bf2f(R.kv[e][c] >> 16) * rs);
                *(LAS u32x4*)(L + O_KL + (key * 72 + half * 32 + e * 8) * 2) = o; }
        }
        {
            const int kp = tid >> 2, dq = tid & 3;
#pragma unroll
            for (int e = 0; e < 2; ++e)
#pragma unroll
                for (int c = 0; c < 4; ++c) { const int d = dq * 16 + e * 8 + c * 2; const unsigned a = R.v0[e][c], bq = R.v1[e][c];
                    *(LAS unsigned*)(L + O_VT + (d * 264 + 2 * kp) * 2) = (a & 0xffffu) | (bq << 16);
                    *(LAS unsigned*)(L + O_VT + ((d + 1) * 264 + 2 * kp) * 2) = (a >> 16) | (bq & 0xffff0000u); }
        }
        const int qi = 16 * wave + fr; const size_t mq = mb + (size_t)(n * 128 + qi) * x.dil + x.r;
        bf16x8 qf[2];
        {
            const u32x4 q0 = R.q0, q1 = R.q1;
            float s2 = 0.f;
#pragma unroll
            for (int c = 0; c < 4; ++c) { const float a0 = bf2f(q0[c] & 0xffffu), a1 = bf2f(q0[c] >> 16), b0 = bf2f(q1[c] & 0xffffu), b1 = bf2f(q1[c] >> 16); s2 += (a0 * a0 + a1 * a1) + (b0 * b0 + b1 * b1); }
            s2 += shx(s2, 16, lane); s2 += shx(s2, 32, lane);
            const float rs = __builtin_amdgcn_rsqf(s2 * (1.f / 64.f) + RMS_EPS);
            const LAS float* qk = (const LAS float*)(L + O_QKG) + 8 * fq;
            const f32x4 g0 = *(const LAS f32x4*)qk, g1 = *(const LAS f32x4*)(qk + 4), g2 = *(const LAS f32x4*)(qk + 32), g3 = *(const LAS f32x4*)(qk + 36);
            u32x4 o0, o1;
#pragma unroll
            for (int c = 0; c < 4; ++c) { const float ga = c < 2 ? g0[2 * c] : g1[2 * c - 4], gb = c < 2 ? g0[2 * c + 1] : g1[2 * c - 3], gc = c < 2 ? g2[2 * c] : g3[2 * c - 4], gd = c < 2 ? g2[2 * c + 1] : g3[2 * c - 3];
                o0[c] = cvtpk(bf2f(q0[c] & 0xffffu) * rs * ga, bf2f(q0[c] >> 16) * rs * gb);
                o1[c] = cvtpk(bf2f(q1[c] & 0xffffu) * rs * gc, bf2f(q1[c] >> 16) * rs * gd); }
            qf[0] = __builtin_bit_cast(bf16x8, o0); qf[1] = __builtin_bit_cast(bf16x8, o1);
        }
        lds_barrier();
        if (it + stride < nitems) { const Idx xn = decode(it + stride); load_raw(R, ws, xn, tid, wave, fr, fq); }
        const int kt0 = wave & ~1;
        f32x4 sc[10];
#pragma unroll
        for (int j = 0; j < 10; ++j) { sc[j] = (f32x4){0.f, 0.f, 0.f, 0.f};
#pragma unroll
            for (int s = 0; s < 2; ++s) { const bf16x8 kf = *(const LAS bf16x8*)(L + O_KL + (((kt0 + j) * 16 + fr) * 72 + 32 * s + 8 * fq) * 2); sc[j] = AT_MFMA(kf, qf[s], sc[j]); } }
        const LAS float* Lb = (const LAS float*)(L + O_LB) + hd * 192 + (qi + 160 - kt0 * 16 - 4 * fq);
        float mx = -1e30f;
#pragma unroll
        for (int j = 0; j < 10; ++j)
#pragma unroll
            for (int rr = 0; rr < 4; ++rr) sc[j][rr] += Lb[-(16 * j + rr)];
        if (n == 0) {
#pragma unroll
            for (int j = 0; j < 10; ++j)
#pragma unroll
                for (int rr = 0; rr < 4; ++rr) if ((kt0 + j) * 16 + 4 * fq + rr < 128) sc[j][rr] = -1e30f; }
#pragma unroll
        for (int j = 0; j < 10; ++j)
#pragma unroll
            for (int rr = 0; rr < 4; ++rr) mx = fmaxf(mx, sc[j][rr]);
        mx = fmaxf(mx, shx(mx, 16, lane)); mx = fmaxf(mx, shx(mx, 32, lane));
        float l = 0.f;
#pragma unroll
        for (int j = 0; j < 10; ++j)
#pragma unroll
            for (int rr = 0; rr < 4; ++rr) { const float p = __builtin_amdgcn_exp2f(sc[j][rr] - mx); sc[j][rr] = p; l += p; }
        l += shx(l, 16, lane); l += shx(l, 32, lane);
        f32x4 oc[4];
#pragma unroll
        for (int dt = 0; dt < 4; ++dt) oc[dt] = (f32x4){0.f, 0.f, 0.f, 0.f};
#pragma unroll
        for (int s = 0; s < 5; ++s) {
            const bf16x8 pf = mk8((u32x2){cvtpk(sc[2 * s][0], sc[2 * s][1]), cvtpk(sc[2 * s][2], sc[2 * s][3])}, (u32x2){cvtpk(sc[2 * s + 1][0], sc[2 * s + 1][1]), cvtpk(sc[2 * s + 1][2], sc[2 * s + 1][3])});
            const int key0 = (kt0 + 2 * s) * 16 + 4 * fq;
#pragma unroll
            for (int dt = 0; dt < 4; ++dt) { const bf16x8 vf = mk8(*(const LAS u32x2*)(L + O_VT + ((16 * dt + fr) * 264 + key0) * 2), *(const LAS u32x2*)(L + O_VT + ((16 * dt + fr) * 264 + key0 + 16) * 2)); oc[dt] = AT_MFMA(vf, pf, oc[dt]); }
        }
        const float il = __builtin_amdgcn_rcpf(l);
#pragma unroll
        for (int dt = 0; dt < 4; ++dt) *(u32x2*)(AQ + mq * 768 + hd * 64 + 16 * dt + 4 * fq) = (u32x2){cvtpk(oc[dt][0] * il, oc[dt][1] * il), cvtpk(oc[dt][2] * il, oc[dt][3] * il)};
        if (fq == 0) LSE[mq * 12 + hd] = (mx + __builtin_amdgcn_logf(l)) * 0.6931471805599453f;
        lds_barrier();
    }
}
#undef AT_MFMA
}

namespace lr {
typedef short bf16x8 __attribute__((ext_vector_type(8)));
typedef float f32x4 __attribute__((ext_vector_type(4)));
typedef float f32x2 __attribute__((ext_vector_type(2)));
typedef unsigned u32x4 __attribute__((ext_vector_type(4)));
constexpr int O_WAT = 0, O_WXT = 9216, O_XCF = 18432, O_XCB = O_XCF + 16384, O_AF = O_XCB + 9216, O_BF = O_AF + 16384, O_VEC = O_BF + 16384, O_FOLD = O_VEC + 2048, O_HC = O_FOLD + 4096, O_END = O_HC + 256;
constexpr int V_CW = 0, V_CB = 256, V_BA = 320, V_BX = 384, V_SPL = 448;
__device__ __forceinline__ float gelu_fast(float x) { const float u = 0.7978845608028654f * (x + 0.044715f * x * x * x); return x * (1.f - __builtin_amdgcn_rcpf(1.f + __expf(2.f * u))); }
#define LR_MFMA(a, b, c) __builtin_amdgcn_mfma_f32_16x16x32_bf16((a), (b), (c), 0, 0, 0)
template <int PASS>
__device__ __forceinline__ void item(Frame& F, unsigned char* ws, const LruP& P, int b, int blk, int tg) {
    LAS unsigned char* L = F.lds;
    const int wave = F.wave;
    LAS float* VEC = (LAS float*)(L + O_VEC);
    const bf16* ZBX = (const bf16*)(ws + Z_BX); bf16* ZBY = (bf16*)(ws + Z_BY);
    f32x2* AGG = (f32x2*)(ws + WS_LRUAGG);
    {
        const int tid = F.tid, j = tid & 63, ig = tid >> 6;
        float va[8], vx[8];
#pragma unroll
        for (int e = 0; e < 8; ++e) { va[e] = P.wa[blk * 4096 + (ig * 8 + e) * 64 + j]; vx[e] = P.wx[blk * 4096 + (ig * 8 + e) * 64 + j]; }
        *(LAS u32x4*)(L + O_WAT + (j * 72 + ig * 8) * 2) = (u32x4){pg8::cvt_pk_bf16(va[0], va[1]), pg8::cvt_pk_bf16(va[2], va[3]), pg8::cvt_pk_bf16(va[4], va[5]), pg8::cvt_pk_bf16(va[6], va[7])};
        *(LAS u32x4*)(L + O_WXT + (j * 72 + ig * 8) * 2) = (u32x4){pg8::cvt_pk_bf16(vx[0], vx[1]), pg8::cvt_pk_bf16(vx[2], vx[3]), pg8::cvt_pk_bf16(vx[4], vx[5]), pg8::cvt_pk_bf16(vx[6], vx[7])};
        if (tid < 64) { const int ch = blk * 64 + tid;
            const float c0 = P.cw[ch], c1 = P.cw[512 + ch], c2 = P.cw[1024 + ch], c3 = P.cw[1536 + ch], cbv = P.cb[ch], bav = P.ba[ch], bxv = P.bx[ch], xl = -P.lam[ch];
            __builtin_amdgcn_sched_barrier(0);
            VEC[V_CW + tid] = c0; VEC[V_CW + 64 + tid] = c1; VEC[V_CW + 128 + tid] = c2; VEC[V_CW + 192 + tid] = c3;
            VEC[V_CB + tid] = cbv; VEC[V_BA + tid] = bav; VEC[V_BX + tid] = bxv; VEC[V_SPL + tid] = fmaxf(xl, 0.f) + __logf(1.f + __expf(-fabsf(xl))); }
    }
    float hcar = 0.f;
    if (PASS == 1) {
        const int c = F.lane; float A = 1.f, B = 0.f;
        f32x2 abv[15];
#pragma unroll
        for (int k = 0; k < 15; ++k) { abv[k] = (f32x2){1.f, 0.f}; if (k < tg) abv[k] = AGG[((size_t)b * 128 + wave * tg + k) * 512 + blk * 64 + c]; }
#pragma unroll
        for (int k = 0; k < 15; ++k) { B = abv[k].x * B + abv[k].y; A = abv[k].x * A; }
        ((LAS f32x2*)(L + O_FOLD))[wave * 64 + c] = (f32x2){A, B};
        lds_barrier();
        if (wave == 0) {
#pragma unroll
            for (int w = 0; w < 8; ++w) { const f32x2 ab = ((LAS f32x2*)(L + O_FOLD))[w * 64 + c]; hcar = ab.x * hcar + ab.y; } }
    }
    if (wave == 0) ((LAS float*)(L + O_HC))[F.lane] = hcar;
    u32x4 xq[4], yq = {0u, 0u, 0u, 0u};
#define LR_LOAD(TILE, TID) do { const int tt_ = (TID) >> 3, c8_ = ((TID) & 7) * 8, t0_ = (TILE) * 64; \
        _Pragma("unroll") for (int i = 0; i < 4; ++i) { const int ts = t0_ + tt_ - 3 + i; xq[i] = (u32x4){0u, 0u, 0u, 0u}; if (ts >= 0) xq[i] = *(const u32x4*)(ZBX + ((size_t)b * SEQ + ts) * 512 + blk * 64 + c8_); } \
        if (PASS == 1) yq = *(const u32x4*)(ZBY + ((size_t)b * SEQ + t0_ + tt_) * 512 + blk * 64 + c8_); } while (0)
    { int ln; asm volatile("v_mbcnt_lo_u32_b32 %0, -1, 0\n\tv_mbcnt_hi_u32_b32 %0, -1, %0" : "=v"(ln)); LR_LOAD(tg * 8, wave * 64 + ln); }
    lds_barrier();
#pragma unroll 1
    for (int tl = 0; tl < 8; ++tl) {
        int lane_c; asm volatile("v_mbcnt_lo_u32_b32 %0, -1, 0\n\tv_mbcnt_hi_u32_b32 %0, -1, %0" : "=v"(lane_c));
        const int lane = lane_c, tid = wave * 64 + lane, fr = lane & 15, fq = lane >> 4;
        const int tile = tg * 8 + tl, t0 = tile * 64; const size_t m0 = (size_t)b * SEQ + t0;
        const u32x4 yv = yq;
        {
            const int tt = tid >> 3, c8 = (tid & 7) * 8; float acc[8];
#pragma unroll
            for (int e = 0; e < 8; ++e) acc[e] = VEC[V_CB + c8 + e];
#pragma unroll
            for (int i = 0; i < 4; ++i) { const u32x4 xv = xq[i];
#pragma unroll
                    for (int c = 0; c < 4; ++c) { acc[2 * c] += VEC[V_CW + i * 64 + c8 + 2 * c] * bf2f(xv[c] & 0xffffu); acc[2 * c + 1] += VEC[V_CW + i * 64 + c8 + 2 * c + 1] * bf2f(xv[c] >> 16); } }
            if (tl + 1 < 8) LR_LOAD(tile + 1, tid);
            *(LAS f32x4*)(L + O_XCF + (tt * 64 + c8) * 4) = (f32x4){acc[0], acc[1], acc[2], acc[3]}; *(LAS f32x4*)(L + O_XCF + (tt * 64 + c8 + 4) * 4) = (f32x4){acc[4], acc[5], acc[6], acc[7]};
            *(LAS u32x4*)(L + O_XCB + (tt * 72 + c8) * 2) = (u32x4){pg8::cvt_pk_bf16(acc[0], acc[1]), pg8::cvt_pk_bf16(acc[2], acc[3]), pg8::cvt_pk_bf16(acc[4], acc[5]), pg8::cvt_pk_bf16(acc[6], acc[7])};
        }
        lds_barrier();
        {
            const int nt = wave & 3, mh = wave >> 2, jn = 16 * nt + fr;
            f32x4 ga[2], gx[2];
#pragma unroll
            for (int mm = 0; mm < 2; ++mm) { ga[mm] = (f32x4){0.f, 0.f, 0.f, 0.f}; gx[mm] = ga[mm]; }
#pragma unroll
            for (int s = 0; s < 2; ++s) { const bf16x8 wa = *(const LAS bf16x8*)(L + O_WAT + (jn * 72 + 32 * s + 8 * fq) * 2), wx = *(const LAS bf16x8*)(L + O_WXT + (jn * 72 + 32 * s + 8 * fq) * 2);
#pragma unroll
                for (int mm = 0; mm < 2; ++mm) { const bf16x8 xa = *(const LAS bf16x8*)(L + O_XCB + ((16 * (2 * mh + mm) + fr) * 72 + 32 * s + 8 * fq) * 2); ga[mm] = LR_MFMA(xa, wa, ga[mm]); gx[mm] = LR_MFMA(xa, wx, gx[mm]); } }
            const float ba = VEC[V_BA + jn], bx = VEC[V_BX + jn], spl = VEC[V_SPL + jn];
#pragma unroll
            for (int mm = 0; mm < 2; ++mm)
#pragma unroll
                for (int r = 0; r < 4; ++r) { const int tt = 16 * (2 * mh + mm) + 4 * fq + r;
                    const float xc = ((LAS float*)(L + O_XCF))[tt * 64 + jn];
                    const float g_a = __builtin_amdgcn_rcpf(1.f + __expf(-(ga[mm][r] + ba))), g_x = __builtin_amdgcn_rcpf(1.f + __expf(-(gx[mm][r] + bx)));
                    const float log_a = -8.0f * g_a * spl; const float a = __expf(log_a); float mult = __builtin_amdgcn_sqrtf(fmaxf(1.f - a * a, 0.f));
                    if (t0 + tt == 0) mult = 1.f;
                    ((LAS float*)(L + O_AF))[tt * 64 + jn] = a; ((LAS float*)(L + O_BF))[tt * 64 + jn] = xc * g_x * mult; }
        }
        lds_barrier();
        {
            float al[8], hl[8]; float A = 1.f, B = 0.f;
#pragma unroll
            for (int k = 0; k < 8; ++k) { const int tt = 8 * wave + k; const float a = ((LAS float*)(L + O_AF))[tt * 64 + lane]; B = a * B + ((LAS float*)(L + O_BF))[tt * 64 + lane]; A *= a; al[k] = A; hl[k] = B; }
            ((LAS f32x2*)(L + O_FOLD))[wave * 64 + lane] = (f32x2){A, B};
            lds_barrier();
            float hin = ((LAS float*)(L + O_HC))[lane];
            float At = 1.f;
#pragma unroll
            for (int w = 0; w < 8; ++w) { const f32x2 ab = ((LAS f32x2*)(L + O_FOLD))[w * 64 + lane]; if (w < wave) hin = ab.x * hin + ab.y; At *= ab.x; }
            if (PASS == 0) {
                if (wave == 7) { const float Bt = al[7] * hin + hl[7];
                    AGG[((size_t)b * 128 + tile) * 512 + blk * 64 + lane] = (f32x2){At, Bt}; }
            } else {
#pragma unroll
                for (int k = 0; k < 8; ++k) ((LAS float*)(L + O_BF))[(8 * wave + k) * 64 + lane] = al[k] * hin + hl[k];
                if (wave == 7) hcar = al[7] * hin + hl[7];
            }
        }
        lds_barrier();
        if (PASS == 1 && wave == 7) ((LAS float*)(L + O_HC))[lane] = hcar;
        if (PASS == 1) {
            const int tt = tid >> 3, c8 = (tid & 7) * 8; bf16* yp = ZBY + (m0 + tt) * 512 + blk * 64 + c8;
            const f32x4 h0 = *(const LAS f32x4*)(L + O_BF + (tt * 64 + c8) * 4), h1 = *(const LAS f32x4*)(L + O_BF + (tt * 64 + c8 + 4) * 4);
            u32x4 o;
#pragma unroll
            for (int c = 0; c < 4; ++c) { const float hA = c < 2 ? h0[2 * c] : h1[2 * c - 4], hB = c < 2 ? h0[2 * c + 1] : h1[2 * c - 3];
                o[c] = pg8::cvt_pk_bf16(hA * gelu_fast(bf2f(yv[c] & 0xffffu)), hB * gelu_fast(bf2f(yv[c] >> 16))); }
            *(u32x4*)yp = o;
            lds_barrier();
        }
    }
}
#undef LR_MFMA
#undef LR_LOAD
}

__device__ __forceinline__ void phase_combine(Frame& F, unsigned char* ws) {
    typedef unsigned u32x4c __attribute__((ext_vector_type(4)));
    const bf16* AQ = (const bf16*)(ws + A_Q); const float* LSE = (const float*)(ws + WS_LSE); bf16* OC = (bf16*)(ws + WS_OC);
    const int stride = F.G * NTHR;
    for (int it0 = F.vcu * NTHR + F.tid; it0 < M * 32; it0 += 4 * stride) {
        float l0[4], l1[4], l2[4]; u32x4c a0[4], a1[4], a2[4];
#pragma unroll
        for (int u = 0; u < 4; ++u) { const int it = it0 + u * stride; if (it < M * 32) { const int m = it >> 5, c8 = (it & 31) * 8, hh = c8 >> 6;
            l0[u] = LSE[(size_t)m * 12 + hh]; l1[u] = LSE[(size_t)m * 12 + 4 + hh]; l2[u] = LSE[(size_t)m * 12 + 8 + hh];
            a0[u] = *(const u32x4c*)(AQ + (size_t)m * 768 + c8); a1[u] = *(const u32x4c*)(AQ + (size_t)m * 768 + 256 + c8); a2[u] = *(const u32x4c*)(AQ + (size_t)m * 768 + 512 + c8); } }
        __builtin_amdgcn_sched_barrier(0);
#pragma unroll
        for (int u = 0; u < 4; ++u) { const int it = it0 + u * stride; if (it < M * 32) { const int m = it >> 5, c8 = (it & 31) * 8;
            const float mx = fmaxf(l0[u], fmaxf(l1[u], l2[u])); float e0 = __expf(l0[u] - mx), e1 = __expf(l1[u] - mx), e2 = __expf(l2[u] - mx); const float inv = 1.f / (e0 + e1 + e2);
            e0 *= inv; e1 *= inv; e2 *= inv;
            u32x4c o;
#pragma unroll
            for (int c = 0; c < 4; ++c) o[c] = pg8::cvt_pk_bf16(e0 * bf2f(a0[u][c] & 0xffffu) + e1 * bf2f(a1[u][c] & 0xffffu) + e2 * bf2f(a2[u][c] & 0xffffu), e0 * bf2f(a0[u][c] >> 16) + e1 * bf2f(a1[u][c] >> 16) + e2 * bf2f(a2[u][c] >> 16));
            *(u32x4c*)(OC + (size_t)m * 256 + c8) = o; } }
    }
}

constexpr int LDS_BYTES = 163840, LDSCTL_OFF = LDS_BYTES - 512, MISC_OFF = LDSCTL_OFF + 64;
constexpr int PH_PER_LAYER = 10, NPHASES = DEPTH * PH_PER_LAYER;

template <int PH>
__global__ void __launch_bounds__(NTHR, 2) fwd_kernel(Args args) {
    extern __shared__ __attribute__((aligned(16))) unsigned char lds[];
    Frame F0;
    F0.lds = (LAS unsigned char*)lds;
    F0.tid = 0; F0.lane = 0; F0.wave = __builtin_amdgcn_readfirstlane((int)threadIdx.x >> 6);
    F0.bid = blockIdx.x; F0.G = gridDim.x; { const int bx = blockIdx.x; F0.vcu = (F0.G % 8 == 0) ? (bx % 8) * (F0.G / 8) + bx / 8 : bx; }
    unsigned char* ws = args.ws;
    volatile LAS unsigned* MISC = (volatile LAS unsigned*)(F0.lds + MISC_OFF);
    for (int u = threadIdx.x; u < (LDS_BYTES - LDSCTL_OFF) / 4; u += NTHR) ((LAS unsigned*)(F0.lds + LDSCTL_OFF))[u] = 0u;
    __syncthreads();
    XcdBarrier bar; bar.bar = (unsigned*)(ws + WS_CTL) + CW_BAR; bar.x = 0; bar.st = nullptr;
    if (MK_ONE_LAUNCH) bar = xcd_barrier_post((unsigned*)(ws + WS_CTL) + CW_BAR, MISC + 8);
    const int lo = args.ph_lo, hi = args.ph_hi;
#define IN(k) ((PH < 0 || PH == ((k) % PH_PER_LAYER)) && lo <= (k) && (k) < hi)
#define SEAM(k) do { if (MK_ONE_LAUNCH && IN(k) && IN((k) + 1)) { for (int rb_ = 0; rb_ < REP_BAR; ++rb_) xcd_barrier(bar); } } while (0)

#define PHASE(k) if constexpr (PH < 0 || PH == (k)) if (IN(pb + (k)))
#define PHASE_BEGIN Frame F = phase_frame(F0); unsigned char* ws = launder(args.ws); float* outp = launder(args.out); (void)outp; float* ssb = (float*)(ws + WS_CTL + WS_SS); (void)ssb;
#pragma unroll 1
    for (int l = 0; l < DEPTH; ++l) {
        const int pb = l * PH_PER_LAYER;
        const float* xin = (l == 0) ? args.in[I_X] : args.out;
        if (l == 0) { PHASE(0) { PHASE_BEGIN phase_x2bf(F, launder(args.in[I_X]), (bf16*)(ws + WS_XB), ssb); for (int i = F.vcu * NTHR + F.tid; i < 3 * M; i += F.G * NTHR) ssb[M + i] = 0.f;     convert_wb1(F, args, 0, ws); } SEAM(pb + 0); }
        PHASE(1) { { PHASE_BEGIN rk::lora_inputs<0>(F, ws, launder(args.in[I_MU] + l * 1824), launder((const float*)ssb + (size_t)(2 * l) * M)); __syncthreads(); }
          PHASE_BEGIN pg8::Gemm g{(const bf16*)(ws + WS_XB), (const bf16*)(ws + WS_WMIX), M, 5120, D}; pg8::EpiMixMF E{ws, (const LAS float*)(F.lds + 131072)};
            for (int rep = 0; rep < REP_MIX; ++rep) { Frame Fr = phase_frame(F0); pg8::RstdOrder S; S.init(M, 5120, Fr.G, Fr.bid); S.ss = ssb + (size_t)(2 * l) * M; S.tab = (LAS float*)(Fr.lds + 131072); S.tid = Fr.tid;
                pg8::gemm_phase<pg8::EpiMixMF, pg8::RstdOrder, true, true, true>(Fr.lds, g, S, E, Fr.tid); } } SEAM(pb + 1);
        PHASE(2) { PHASE_BEGIN
            RwkvP P{args.in[I_MU] + l * 1824, args.in[I_W0] + l * 512, args.in[I_WUP] + l * 64 * 512, args.in[I_A0] + l * 512, args.in[I_AUP] + l * 64 * 512, args.in[I_GUP] + l * 160 * 512,
                    args.in[I_KK] + l * 512, args.in[I_KA] + l * 512, args.in[I_RK] + l * 512, args.in[I_LNG] + l * 512, args.in[I_LNB] + l * 512};
            LruP PL{args.in[I_CW] + l * 4 * 512, args.in[I_CB] + l * 512, args.in[I_LWA] + l * 8 * 4096, args.in[I_LBA] + l * 512, args.in[I_LWX] + l * 8 * 4096, args.in[I_LBX] + l * 512, args.in[I_LAM] + l * 512};
            { Frame Fi = phase_frame(F); rk::lora_inputs<1>(Fi, launder(ws), launder(P.mu), launder((const float*)ssb + (size_t)(2 * l) * M)); }
            xcd_barrier(bar);
            for (int rep = 0; rep < REP_RWKV; ++rep) for (int it = F.vcu; it < 256; it += F.G) { Frame Fi = phase_frame(F); rk2::item<0>(Fi, launder(ws), P, it >> 7, (it >> 4) & 7, it & 15); }
            for (int rep = 0; rep < REP_LRUA; ++rep) for (int it = F.vcu; it < 256; it += F.G) { Frame Fi = phase_frame(F); lr::item<0>(Fi, launder(ws), PL, it >> 7, (it >> 4) & 7, it & 15); }
            { Frame Fi = phase_frame(F); at::bias_table(Fi, launder(args.in[I_RELB]), launder(args.in[I_QG] + l * 64), launder(args.in[I_KG] + l * 64)); }
            { Frame Fi = phase_frame(F); at::run(Fi, launder(ws), launder(args.in[I_QG] + l * 64), launder(args.in[I_KG] + l * 64), Fi.vcu, Fi.G, 1536); }
        } SEAM(pb + 2);
        PHASE(3) { PHASE_BEGIN
            { RwkvP P{args.in[I_MU] + l * 1824, args.in[I_W0] + l * 512, args.in[I_WUP] + l * 64 * 512, args.in[I_A0] + l * 512, args.in[I_AUP] + l * 64 * 512, args.in[I_GUP] + l * 160 * 512,
                    args.in[I_KK] + l * 512, args.in[I_KA] + l * 512, args.in[I_RK] + l * 512, args.in[I_LNG] + l * 512, args.in[I_LNB] + l * 512};
              for (int rep = 0; rep < REP_RWKV; ++rep) for (int it = F.vcu; it < 256; it += F.G) { Frame Fi = phase_frame(F); rk2::item<1>(Fi, launder(ws), P, it >> 7, (it >> 4) & 7, it & 15); } }
            { LruP PL{args.in[I_CW] + l * 4 * 512, args.in[I_CB] + l * 512, args.in[I_LWA] + l * 8 * 4096, args.in[I_LBA] + l * 512, args.in[I_LWX] + l * 8 * 4096, args.in[I_LBX] + l * 512, args.in[I_LAM] + l * 512};
              for (int it = F.vcu; it < 256; it += F.G) { Frame Fi = phase_frame(F); lr::item<1>(Fi, launder(ws), PL, it >> 7, (it >> 4) & 7, it & 15); } }
            phase_combine(F, ws); } SEAM(pb + 3);
        PHASE(5) { for (int rep = 0; rep < (REP_PH == 5 ? 2 : 1); ++rep) {
            Frame Fa = phase_frame(F0); unsigned char* wsa = launder(args.ws); pg8::StaticOrder S; S.init(M, D, Fa.G, Fa.bid); pg8::Unit u;
            if (S.next(0, u)) {
                pg8::MergeDisp Dp{(const char*)(wsa + WS_XB), (const char*)(wsa + WS_WG), (const char*)wsa, (const char*)(wsa + WS_PA),
                                  (bf16*)(wsa + WS_GSCR), (bf16*)(wsa + WS_MERGED), (const float*)(wsa + WS_CTL + WS_SS) + (size_t)(2 * l) * M, (LAS float*)(Fa.lds + 131072), Fa.tid};
                pg8::gemm_seq<pg8::MergeDisp>(Fa.lds, Dp, 6, u.pm, u.pn, Fa.tid); }
        } } SEAM(pb + 5);
        PHASE(6) { { PHASE_BEGIN convert_wb2(F, args, l, ws); __syncthreads(); }
            { PHASE_BEGIN pg8::Gemm g{(const bf16*)(ws + WS_MERGED), (const bf16*)(ws + WS_WOUT), M, D, D}; pg8::StaticOrder S; S.init(M, D, F.G, F.bid); pg8::EpiResH E{nullptr, (const bf16*)(ws + WS_XB), (bf16*)(ws + WS_XB), nullptr, ssb + (size_t)(2 * l + 1) * M};
              if (REP_PH == 6) { pg8::EpiResH Ed = E; Ed.dry = true; Frame Fr = phase_frame(F0); pg8::gemm_phase<pg8::EpiResH, pg8::StaticOrder, true, true>(Fr.lds, g, S, Ed, Fr.tid); }
              { Frame Fr = phase_frame(F0); pg8::gemm_phase<pg8::EpiResH, pg8::StaticOrder, true, true>(Fr.lds, g, S, E, Fr.tid); } } } SEAM(pb + 6);
        PHASE(8) { if (l + 1 < DEPTH) { PHASE_BEGIN convert_wb1(F, args, l + 1, ws); __syncthreads(); }
            { PHASE_BEGIN pg8::Gemm g{(const bf16*)(ws + WS_XB), (const bf16*)(ws + WS_WUP), M, FF, D}; pg8::EpiActMF<2> E{(bf16*)(ws + WS_HID), FF, (const LAS float*)(F.lds + 131072)};
              for (int rep = 0; rep < (REP_PH == 8 ? 2 : 1); ++rep) { Frame Fr = phase_frame(F0); pg8::RstdOrder S; S.init(M, FF, Fr.G, Fr.bid); S.ss = ssb + (size_t)(2 * l + 1) * M; S.tab = (LAS float*)(Fr.lds + 131072); S.tid = Fr.tid;
                pg8::gemm_phase<pg8::EpiActMF<2>, pg8::RstdOrder, true, true, true>(Fr.lds, g, S, E, Fr.tid); } } } SEAM(pb + 8);
        PHASE(9) { PHASE_BEGIN pg8::Gemm g{(const bf16*)(ws + WS_HID), (const bf16*)(ws + WS_WDOWN), M, D, FF}; pg8::StaticOrder S; S.init(M, D, F.G, F.bid);
            pg8::EpiResH E{nullptr, (const bf16*)(ws + WS_XB), (l + 1 < DEPTH) ? (bf16*)(ws + WS_XB) : nullptr, (l + 1 < DEPTH) ? nullptr : outp, (l + 1 < DEPTH) ? ssb + (size_t)(2 * l + 2) * M : nullptr};
            if (REP_PH == 9) { pg8::EpiResH Ed = E; Ed.dry = true; Frame Fr = phase_frame(F0); pg8::gemm_phase<pg8::EpiResH, pg8::StaticOrder, true, true>(Fr.lds, g, S, Ed, Fr.tid); }
            { Frame Fr = phase_frame(F0); pg8::gemm_phase<pg8::EpiResH, pg8::StaticOrder, true, true>(Fr.lds, g, S, E, Fr.tid); } }
        if (l + 1 < DEPTH) SEAM(pb + 9);
    }
#undef PHASE
#undef PHASE_BEGIN
#undef IN
#undef SEAM
}

extern "C" void kernel_launch(void* const* d_in, const int* in_sizes, int n_in, void* d_out, int out_size, void* d_ws, size_t ws_size, hipStream_t stream) {
    static int grid = 0;
    if (grid == 0) {
        if (n_in != 31 || in_sizes[0] != M * D || out_size != M * D || ws_size < WS_END) { fprintf(stderr, "kernel_launch: unexpected shapes (n_in %d, in0 %d, out %d, ws %zu); nothing launched\n", n_in, n_in > 0 ? in_sizes[0] : -1, out_size, ws_size); grid = -1; return; }
        int dev = 0, cus = 0;
        if (hipGetDevice(&dev) != hipSuccess || hipDeviceGetAttribute(&cus, hipDeviceAttributeMultiprocessorCount, dev) != hipSuccess) { grid = -1; return; }
        bool okattr = true;
#define SETATTR(P) okattr = okattr && (hipFuncSetAttribute((const void*)fwd_kernel<P>, hipFuncAttributeMaxDynamicSharedMemorySize, LDS_BYTES) == hipSuccess)
#if MK_ONE_LAUNCH
        SETATTR(-1);
#else
        SETATTR(0); SETATTR(1); SETATTR(2); SETATTR(3); SETATTR(4); SETATTR(5); SETATTR(6); SETATTR(7); SETATTR(8); SETATTR(9);
#endif
        if (!okattr) { fprintf(stderr, "kernel_launch: hipFuncSetAttribute failed\n"); grid = -1; return; }
        (void)hipGetLastError();
        grid = cus;
    }
    if (grid < 0) return;
    if (hipMemsetAsync((char*)d_ws + WS_CTL, 0, CTL_ZERO_BYTES, stream) != hipSuccess) return;
    Args a{};
    for (int i = 0; i < 31; ++i) a.in[i] = (const float*)d_in[i];
    a.out = (float*)d_out; a.ws = (unsigned char*)d_ws;
#if MK_ONE_LAUNCH
    {
        a.ph_lo = 0; a.ph_hi = NPHASES;
        hipLaunchKernelGGL(fwd_kernel<-1>, dim3(grid), dim3(NTHR), LDS_BYTES, stream, a);
    }
#else
    {
#define LAUNCH(P) case P: hipLaunchKernelGGL(fwd_kernel<P>, dim3(grid), dim3(NTHR), LDS_BYTES, stream, a); break;
        for (int p = 0; p < NPHASES; ++p) { a.ph_lo = p; a.ph_hi = p + 1;
            switch (p % PH_PER_LAYER) { LAUNCH(0) LAUNCH(1) LAUNCH(2) LAUNCH(3) LAUNCH(4) LAUNCH(5) LAUNCH(6) LAUNCH(7) LAUNCH(8) LAUNCH(9) } }
    }
#endif
}
```
